# Optimizing an MI355X kernel written in HIP

```python
import math
import jax, jax.numpy as jnp
from jax import lax
import numpy as np

D_MODEL = 2048
BATCH = 8
SEQ = 2048
DEPTH = 4

N_META = 16
D_MIX = D_MODEL
D_S5 = D_MIX // 2
S5_GROUP = 16
S5_GROUPS = D_S5 // S5_GROUP
S5_STATE = 64
D_ML = D_MIX - D_S5
ML_HEADS = 8
ML_DV = D_ML // ML_HEADS
ML_DK = ML_DV // 2
ML_CHUNK = 64
META_PAD = (-N_META) % ML_CHUNK
QK_CONV = 3
C_QK = 2 * ML_HEADS * ML_DK
C_GATES = 4 * ML_HEADS
D_IN = D_S5 + C_QK + D_ML + D_ML + C_GATES
D_FF = 5632
FFN_CONV = 3
EPS = 1e-6
NEG = -1e30

kernel_name = 'hybrid_s5_mlstm_encoder'


def rmsnorm(x, g):
    xf = x.astype(jnp.float32)
    y = xf * lax.rsqrt(jnp.mean(xf * xf, axis=-1, keepdims=True) + EPS)
    return (y * g.astype(jnp.float32)).astype(x.dtype)


def dwconv_centred(x, w, b):
    K = w.shape[0]
    r = K // 2
    L = x.shape[1]
    xp = jnp.pad(x, ((0, 0), (r, r), (0, 0)))
    out = b
    for j in range(K):
        out = out + xp[:, j:j + L, :] * w[j]
    return out


def _ssm_combine(e1, e2):
    a1r, a1i, b1r, b1i = e1
    a2r, a2i, b2r, b2i = e2
    return (a2r * a1r - a2i * a1i,
            a2r * a1i + a2i * a1r,
            a2r * b1r - a2i * b1i + b2r,
            a2r * b1i + a2i * b1r + b2i)


def s5_direction(u, a_re, a_im, log_dt, b_re, b_im, c_re, c_im, reverse):
    f32 = jnp.float32
    a_re = jnp.minimum(a_re.astype(f32), -1e-4)
    a_im = a_im.astype(f32)
    dt = jnp.exp(log_dt.astype(f32))[:, None]
    mag = jnp.exp(a_re * dt)
    lam_r = mag * jnp.cos(a_im * dt)
    lam_i = mag * jnp.sin(a_im * dt)
    den = a_re * a_re + a_im * a_im
    p = lam_r - 1.0
    z_r = (p * a_re + lam_i * a_im) / den
    z_i = (lam_i * a_re - p * a_im) / den
    b_re = b_re.astype(f32)
    b_im = b_im.astype(f32)
    bb_r = z_r[..., None] * b_re - z_i[..., None] * b_im
    bb_i = z_r[..., None] * b_im + z_i[..., None] * b_re
    x_r = jnp.einsum('blgh,gph->blgp', u, bb_r)
    x_i = jnp.einsum('blgh,gph->blgp', u, bb_i)
    L = u.shape[1]
    lam_r_seq = jnp.broadcast_to(lam_r, (1, L) + lam_r.shape)
    lam_i_seq = jnp.broadcast_to(lam_i, (1, L) + lam_i.shape)
    _, _, s_r, s_i = lax.associative_scan(
        _ssm_combine, (lam_r_seq, lam_i_seq, x_r, x_i), reverse=reverse, axis=1)
    return (jnp.einsum('blgp,ghp->blgh', s_r, c_re.astype(f32))
            - jnp.einsum('blgp,ghp->blgh', s_i, c_im.astype(f32)))


def s5_mixer(u, a_re, a_im, log_dt, b_re, b_im, c_re, c_im, d_skip, w_glu, b_glu):
    Bsz, L, _ = u.shape
    uf = u.astype(jnp.float32).reshape(Bsz, L, S5_GROUPS, S5_GROUP)
    y = (s5_direction(uf, a_re[0], a_im[0], log_dt[0], b_re[0], b_im[0], c_re[0], c_im[0], False)
         + s5_direction(uf, a_re[1], a_im[1], log_dt[1], b_re[1], b_im[1], c_re[1], c_im[1], True)
         + d_skip.astype(jnp.float32) * uf)
    y = jax.nn.gelu(y.reshape(Bsz, L, D_S5))
    return y * jax.nn.sigmoid(y @ w_glu.astype(jnp.float32) + b_glu.astype(jnp.float32))


def mlstm_chunkwise(q, k, v, log_i, log_f):
    Bsz, H, T, dk = q.shape
    dv = v.shape[-1]
    c = ML_CHUNK
    N = T // c
    q = q.reshape(Bsz, H, N, c, dk)
    k = k.reshape(Bsz, H, N, c, dk)
    v = v.reshape(Bsz, H, N, c, dv)
    li = log_i.reshape(Bsz, H, N, c)
    lf = log_f.reshape(Bsz, H, N, c)
    b = jnp.cumsum(lf, axis=-1)
    g = b[..., -1]
    a = g[..., None] - b + li
    m_loc = jnp.max(a, axis=-1)
    w_loc = jnp.exp(a - m_loc[..., None])
    kv_loc = jnp.einsum('bhnc,bhnck,bhncv->bhnkv', w_loc, k, v)
    n_loc = jnp.einsum('bhnc,bhnck->bhnk', w_loc, k)

    def step(carry, inp):
        C, nv, m = carry
        g_n, m_l, kv_l, n_l = inp
        m_new = jnp.maximum(g_n + m, m_l)
        s_old = jnp.exp(g_n + m - m_new)
        s_loc = jnp.exp(m_l - m_new)
        C_new = s_old[..., None, None] * C + s_loc[..., None, None] * kv_l
        n_new = s_old[..., None] * nv + s_loc[..., None] * n_l
        return (C_new, n_new, m_new), (C, nv, m)

    init = (jnp.zeros((Bsz, H, dk, dv), jnp.float32),
            jnp.zeros((Bsz, H, dk), jnp.float32),
            jnp.full((Bsz, H), NEG, jnp.float32))
    xs = (jnp.moveaxis(g, 2, 0), jnp.moveaxis(m_loc, 2, 0),
          jnp.moveaxis(kv_loc, 2, 0), jnp.moveaxis(n_loc, 2, 0))
    _, (C_prev, n_prev, m_prev) = lax.scan(step, init, xs)
    C_prev = jnp.moveaxis(C_prev, 0, 2)
    n_prev = jnp.moveaxis(n_prev, 0, 2)
    m_prev = jnp.moveaxis(m_prev, 0, 2)

    D = b[..., :, None] - b[..., None, :] + li[..., None, :]
    mask = jnp.tril(jnp.ones((c, c), dtype=bool))
    Dm = jnp.where(mask, D, NEG)
    m_inter = b + m_prev[..., None]
    m_t = jnp.maximum(m_inter, jnp.max(Dm, axis=-1))
    w = jnp.where(mask, jnp.exp(Dm - m_t[..., None]), 0.0)
    s = jnp.einsum('bhntk,bhnsk->bhnts', q, k) * w
    s_inter = jnp.exp(m_inter - m_t)
    num = (jnp.einsum('bhnts,bhnsv->bhntv', s, v)
           + s_inter[..., None] * jnp.einsum('bhntk,bhnkv->bhntv', q, C_prev))
    den = jnp.sum(s, axis=-1) + s_inter * jnp.einsum('bhntk,bhnk->bhnt', q, n_prev)
    h = num / jnp.maximum(jnp.abs(den), jnp.exp(-m_t))[..., None]
    return h.reshape(Bsz, H, T, dv)


def _pad_front(x, n, value):
    widths = [(0, 0)] * x.ndim
    widths[2] = (n, 0)
    return jnp.pad(x, widths, constant_values=value)


def mlstm_mixer(qk_in, v_in, o_pre, gates_pre, conv_w, conv_b, gate_b, head_g):
    f32 = jnp.float32
    Bsz, L, _ = qk_in.shape
    qk = jax.nn.silu(dwconv_centred(qk_in.astype(f32), conv_w.astype(f32), conv_b.astype(f32)))
    q, k = jnp.split(qk, 2, axis=-1)
    q = q.reshape(Bsz, L, ML_HEADS, ML_DK).transpose(0, 2, 1, 3) * (ML_DK ** -0.5)
    k = k.reshape(Bsz, L, ML_HEADS, ML_DK).transpose(0, 2, 1, 3)
    v = v_in.astype(f32).reshape(Bsz, L, ML_HEADS, ML_DV).transpose(0, 2, 1, 3)
    gts = (gates_pre.astype(f32) + gate_b.astype(f32)).reshape(Bsz, L, 4, ML_HEADS).transpose(2, 0, 3, 1)
    li_f, lf_f = gts[0], jax.nn.log_sigmoid(gts[1])
    li_b, lf_b = gts[2], jax.nn.log_sigmoid(gts[3])
    qp, kp, vp = (_pad_front(t, META_PAD, 0.0) for t in (q, k, v))
    li_f, li_b = _pad_front(li_f, META_PAD, NEG), _pad_front(li_b, META_PAD, NEG)
    lf_f, lf_b = _pad_front(lf_f, META_PAD, 0.0), _pad_front(lf_b, META_PAD, 0.0)
    flip = lambda t: jnp.flip(t, axis=2)
    h_fwd = mlstm_chunkwise(qp, kp, vp, li_f, lf_f)
    h_bwd = flip(mlstm_chunkwise(flip(qp), flip(kp), flip(vp), flip(li_b), flip(lf_b)))
    h = (h_fwd + h_bwd)[:, :, META_PAD:, :]
    h = h * lax.rsqrt(jnp.mean(h * h, axis=-1, keepdims=True) + EPS) * head_g.astype(f32)[None, :, None, :]
    h = h.transpose(0, 2, 1, 3).reshape(Bsz, L, D_ML)
    return jax.nn.sigmoid(o_pre.astype(f32)) * h


def conv_ffn(x, w_gate, w_up, conv_w, conv_b, w_down):
    gt = dwconv_centred(x @ w_gate, conv_w, conv_b)
    return (jax.nn.silu(gt) * (x @ w_up)) @ w_down


def setup_inputs(seed: int = 0) -> dict:
    key = jax.random.key(seed)
    ks = jax.random.split(key, 32)
    f32 = jnp.float32
    nrm = lambda k, shape, s: jax.random.normal(k, shape, f32) * s
    G, P, H = S5_GROUPS, S5_STATE, S5_GROUP
    a_im0 = jnp.pi * jnp.arange(P, dtype=f32)
    gate_bias = jnp.concatenate([
        jnp.zeros((ML_HEADS,), f32), jnp.linspace(3.0, 6.0, ML_HEADS, dtype=f32),
        jnp.zeros((ML_HEADS,), f32), jnp.linspace(3.0, 6.0, ML_HEADS, dtype=f32)])
    return {
        'x': nrm(ks[0], (BATCH, SEQ, D_MODEL), 1.0),
        'meta': nrm(ks[1], (N_META, D_MODEL), 1.0),
        'norm_mix_g': 1.0 + nrm(ks[2], (DEPTH, D_MODEL), 0.01),
        'w_in': nrm(ks[3], (DEPTH, D_MODEL, D_IN), D_MODEL ** -0.5),
        's5_a_re': -0.5 + nrm(ks[4], (DEPTH, 2, G, P), 0.01),
        's5_a_im': a_im0 + nrm(ks[5], (DEPTH, 2, G, P), 0.01),
        's5_log_dt': jax.random.uniform(ks[6], (DEPTH, 2, G), f32, math.log(1e-3), math.log(1e-1)),
        's5_b_re': nrm(ks[7], (DEPTH, 2, G, P, H), (2 * H) ** -0.5),
        's5_b_im': nrm(ks[8], (DEPTH, 2, G, P, H), (2 * H) ** -0.5),
        's5_c_re': nrm(ks[9], (DEPTH, 2, G, H, P), P ** -0.5),
        's5_c_im': nrm(ks[10], (DEPTH, 2, G, H, P), P ** -0.5),
        's5_d': nrm(ks[11], (DEPTH, G, H), 1.0),
        's5_w_glu': nrm(ks[12], (DEPTH, D_S5, D_S5), D_S5 ** -0.5),
        's5_b_glu': nrm(ks[13], (DEPTH, D_S5), 0.01),
        's5_out_g': 1.0 + nrm(ks[14], (DEPTH, D_S5), 0.01),
        'ml_conv_w': nrm(ks[15], (DEPTH, QK_CONV, C_QK), QK_CONV ** -0.5),
        'ml_conv_b': nrm(ks[16], (DEPTH, C_QK), 0.01),
        'ml_gate_b': gate_bias + nrm(ks[17], (DEPTH, C_GATES), 0.1),
        'ml_head_g': 1.0 + nrm(ks[18], (DEPTH, ML_HEADS, ML_DV), 0.01),
        'w_out': nrm(ks[19], (DEPTH, D_MIX, D_MODEL), D_MIX ** -0.5),
        'norm_ffn_g': 1.0 + nrm(ks[20], (DEPTH, D_MODEL), 0.01),
        'ffn_w_gate': nrm(ks[21], (DEPTH, D_MODEL, D_FF), D_MODEL ** -0.5),
        'ffn_w_up': nrm(ks[22], (DEPTH, D_MODEL, D_FF), D_MODEL ** -0.5),
        'ffn_conv_w': nrm(ks[23], (DEPTH, FFN_CONV, D_FF), FFN_CONV ** -0.5),
        'ffn_conv_b': nrm(ks[24], (DEPTH, D_FF), 0.01),
        'ffn_w_down': nrm(ks[25], (DEPTH, D_FF, D_MODEL), D_FF ** -0.5),
        'final_g': 1.0 + nrm(ks[26], (D_MODEL,), 0.01),
    }


def reference(x, meta, norm_mix_g, w_in, s5_a_re, s5_a_im, s5_log_dt, s5_b_re, s5_b_im,
              s5_c_re, s5_c_im, s5_d, s5_w_glu, s5_b_glu, s5_out_g, ml_conv_w, ml_conv_b,
              ml_gate_b, ml_head_g, w_out, norm_ffn_g, ffn_w_gate, ffn_w_up, ffn_conv_w,
              ffn_conv_b, ffn_w_down, final_g):
    Bsz = x.shape[0]
    dt = x.dtype
    h = jnp.concatenate(
        [jnp.broadcast_to(meta.astype(dt), (Bsz, N_META, D_MODEL)), x], axis=1)
    splits = [D_S5, D_S5 + C_QK, D_S5 + C_QK + D_ML, D_S5 + C_QK + 2 * D_ML]
    for l in range(DEPTH):
        hn = rmsnorm(h, norm_mix_g[l])
        z = hn @ w_in[l]
        u_s5, qk_in, v_in, o_pre, gates_pre = jnp.split(z, splits, axis=-1)
        y_s5 = s5_mixer(u_s5, s5_a_re[l], s5_a_im[l], s5_log_dt[l], s5_b_re[l], s5_b_im[l],
                        s5_c_re[l], s5_c_im[l], s5_d[l], s5_w_glu[l], s5_b_glu[l])
        y_s5 = rmsnorm(y_s5, s5_out_g[l])
        y_ml = mlstm_mixer(qk_in, v_in, o_pre, gates_pre, ml_conv_w[l], ml_conv_b[l],
                           ml_gate_b[l], ml_head_g[l])
        y = jnp.concatenate([y_s5, y_ml], axis=-1).astype(dt)
        h = h + (y @ w_out[l]).astype(dt)
        hn = rmsnorm(h, norm_ffn_g[l])
        h = h + conv_ffn(hn, ffn_w_gate[l], ffn_w_up[l], ffn_conv_w[l], ffn_conv_b[l],
                         ffn_w_down[l]).astype(dt)
    return rmsnorm(h, final_g)[:, N_META:, :]
```

```cpp
#include <hip/hip_runtime.h>
#include <hip/hip_cooperative_groups.h>
#include <cstdio>
namespace cg = cooperative_groups;

#define LAS __attribute__((address_space(3)))
typedef unsigned short bf16_t;
typedef short bf16x8 __attribute__((ext_vector_type(8)));
typedef float f32x4 __attribute__((ext_vector_type(4)));
typedef unsigned u32x4 __attribute__((ext_vector_type(4)));
typedef unsigned u32x2 __attribute__((ext_vector_type(2)));

constexpr int DM = 2048, NB = 8, LP = 2112, PADF = 48, MP = NB * LP;
constexpr int DIN = 4128, DINP = 4352, DFF = 5632, DEPTH = 4;
constexpr int NCH = LP / 16;
constexpr int S5ROWS = NB * NCH;
constexpr int S5ROWP = 1280;
constexpr float EPSN = 1e-6f;
constexpr int LDH = 2112, LDF = 5696, LDG = 1088, LDU = 576, LDWS = 320, LDTO = 576;
constexpr int CV_SPLIT1 = 7075, CV_SPLIT2 = 14150;
constexpr int NPH_L = 6, NPHASES = 2 + DEPTH * NPH_L;

constexpr size_t MiB = 1u << 20;
constexpr size_t WO_WIN = 0 * MiB, WO_WGLU = 18 * MiB, WO_WOUT = 21 * MiB, WO_WGU = 30 * MiB, WO_WDN = 76 * MiB;
constexpr size_t WS_WSET = 1 * MiB;
constexpr size_t WS_WST = 100 * MiB, WS_TO = 140 * MiB, WS_H = 212 * MiB, WS_HN = 344 * MiB + 8192, WS_G = 413 * MiB, WS_Y = 416 * MiB;
constexpr size_t WS_UA = 485 * MiB, WS_Z = 576 * MiB, WS_SLOC = 676 * MiB, WS_YGELU = 676 * MiB, WS_YGLU = 716 * MiB, WS_HFB = 756 * MiB;
constexpr size_t WS_GT = 486 * MiB, WS_ACT = 669 * MiB, WS_SS = 854 * MiB, WS_END = 856 * MiB;
constexpr int LDS_BYTES = 147456;

struct Params { const float* in[27]; float* out; unsigned char* ws; int ph_lo, ph_hi; };

#define LAUNDER_Z() int zz = 0; asm volatile("" : "+s"(zz))
#define PIN(i) (P.in[(i) + zz])
__device__ __forceinline__ int tid_l() { int w = __builtin_amdgcn_readfirstlane(threadIdx.x >> 6); asm volatile("" : "+s"(w)); int ln = __builtin_amdgcn_mbcnt_hi(~0u, __builtin_amdgcn_mbcnt_lo(~0u, 0u)); asm volatile("" : "+v"(ln)); return w * 64 + ln; }
__device__ __forceinline__ int bid_l() { int t = blockIdx.x; asm volatile("" : "+s"(t)); return t; }
__device__ __forceinline__ unsigned cvt_pk_bf16(float lo, float hi) { unsigned r; asm volatile("v_cvt_pk_bf16_f32 %0, %1, %2" : "=v"(r) : "v"(lo), "v"(hi)); return r; }
__device__ __forceinline__ float bf_lo(unsigned w) { return __uint_as_float(w << 16); }
__device__ __forceinline__ float bf_hi(unsigned w) { return __uint_as_float(w & 0xffff0000u); }
__device__ __forceinline__ float bf2f(bf16_t b) { return __uint_as_float((unsigned)b << 16); }
__device__ __forceinline__ bf16_t f2bf(float f) { return (bf16_t)(cvt_pk_bf16(f, 0.f) & 0xffffu); }
__device__ __forceinline__ float sigmoidf_(float x) { return 1.0f / (1.0f + __expf(-x)); }
__device__ __forceinline__ float siluf_(float x) { return x * sigmoidf_(x); }
__device__ __forceinline__ float gelu_tanh(float x) { const float u = 0.7978845608028654f * (x + 0.044715f * x * x * x); const float t = 1.0f - 2.0f / (__expf(2.0f * u) + 1.0f); return 0.5f * x * (1.0f + t); }
__device__ __forceinline__ float shx(float v, int o, int lane) { return __int_as_float(__builtin_amdgcn_ds_bpermute((lane ^ o) << 2, __float_as_int(v))); }
__device__ __forceinline__ float shi(float v, int idx) { return __int_as_float(__builtin_amdgcn_ds_bpermute(idx << 2, __float_as_int(v))); }
__device__ __forceinline__ float wave_sum(float v, int lane) {
#pragma unroll
    for (int o = 1; o < 64; o <<= 1) v += shx(v, o, lane);
    return v;
}
__device__ __forceinline__ float wave_max(float v, int lane) {
#pragma unroll
    for (int o = 1; o < 64; o <<= 1) v = fmaxf(v, shx(v, o, lane));
    return v;
}

constexpr int BM = 256, BK = 64, HALF = 128, HTB = HALF * BK * 2;
__device__ __forceinline__ int lds_byte(int r, int c) { const int st = (r >> 4) * 2 + (c >> 5), rr = r & 15, cc = c & 31, ob = rr * 64 + cc * 2; return st * 1024 + (ob ^ (((ob >> 9) & 1) << 5)); }
__device__ __forceinline__ void stage_rc(int b, int& R, int& C) { const int st = b / 1024, sb = b % 1024, swz = sb ^ (((sb >> 9) & 1) << 5); R = (st >> 1) * 16 + swz / 64; C = (st & 1) * 32 + (swz % 64) / 2; }

struct Unit { int pm, pn, b, piece, tu, k0, nt; };
struct GemmDesc { const bf16_t* A; const bf16_t* Bt; int lda, ldb, K, nM, nN, nB; size_t sA, sB; int epi, layer, ssi, amode, gG, gc, split, ubase, umax, perm; };
enum { EPI_WIN = 0, EPI_S5A = 1, EPI_S5C = 2, EPI_GLU = 3, EPI_RES = 4, EPI_FFN = 5 };

__device__ __forceinline__ bool next_unit(const GemmDesc& d, int i, int G, int c, Unit& u) {
    const int per = d.nM * d.nN; long L = (long)d.ubase + (long)i * G + c; const int ntf = d.K / BK;
    if (L >= d.umax) return false;
    u.piece = -1; u.tu = 0; u.k0 = 0; u.nt = ntf;
    if (d.split > 0) { const int nfull = (per / G) * G;
        if (L >= nfull) { const long q = L - nfull; if (q >= (long)(per - nfull) * d.split) return false;
            u.tu = (int)(q / d.split); u.piece = (int)(q % d.split); u.nt = ntf / d.split; u.k0 = u.piece * u.nt; L = nfull + u.tu; } }
    if (L >= (long)per * d.nB) return false;
    u.b = (int)(L / per); int wgid = (int)(L % per);
    { const int q = per / 8, r = per % 8, xcd = wgid % 8, off = wgid / 8; wgid = (xcd < r ? xcd * (q + 1) : r * (q + 1) + (xcd - r) * q) + off; }
    const int nig = 8 * d.nN, gid = wgid / nig, fm = gid * 8, gsz = (d.nM - fm) < 8 ? (d.nM - fm) : 8;
    u.pm = fm + ((wgid % nig) % gsz); u.pn = (wgid % nig) / gsz; return true;
}

__device__ __forceinline__ void store_bf4(bf16_t* p, f32x4 v) { u32x2 w; w.x = cvt_pk_bf16(v[0], v[1]); w.y = cvt_pk_bf16(v[2], v[3]); *(u32x2*)p = w; }
__device__ __forceinline__ f32x4 load_bf4(const bf16_t* p) { const u32x2 w = *(const u32x2*)p; return (f32x4){bf_lo(w.x), bf_hi(w.x), bf_lo(w.y), bf_hi(w.y)}; }

typedef unsigned long long u64;
constexpr float SSCALE = 16777216.0f;
__device__ __forceinline__ float row_rs(const u64* ss, int r) { return rsqrtf((float)ss[r] * (1.0f / SSCALE) * (1.0f / DM) + EPSN); }
__device__ __forceinline__ void gemm_epilogue(const Params& P, const GemmDesc& d, const f32x4 (&acc)[2][2][4][2], const Unit& u, int wr, int wc, int fr, int fq) {
    LAUNDER_Z(); unsigned char* ws = P.ws + zz; const int l = d.layer;
    int lane;
    { const int t2 = tid_l(); const int w2 = __builtin_amdgcn_readfirstlane(t2 >> 6); wr = w2 >> 2; wc = w2 & 3; lane = t2 & 63; fr = lane & 15; fq = lane >> 4; }
    const int rbase = u.pm * BM + wr * 64 + fr, cbase = u.pn * BM + wc * 32 + 4 * fq;
    if (d.epi == EPI_RES) {
        const int cb8 = u.pn * BM + wc * 32 + 8 * fq;
        float* hb = (float*)(ws + WS_H) + (size_t)rbase * DM + cb8; bf16_t* nb = (bf16_t*)(ws + WS_HN) + (size_t)rbase * LDH + cb8;
        u64* ssp = (u64*)(ws + WS_SS) + (size_t)d.ssi * MP + rbase;
#pragma unroll
        for (int ai = 0; ai < 2; ++ai)
#pragma unroll
        for (int mh = 0; mh < 2; ++mh) {
            f32x4 t[2][2][2];
            float* hp = hb + (size_t)(ai * HALF + mh * 32) * DM; asm volatile("" : "+v"(hp));
#pragma unroll
            for (int m = 0; m < 2; ++m)
#pragma unroll
                for (int bj = 0; bj < 2; ++bj)
#pragma unroll
                    for (int n = 0; n < 2; ++n) t[m][bj][n] = __builtin_nontemporal_load((const f32x4*)(hp + (size_t)(m * 16) * DM + bj * HALF + n * 4));
            float sq[2] = {0.f, 0.f};
#pragma unroll
            for (int m = 0; m < 2; ++m)
#pragma unroll
                for (int bj = 0; bj < 2; ++bj)
#pragma unroll
                    for (int n = 0; n < 2; ++n) { const f32x4 hv = t[m][bj][n] + acc[ai][bj][mh * 2 + m][n]; t[m][bj][n] = hv;
                        __builtin_nontemporal_store(hv, (f32x4*)(hp + (size_t)(m * 16) * DM + bj * HALF + n * 4));
                        sq[m] += (hv[0] * hv[0] + hv[1] * hv[1]) + (hv[2] * hv[2] + hv[3] * hv[3]); }
            bf16_t* np = nb + (size_t)(ai * HALF + mh * 32) * LDH; asm volatile("" : "+v"(np));
#pragma unroll
            for (int m = 0; m < 2; ++m) {
#pragma unroll
                for (int bj = 0; bj < 2; ++bj) { u32x4 o; o.x = cvt_pk_bf16(t[m][bj][0][0], t[m][bj][0][1]); o.y = cvt_pk_bf16(t[m][bj][0][2], t[m][bj][0][3]); o.z = cvt_pk_bf16(t[m][bj][1][0], t[m][bj][1][1]); o.w = cvt_pk_bf16(t[m][bj][1][2], t[m][bj][1][3]);
                    *(u32x4*)(np + (size_t)(m * 16) * LDH + bj * HALF) = o; }
                float q = sq[m]; q += shx(q, 16, lane); q += shx(q, 32, lane);
                if (fq == 0) atomicAdd(ssp + ai * HALF + mh * 32 + m * 16, (u64)(q * SSCALE));
            }
        }
        return;
    }
    if (d.epi == EPI_FFN) {
        const int ccol = u.pn * 128 + wc * 32 + 8 * fq;
        const float* cwb = PIN(23) + (size_t)l * 3 * DFF + ccol; const float* cbb = PIN(24) + (size_t)l * DFF + ccol;
        const u64* ssb = (const u64*)(ws + WS_SS) + (size_t)d.ssi * MP;
#pragma unroll
        for (int ai = 0; ai < 2; ++ai) {
            const int row0 = u.pm * 248 + (ai * 2 + wr) * 62 - 1 + fr;
            float rsv[4];
#pragma unroll
            for (int m = 0; m < 4; ++m) { int rc = row0 + m * 16; rc = rc < 0 ? 0 : (rc > MP - 1 ? MP - 1 : rc); rsv[m] = row_rs(ssb, rc); }
            bf16_t* ab = (bf16_t*)(ws + WS_ACT) + (size_t)row0 * LDF + ccol;
            u32x2 keep[4];
#pragma unroll
            for (int n = 0; n < 2; ++n) {
                const f32x4 w0 = *(const f32x4*)(cwb + n * 4), w1 = *(const f32x4*)(cwb + DFF + n * 4), w2 = *(const f32x4*)(cwb + 2 * DFF + n * 4), cb = *(const f32x4*)(cbb + n * 4);
                f32x4 X[4], RR[4], RL[4];
#pragma unroll
                for (int m = 0; m < 4; ++m) { X[m] = acc[ai][0][m][n] * rsv[m];
#pragma unroll
                    for (int j = 0; j < 4; ++j) { RR[m][j] = __int_as_float(__builtin_amdgcn_update_dpp(0, __float_as_int(X[m][j]), 0x121, 0xf, 0xf, false));
                                                  RL[m][j] = __int_as_float(__builtin_amdgcn_update_dpp(0, __float_as_int(X[m][j]), 0x12f, 0xf, 0xf, false)); } }
#pragma unroll
                for (int m = 0; m < 4; ++m) {
                    const f32x4 prev = (fr > 0) ? RR[m] : RR[m > 0 ? m - 1 : 0];
                    const f32x4 next = (fr < 15) ? RL[m] : RL[m < 3 ? m + 1 : 3];
                    const f32x4 gt = cb + w0 * prev + w1 * X[m] + w2 * next; const f32x4 v = acc[ai][1][m][n] * rsv[m];
                    const int lr = m * 16 + fr, row = row0 + m * 16;
                    u32x2 pk; pk.x = cvt_pk_bf16(siluf_(gt[0]) * v[0], siluf_(gt[1]) * v[1]); pk.y = cvt_pk_bf16(siluf_(gt[2]) * v[2], siluf_(gt[3]) * v[3]);
                    if (n == 0) keep[m] = pk;
                    else if (lr >= 1 && lr <= 62 && row < MP) { u32x4 o; o.x = keep[m].x; o.y = keep[m].y; o.z = pk.x; o.w = pk.y; __builtin_nontemporal_store(o, (u32x4*)(ab + (size_t)(m * 16) * LDF)); } }
            }
        }
        return;
    }
    if (d.epi == EPI_GLU) {
        const int c8 = u.pn * BM + wc * 32 + 8 * fq;
        const bf16_t* yb = (const bf16_t*)(ws + WS_YGELU) + (size_t)rbase * LDG + c8; bf16_t* ob = (bf16_t*)(ws + WS_YGLU) + (size_t)rbase * 1024 + c8;
        const float* bb = PIN(13) + (size_t)l * 1024 + c8;
#pragma unroll
        for (int bj = 0; bj < 2; ++bj) {
            f32x4 bg[2];
#pragma unroll
            for (int n = 0; n < 2; ++n) bg[n] = *(const f32x4*)(bb + bj * HALF + n * 4);
#pragma unroll
            for (int ai = 0; ai < 2; ++ai) {
                u32x4 y[4];
                const bf16_t* yq = yb + (size_t)(ai * HALF) * LDG + bj * HALF; asm volatile("" : "+v"(yq));
#pragma unroll
                for (int m = 0; m < 4; ++m) y[m] = *(const u32x4*)(yq + (size_t)(m * 16) * LDG);
#pragma unroll
                for (int m = 0; m < 4; ++m) { const f32x4 v0 = acc[ai][bj][m][0] + bg[0], v1 = acc[ai][bj][m][1] + bg[1]; const u32x4 yy = y[m]; u32x4 o;
                    o.x = cvt_pk_bf16(bf_lo(yy.x) * sigmoidf_(v0[0]), bf_hi(yy.x) * sigmoidf_(v0[1])); o.y = cvt_pk_bf16(bf_lo(yy.y) * sigmoidf_(v0[2]), bf_hi(yy.y) * sigmoidf_(v0[3]));
                    o.z = cvt_pk_bf16(bf_lo(yy.z) * sigmoidf_(v1[0]), bf_hi(yy.z) * sigmoidf_(v1[1])); o.w = cvt_pk_bf16(bf_lo(yy.w) * sigmoidf_(v1[2]), bf_hi(yy.w) * sigmoidf_(v1[3]));
                    *(u32x4*)(ob + (size_t)(ai * HALF + m * 16) * 1024 + bj * HALF) = o; }
            }
        }
        return;
    }
    if (d.epi == EPI_S5C) {
#pragma unroll
        for (int ai = 0; ai < 2; ++ai)
#pragma unroll
        for (int m = 0; m < 4; ++m) {
            const int r = rbase + ai * HALF + m * 16;
            if (r < S5ROWS) { const int b = r / NCH, nn = r - b * NCH;
#pragma unroll
                for (int bj = 0; bj < 2; ++bj) { const int c8 = bj * HALF + wc * 32 + 8 * fq, tl = c8 >> 4, ch = c8 & 15; const size_t row = (size_t)b * LP + nn * 16 + tl;
                    const f32x4 v0 = acc[ai][bj][m][0], v1 = acc[ai][bj][m][1]; u32x4 o;
                    o.x = cvt_pk_bf16(gelu_tanh(v0[0]), gelu_tanh(v0[1])); o.y = cvt_pk_bf16(gelu_tanh(v0[2]), gelu_tanh(v0[3])); o.z = cvt_pk_bf16(gelu_tanh(v1[0]), gelu_tanh(v1[1])); o.w = cvt_pk_bf16(gelu_tanh(v1[2]), gelu_tanh(v1[3]));
                    *(u32x4*)((bf16_t*)(ws + WS_YGELU) + row * LDG + u.b * 16 + ch) = o; } }
        }
        return;
    }
    if (d.epi == EPI_WIN) {
        const u64* ssb = (const u64*)(ws + WS_SS) + (size_t)d.ssi * MP;
#pragma unroll
        for (int ai = 0; ai < 2; ++ai)
#pragma unroll
        for (int m = 0; m < 4; ++m) {
            const int r = rbase + ai * HALF + m * 16; const float rsc = row_rs(ssb, r);
#pragma unroll
            for (int bj = 0; bj < 2; ++bj) {
                const int c8 = u.pn * BM + bj * HALF + wc * 32 + 8 * fq;
                const f32x4 v0 = acc[ai][bj][m][0] * rsc, v1 = acc[ai][bj][m][1] * rsc;
                if (u.pn < 16) { u32x4 o; o.x = cvt_pk_bf16(v0[0], v0[1]); o.y = cvt_pk_bf16(v0[2], v0[3]); o.z = cvt_pk_bf16(v1[0], v1[1]); o.w = cvt_pk_bf16(v1[2], v1[3]);
                    if (u.pn < 4) { const int g = c8 >> 4, ch = c8 & 15, b = r / LP, pos = r - b * LP, cr = b * NCH + (pos >> 4), tl = pos & 15;
                        __builtin_nontemporal_store(o, (u32x4*)((bf16_t*)(ws + WS_UA) + ((size_t)g * S5ROWP + cr) * LDU + tl * 16 + ch)); }
                    else __builtin_nontemporal_store(o, (u32x4*)((bf16_t*)(ws + WS_Z) + (size_t)r * 3072 + (c8 - 1024))); }
                else if (c8 - 4096 < 32) { float* gp = (float*)(ws + WS_G) + (size_t)r * 32 + (c8 - 4096); *(f32x4*)gp = v0; *(f32x4*)(gp + 4) = v1; }
            }
        }
        return;
    }
#pragma unroll
    for (int ai = 0; ai < 2; ++ai)
#pragma unroll
    for (int m = 0; m < 4; ++m) {
        const int r = rbase + ai * HALF + m * 16;
        const float rsc = (d.epi == EPI_WIN) ? row_rs((const u64*)(ws + WS_SS) + (size_t)d.ssi * MP, r) : 1.0f;
#pragma unroll
        for (int bj = 0; bj < 2; ++bj)
#pragma unroll
        for (int n = 0; n < 2; ++n) {
            const int c0 = cbase + bj * HALF + n * 16;
            const f32x4 v = acc[ai][bj][m][n] * rsc;
            switch (d.epi) {
            case EPI_WIN: {
                if (u.pn < 4) { const int g = c0 >> 4, ch = c0 & 15, b = r / LP, pos = r - b * LP, cr = b * NCH + (pos >> 4), tl = pos & 15;
                    store_bf4((bf16_t*)(ws + WS_UA) + ((size_t)g * S5ROWP + cr) * LDU + tl * 16 + ch, v); }
                else if (u.pn < 16) store_bf4((bf16_t*)(ws + WS_Z) + (size_t)r * 3072 + (c0 - 1024), v);
                else if (c0 - 4096 < 32) *(f32x4*)((float*)(ws + WS_G) + (size_t)r * 32 + (c0 - 4096)) = v;
            } break;
            case EPI_S5A: *(f32x4*)((float*)(ws + WS_SLOC) + ((size_t)u.b * S5ROWP + r) * 256 + c0) = v; break;
            case EPI_S5C: {
                if (r < S5ROWS) { const int b = r / NCH, nn = r - b * NCH, tl = c0 >> 4, ch = c0 & 15; const size_t row = (size_t)b * LP + nn * 16 + tl;
                    store_bf4((bf16_t*)(ws + WS_YGELU) + row * LDG + u.b * 16 + ch, (f32x4){gelu_tanh(v[0]), gelu_tanh(v[1]), gelu_tanh(v[2]), gelu_tanh(v[3])}); }
            } break;
            default: break;
            }
        }
    }
}

__device__ __forceinline__ void gemm_phase(const Params& P, LAS unsigned char* lds, const GemmDesc d) {
    const int tid = tid_l(), wid = __builtin_amdgcn_readfirstlane(tid >> 6), lane = tid & 63, wr = wid >> 2, wc = wid & 3, fr = lane & 15, fq = lane >> 4;
    const int K = d.K, nt = K / BK; const int G = d.gG, cblk = d.gc;
    unsigned voffA[2], voffB[2];
#pragma unroll
    for (int i = 0; i < 2; ++i) { int R, C; stage_rc(tid * 16 + i * 8192, R, C); const int Ra = (d.amode && R >= 64) ? R - 2 : R; voffA[i] = (unsigned)(Ra * d.lda + C) * 2u; const int Rb = d.perm ? ((R & ~31) + 8 * ((R & 15) >> 2) + 4 * ((R & 31) >> 4) + (R & 3)) : R; voffB[i] = (unsigned)(Rb * d.ldb + C) * 2u; }
    const size_t kstep = (size_t)(BK * 2);
    const size_t hstepA = (size_t)(d.amode ? 124 : HALF) * d.lda * 2, hstepB = (size_t)HALF * d.ldb * 2;
    const unsigned ldsw = (unsigned)wid * 1024u;
    const int aoff = lds_byte(wr * 64 + fr, fq * 8), boff = lds_byte(wc * 32 + fr, fq * 8);
#define PG8_SA(b, h) (((b) * 2 + (h)) * HTB)
#define PG8_SB(b, h) ((4 + (b) * 2 + (h)) * HTB)
#define PG8_STAGE(bufoff, gbase, voff) do { _Pragma("unroll") for (int _i = 0; _i < 2; ++_i) \
        __builtin_amdgcn_global_load_lds((const unsigned*)((const char*)(gbase) + (voff)[_i]), (LAS unsigned*)(lds + (bufoff) + ldsw + _i * 8192), 16, 0, 0); } while (0)
#define PG8_LDA(dst, b, h) do { _Pragma("unroll") for (int m = 0; m < 4; ++m) _Pragma("unroll") for (int k = 0; k < 2; ++k) dst[m][k] = *(const LAS bf16x8*)(lds + PG8_SA(b, h) + aoff + m * 2048 + k * 1024); } while (0)
#define PG8_LDB(dst, b, h) do { _Pragma("unroll") for (int n = 0; n < 2; ++n) _Pragma("unroll") for (int k = 0; k < 2; ++k) dst[n][k] = *(const LAS bf16x8*)(lds + PG8_SB(b, h) + boff + n * 2048 + k * 1024); } while (0)
#define PG8_MMA(ai, bj, At, Bt) do { __builtin_amdgcn_s_setprio(1); _Pragma("unroll") for (int m = 0; m < 4; ++m) _Pragma("unroll") for (int n = 0; n < 2; ++n) _Pragma("unroll") for (int k = 0; k < 2; ++k) \
        acc[ai][bj][m][n] = __builtin_amdgcn_mfma_f32_16x16x32_bf16(Bt[n][k], At[m][k], acc[ai][bj][m][n], 0, 0, 0); __builtin_amdgcn_s_setprio(0); } while (0)
#define PG8_WAIT_V(n) asm volatile("s_waitcnt vmcnt(" #n ")" ::: "memory")
#define PG8_WAIT_L(n) asm volatile("s_waitcnt lgkmcnt(" #n ")" ::: "memory")
#define PG8_BAR __builtin_amdgcn_s_barrier()
#define PG8_SCHED __builtin_amdgcn_sched_barrier(0)
    Unit cur, nxt; int ui = 0;
    if (!next_unit(d, 0, G, cblk, cur)) return;
    f32x4 acc[2][2][4][2];
#pragma unroll
    for (int a = 0; a < 2; ++a)
#pragma unroll
        for (int b = 0; b < 2; ++b)
#pragma unroll
            for (int m = 0; m < 4; ++m)
#pragma unroll
                for (int n = 0; n < 2; ++n) acc[a][b][m][n] = (f32x4){0.f, 0.f, 0.f, 0.f};
    bf16x8 At[4][2], B0[2][2], B1[2][2];
    const char* cA = (const char*)d.A + ((size_t)cur.b * d.sA) * 2 + (size_t)cur.pm * 2 * hstepA + (size_t)cur.k0 * kstep;
    const char* cB = (const char*)d.Bt + ((size_t)cur.b * d.sB) * 2 + (size_t)cur.pn * 2 * hstepB + (size_t)cur.k0 * kstep;
    PG8_STAGE(PG8_SB(0, 0), cB, voffB); PG8_STAGE(PG8_SA(0, 0), cA, voffA); PG8_STAGE(PG8_SB(0, 1), cB + hstepB, voffB); PG8_STAGE(PG8_SA(0, 1), cA + hstepA, voffA);
    if (wr == 1) PG8_BAR;
    PG8_WAIT_V(4); PG8_BAR;
    PG8_STAGE(PG8_SB(1, 0), cB + kstep, voffB); PG8_STAGE(PG8_SA(1, 0), cA + kstep, voffA); PG8_STAGE(PG8_SB(1, 1), cB + hstepB + kstep, voffB);
    PG8_WAIT_V(6); PG8_BAR;
    for (;;) {
        const bool has_next = next_unit(d, ui + 1, G, cblk, nxt);
        const char* nA = has_next ? (const char*)d.A + ((size_t)nxt.b * d.sA) * 2 + (size_t)nxt.pm * 2 * hstepA + (size_t)nxt.k0 * kstep : cA;
        const char* nB = has_next ? (const char*)d.Bt + ((size_t)nxt.b * d.sB) * 2 + (size_t)nxt.pn * 2 * hstepB + (size_t)nxt.k0 * kstep : cB;
        const int ntu = cur.nt;
        for (int t = 0; t < ntu; t += 2) {
            const bool last = (t == ntu - 2);
            const char* a1 = cA + (size_t)(t + 1) * kstep;
            const char* a2 = last ? nA : cA + (size_t)(t + 2) * kstep; const char* b2 = last ? nB : cB + (size_t)(t + 2) * kstep;
            const char* a3 = a2 + kstep; const char* b3 = b2 + kstep;
            PG8_LDB(B0, 0, 0); PG8_SCHED; PG8_LDA(At, 0, 0); PG8_STAGE(PG8_SA(1, 1), a1 + hstepA, voffA);
            PG8_WAIT_L(8); PG8_BAR; PG8_WAIT_L(0); PG8_MMA(0, 0, At, B0); PG8_BAR; PG8_SCHED;
            PG8_LDB(B1, 0, 1); PG8_STAGE(PG8_SB(0, 0), b2, voffB);
            PG8_BAR; PG8_WAIT_L(0); PG8_MMA(0, 1, At, B1); PG8_BAR;
            PG8_LDA(At, 0, 1); PG8_STAGE(PG8_SA(0, 0), a2, voffA);
            PG8_BAR; PG8_WAIT_L(0); PG8_MMA(1, 0, At, B0); PG8_BAR; PG8_SCHED;
            PG8_STAGE(PG8_SB(0, 1), b2 + hstepB, voffB);
            PG8_WAIT_V(6); PG8_BAR; PG8_MMA(1, 1, At, B1); PG8_BAR;
            PG8_LDB(B0, 1, 0); PG8_SCHED; PG8_LDA(At, 1, 0); PG8_STAGE(PG8_SA(0, 1), a2 + hstepA, voffA);
            PG8_WAIT_L(8); PG8_BAR; PG8_WAIT_L(0); PG8_MMA(0, 0, At, B0); PG8_BAR; PG8_SCHED;
            PG8_LDB(B1, 1, 1); PG8_STAGE(PG8_SB(1, 0), b3, voffB);
            PG8_BAR; PG8_WAIT_L(0); PG8_MMA(0, 1, At, B1); PG8_BAR;
            PG8_LDA(At, 1, 1); PG8_STAGE(PG8_SA(1, 0), a3, voffA);
            PG8_BAR; PG8_WAIT_L(0); PG8_MMA(1, 0, At, B0); PG8_BAR; PG8_SCHED;
            PG8_STAGE(PG8_SB(1, 1), b3 + hstepB, voffB);
            PG8_WAIT_V(6); PG8_BAR; PG8_MMA(1, 1, At, B1); PG8_BAR;
        }
        bool do_epi = true;
        if (cur.piece >= 0) {
            LAUNDER_Z();
            const int t3 = tid_l(); const int w3 = __builtin_amdgcn_readfirstlane(t3 >> 6), l3 = t3 & 63;
            const size_t pstride = (size_t)8 * 32 * 64;
            f32x4* slab = (f32x4*)(P.ws + zz + WS_UA) + ((size_t)(cur.tu * d.split) * 8 + w3) * 32 * 64 + l3;
            {   f32x4* mine = slab + (size_t)cur.piece * pstride;
#pragma unroll
                for (int idx = 0; idx < 32; ++idx) { asm volatile("global_store_dwordx4 %0, %1, off sc1\n\ts_nop 1" :: "v"(mine), "v"(acc[idx >> 4][(idx >> 3) & 1][(idx >> 1) & 3][idx & 1]) : "memory"); mine += 64; } }
            asm volatile("s_waitcnt vmcnt(0)" ::: "memory");
            unsigned old = 0u;
            if (l3 == 0) old = __hip_atomic_fetch_add((unsigned*)(P.ws + zz) + 8192 + cur.tu * 8 + w3, 1u, __ATOMIC_RELAXED, __HIP_MEMORY_SCOPE_AGENT);
            old = (unsigned)__builtin_amdgcn_readfirstlane((int)old);
            do_epi = ((old % (unsigned)d.split) == (unsigned)d.split - 1u);
            if (do_epi) {
                __builtin_amdgcn_fence(__ATOMIC_ACQUIRE, "agent");
                asm volatile("s_waitcnt vmcnt(0)" ::: "memory");
                const f32x4* p = slab;
#pragma unroll
                for (int i4 = 0; i4 < 8; ++i4) { f32x4 t4[4][4];
#pragma unroll
                    for (int j = 0; j < 4; ++j) { asm volatile("" : "+v"(p));
#pragma unroll
                        for (int q = 0; q < 4; ++q) t4[j][q] = p[(size_t)q * pstride];
                        p += 64; }
#pragma unroll
                    for (int j = 0; j < 4; ++j) { const int idx = i4 * 4 + j; acc[idx >> 4][(idx >> 3) & 1][(idx >> 1) & 3][idx & 1] = ((t4[j][0] + t4[j][1]) + t4[j][2]) + t4[j][3]; } }
            }
        }
        if (do_epi) gemm_epilogue(P, d, acc, cur, wr, wc, fr, fq);
        if (!has_next) break;
#pragma unroll
        for (int a = 0; a < 2; ++a)
#pragma unroll
            for (int b = 0; b < 2; ++b)
#pragma unroll
                for (int m = 0; m < 4; ++m)
#pragma unroll
                    for (int n = 0; n < 2; ++n) acc[a][b][m][n] = (f32x4){0.f, 0.f, 0.f, 0.f};
        cur = nxt; cA = nA; cB = nB; ++ui;
    }
    PG8_WAIT_V(0);
    if (wr == 0) PG8_BAR;
    PG8_BAR;
#undef PG8_SA
#undef PG8_SB
#undef PG8_STAGE
#undef PG8_LDA
#undef PG8_LDB
#undef PG8_MMA
#undef PG8_WAIT_V
#undef PG8_WAIT_L
#undef PG8_BAR
#undef PG8_SCHED
}

__device__ __forceinline__ void transpose_item(const float* W, int K, int N, bf16_t* WT, int ldw, LAS float* scr, int item, int lane, const float* gsc, int rowmap = 0) {
    const int nblk = N / 32, kb = item / nblk, nb = item % nblk, k0 = 64 * kb, n0 = 32 * nb;
    float wv[32];
#pragma unroll
    for (int i = 0; i < 32; ++i) { const int kk = 2 * i + (lane >> 5); wv[i] = W[(size_t)(k0 + kk) * N + n0 + (lane & 31)]; }
#pragma unroll
    for (int i = 0; i < 32; ++i) { const int kk = 2 * i + (lane >> 5); const float gg = gsc ? gsc[k0 + kk] : 1.0f; scr[kk * 33 + (lane & 31)] = wv[i] * gg; }
    asm volatile("s_waitcnt lgkmcnt(0)" ::: "memory");
    const int c = lane & 7;
#pragma unroll
    for (int j = 0; j < 4; ++j) { const int n = (lane >> 3) + 8 * j; const LAS float* s = scr + (8 * c) * 33 + n;
        u32x4 o; o.x = cvt_pk_bf16(s[0 * 33], s[1 * 33]); o.y = cvt_pk_bf16(s[2 * 33], s[3 * 33]); o.z = cvt_pk_bf16(s[4 * 33], s[5 * 33]); o.w = cvt_pk_bf16(s[6 * 33], s[7 * 33]);
        const int nr = n0 + n; const int dr = rowmap ? ((nr >> 7) * 256 + (nr & 127) + (rowmap == 2 ? 128 : 0)) : nr;
        *(u32x4*)(WT + (size_t)dr * ldw + k0 + 8 * c) = o; }
    asm volatile("s_waitcnt lgkmcnt(0)" ::: "memory");
}

__device__ __forceinline__ void norm_row_bf16(const float* hrow, const float* g, bf16_t* orow, int lane, bool pad) {
    u32x2* o8 = (u32x2*)orow + lane;
    if (pad) {
#pragma unroll
        for (int j = 0; j < 8; ++j) o8[64 * j] = (u32x2){0u, 0u};
        return; }
    const f32x4* xr = (const f32x4*)hrow + lane; const f32x4* gr = (const f32x4*)g + lane;
    f32x4 v[8]; float s = 0.f;
#pragma unroll
    for (int j = 0; j < 8; ++j) { v[j] = xr[64 * j]; s += (v[j][0] * v[j][0] + v[j][1] * v[j][1]) + (v[j][2] * v[j][2] + v[j][3] * v[j][3]); }
    const float rs = rsqrtf(wave_sum(s, lane) * (1.0f / DM) + EPSN);
#pragma unroll
    for (int j = 0; j < 8; ++j) { const f32x4 gg = gr[64 * j]; u32x2 w; w.x = cvt_pk_bf16(v[j][0] * rs * gg[0], v[j][1] * rs * gg[1]); w.y = cvt_pk_bf16(v[j][2] * rs * gg[2], v[j][3] * rs * gg[3]); o8[64 * j] = w; }
}

__device__ __forceinline__ void zero_rows16(void* p, int n16, int gt, int NGT) { unsigned z0 = 0u; asm volatile("" : "+v"(z0)); u32x4* z = (u32x4*)p; for (int i = gt; i < n16; i += NGT) z[i] = (u32x4){z0, z0, z0, z0}; }
__device__ __forceinline__ void phase_init_rows(const Params& P) {
    LAUNDER_Z();
    const int lane = tid_l() & 63, gw = bid_l() * 8 + (tid_l() >> 6), NGW = gridDim.x * 8;
    float* H = (float*)(P.ws + zz + WS_H); bf16_t* HN = (bf16_t*)(P.ws + zz + WS_HN); u64* SS = (u64*)(P.ws + zz + WS_SS);
    float zf = 0.f; asm volatile("" : "+v"(zf));
    for (int r = gw; r < MP; r += NGW) {
        const int b = r / LP, pos = r - b * LP; f32x4* o = (f32x4*)(H + (size_t)r * DM) + lane; u32x2* o8 = (u32x2*)(HN + (size_t)r * LDH) + lane;
        if (pos < PADF) {
#pragma unroll
            for (int j = 0; j < 8; ++j) { o[64 * j] = (f32x4){zf, zf, zf, zf}; o8[64 * j] = (u32x2){__float_as_uint(zf), __float_as_uint(zf)}; }
            if (lane == 0) SS[r] = (u64)__float_as_uint(zf);
        } else {
            const float* src = pos < 64 ? PIN(1) + (size_t)(pos - PADF) * DM : PIN(0) + ((size_t)b * 2048 + (pos - 64)) * DM;
            const f32x4* s4 = (const f32x4*)src + lane; float sq = 0.f;
#pragma unroll
            for (int j = 0; j < 8; ++j) { const f32x4 v = s4[64 * j]; o[64 * j] = v; u32x2 w; w.x = cvt_pk_bf16(v[0], v[1]); w.y = cvt_pk_bf16(v[2], v[3]); o8[64 * j] = w; sq += (v[0] * v[0] + v[1] * v[1]) + (v[2] * v[2] + v[3] * v[3]); }
            sq = wave_sum(sq, lane); if (lane == 0) SS[r] = (u64)(sq * SSCALE);
        }
    }
    const int gt = bid_l() * 512 + tid_l(), NGT = gridDim.x * 512;
    for (int i = gt; i < 8 * MP; i += NGT) SS[MP + i] = (u64)__float_as_uint(zf);
    zero_rows16((bf16_t*)(P.ws + zz + WS_HN) - LDH, LDH / 8, gt, NGT); zero_rows16((bf16_t*)(P.ws + zz + WS_HN) + (size_t)MP * LDH, 256 * LDH / 8, gt, NGT);
    zero_rows16((bf16_t*)(P.ws + zz + WS_WSET + WO_WIN) + (size_t)DIN * LDH, (DINP - DIN) * LDH / 8, gt, NGT);
    zero_rows16((bf16_t*)((unsigned char*)P.out + zz + WO_WIN) + (size_t)DIN * LDH, (DINP - DIN) * LDH / 8, gt, NGT);
}

__device__ __forceinline__ void s5_precompute(const Params& P, LAS unsigned char* lds, int l, int g) {
    LAS float* lpr = (LAS float*)lds;
    LAS float* lpi = lpr + 2 * 17 * 64;
    LAS float* bbr = lpi + 2 * 17 * 64;
    LAS float* bbi = bbr + 2048;
    LAS float* ccr = bbi + 2048;
    LAS float* cci = ccr + 2048;
    LAS float* zr = cci + 2048;
    LAS float* zi = zr + 128;
    LAS float* kd = zi + 128;
    LAUNDER_Z();
    const int tid = tid_l();
    if (tid < 128) {
        const int dir = tid >> 6, p = tid & 63; const size_t o = ((size_t)(l * 2 + dir) * 64 + g) * 64 + p;
        const float are = fminf(PIN(4)[o], -1e-4f), aim = PIN(5)[o], dt = expf(PIN(6)[(size_t)(l * 2 + dir) * 64 + g]);
        const float mag = expf(are * dt); float sn, cs; sincosf(aim * dt, &sn, &cs); const float lr = mag * cs, li = mag * sn;
        { float pr = 1.0f, pi = 0.0f;
          for (int dd = 0; dd <= 16; ++dd) { lpr[(dir * 17 + dd) * 64 + p] = pr; lpi[(dir * 17 + dd) * 64 + p] = pi; const float nr = pr * lr - pi * li, ni = pr * li + pi * lr; pr = nr; pi = ni; } }
        const float den = are * are + aim * aim, pp = lr - 1.0f;
        zr[dir * 64 + p] = (pp * are + li * aim) / den; zi[dir * 64 + p] = (li * are - pp * aim) / den;
    }
    __syncthreads();
    for (int e = tid; e < 2048; e += 512) { const int dir = e >> 10, p = (e >> 4) & 63, h = e & 15; const size_t o = (((size_t)(l * 2 + dir) * 64 + g) * 64 + p) * 16 + h;
        const float br = PIN(7)[o], bi = PIN(8)[o], z_r = zr[dir * 64 + p], z_i = zi[dir * 64 + p];
        bbr[e] = z_r * br - z_i * bi; bbi[e] = z_r * bi + z_i * br; }
    for (int e = tid; e < 2048; e += 512) { const int dir = e >> 10, h = (e >> 6) & 15, p = e & 63; const size_t o = (((size_t)(l * 2 + dir) * 64 + g) * 16 + h) * 64 + p;
        ccr[e] = PIN(9)[o]; cci[e] = PIN(10)[o]; }
    __syncthreads();
    for (int e = tid; e < 8192; e += 512) { const int dir = e >> 12, dd = (e >> 8) & 15, h = (e >> 4) & 15, h2 = e & 15; float s = 0.f;
        for (int p = 0; p < 64; ++p) { const float cr = ccr[(dir * 16 + h) * 64 + p], ci = cci[(dir * 16 + h) * 64 + p], lr = lpr[(dir * 17 + dd) * 64 + p], li = lpi[(dir * 17 + dd) * 64 + p];
            const float ur = cr * lr - ci * li, ui = cr * li + ci * lr; s += ur * bbr[(dir * 64 + p) * 16 + h2] - ui * bbi[(dir * 64 + p) * 16 + h2]; }
        kd[e] = s; }
    __syncthreads();
    bf16_t* WST = (bf16_t*)(P.ws + zz + WS_WST) + ((size_t)l * 64 + g) * (256 * LDWS);
    for (int e8 = tid; e8 < 8192; e8 += 512) { const int n = e8 >> 5, k0 = (e8 & 31) * 8; const int part = n >> 6, p = n & 63, dir = part >> 1; float v[8];
#pragma unroll
        for (int j = 0; j < 8; ++j) { const int k = k0 + j, s = k >> 4, h2 = k & 15, pw = dir == 0 ? 15 - s : s; const float lr = lpr[(dir * 17 + pw) * 64 + p], li = lpi[(dir * 17 + pw) * 64 + p], br = bbr[(dir * 64 + p) * 16 + h2], bi = bbi[(dir * 64 + p) * 16 + h2];
            v[j] = (part & 1) ? (lr * bi + li * br) : (lr * br - li * bi); }
        u32x4 o; o.x = cvt_pk_bf16(v[0], v[1]); o.y = cvt_pk_bf16(v[2], v[3]); o.z = cvt_pk_bf16(v[4], v[5]); o.w = cvt_pk_bf16(v[6], v[7]);
        *(u32x4*)(WST + (size_t)n * LDWS + k0) = o; }
    bf16_t* TO = (bf16_t*)(P.ws + zz + WS_TO) + ((size_t)l * 64 + g) * (256 * LDTO);
    const float* dsk = PIN(11) + ((size_t)l * 64 + g) * 16;
    for (int e8 = tid; e8 < 16384; e8 += 512) { const int n = e8 >> 6, k0 = (e8 & 63) * 8; const int t = n >> 4, h = n & 15; float v[8];
#pragma unroll
        for (int j = 0; j < 8; ++j) { const int k = k0 + j;
            if (k < 256) { const int s = k >> 4, h2 = k & 15;
                if (t > s) v[j] = kd[((0 * 16 + (t - s)) * 16 + h) * 16 + h2];
                else if (t < s) v[j] = kd[((1 * 16 + (s - t)) * 16 + h) * 16 + h2];
                else v[j] = kd[((0 * 16 + 0) * 16 + h) * 16 + h2] + kd[((1 * 16 + 0) * 16 + h) * 16 + h2] + (h == h2 ? dsk[h] : 0.f);
            } else { const int kk = k - 256, part = kk >> 6, p = kk & 63, dir = part >> 1, pw = dir == 0 ? t + 1 : 16 - t;
                const float cr = ccr[(dir * 16 + h) * 64 + p], ci = cci[(dir * 16 + h) * 64 + p], lr = lpr[(dir * 17 + pw) * 64 + p], li = lpi[(dir * 17 + pw) * 64 + p];
                v[j] = (part & 1) ? -(cr * li + ci * lr) : (cr * lr - ci * li); } }
        u32x4 o; o.x = cvt_pk_bf16(v[0], v[1]); o.y = cvt_pk_bf16(v[2], v[3]); o.z = cvt_pk_bf16(v[4], v[5]); o.w = cvt_pk_bf16(v[6], v[7]);
        *(u32x4*)(TO + (size_t)n * LDTO + k0) = o; }
    __syncthreads();
}

__device__ __forceinline__ unsigned char* wset_base(const Params& P, int l, int zz) { return (l & 1) ? (unsigned char*)P.out + zz : P.ws + zz + WS_WSET; }
__device__ __forceinline__ void convert_weights(const Params& P, LAS unsigned char* lds, int l, int gw, int NGW, int wave, int lane, int it_lo = 0, int it_hi = 1 << 30) {
    LAUNDER_Z();
    unsigned char* wb = wset_base(P, l, zz);
    LAS float* scr = (LAS float*)(lds + wave * 16384);
    constexpr int I_IN = 32 * 129, I_GLU = 16 * 32, I_OUT = 32 * 64, I_G = 32 * 176, I_DN = 88 * 64, NIT = I_IN + I_GLU + I_OUT + 2 * I_G + I_DN;
    const int ihi = it_hi < NIT ? it_hi : NIT;
    for (int it = it_lo + gw; it < ihi; it += NGW) { int r = it;
        if (r < I_IN) { transpose_item(PIN(3) + (size_t)l * DM * DIN, DM, DIN, (bf16_t*)(wb + WO_WIN), LDH, scr, r, lane, PIN(2) + (size_t)l * DM); continue; } r -= I_IN;
        if (r < I_GLU) { transpose_item(PIN(12) + (size_t)l * 1024 * 1024, 1024, 1024, (bf16_t*)(wb + WO_WGLU), LDG, scr, r, lane, nullptr); continue; } r -= I_GLU;
        if (r < I_OUT) { transpose_item(PIN(19) + (size_t)l * DM * DM, DM, DM, (bf16_t*)(wb + WO_WOUT), LDH, scr, r, lane, nullptr); continue; } r -= I_OUT;
        if (r < I_G) { transpose_item(PIN(21) + (size_t)l * DM * DFF, DM, DFF, (bf16_t*)(wb + WO_WGU), LDH, scr, r, lane, PIN(20) + (size_t)l * DM, 1); continue; } r -= I_G;
        if (r < I_G) { transpose_item(PIN(22) + (size_t)l * DM * DFF, DM, DFF, (bf16_t*)(wb + WO_WGU), LDH, scr, r, lane, PIN(20) + (size_t)l * DM, 2); continue; } r -= I_G;
        transpose_item(PIN(25) + (size_t)l * DFF * DM, DFF, DM, (bf16_t*)(wb + WO_WDN), LDF, scr, r, lane, nullptr);
    }
}

__device__ __forceinline__ void phase_s5_scan(const Params& P, int l, int bofs) {
    LAUNDER_Z();
    const int t = tid_l(); if (t >= 128) return;
    const int idx = (bid_l() - bofs) * 128 + t; if (idx >= 16384 || idx < 0) return;
    const int p4 = idx & 15, dir = (idx >> 4) & 1, b = (idx >> 5) & 7, g = idx >> 8;
    const size_t o = ((size_t)(l * 2 + dir) * 64 + g) * 64 + 4 * p4;
    const float dt = expf(PIN(6)[(size_t)(l * 2 + dir) * 64 + g]);
    f32x4 Lr, Li;
#pragma unroll
    for (int j = 0; j < 4; ++j) { const float are = fminf(PIN(4)[o + j], -1e-4f), aim = PIN(5)[o + j]; const float mag = expf(are * dt * 16.0f); float sn, cs; sincosf(aim * dt * 16.0f, &sn, &cs); Lr[j] = mag * cs; Li[j] = mag * sn; }
    const f32x4* sl = (const f32x4*)((const float*)(P.ws + zz + WS_SLOC) + ((size_t)g * S5ROWP + b * NCH) * 256 + dir * 128 + 4 * p4);
    bf16_t* so = (bf16_t*)(P.ws + zz + WS_UA) + ((size_t)g * S5ROWP + b * NCH) * LDU + 256 + dir * 128 + 4 * p4;
    f32x4 sr = (f32x4){0.f, 0.f, 0.f, 0.f}, si = (f32x4){0.f, 0.f, 0.f, 0.f};
    for (int blk = 0; blk < 11; ++blk) {
        f32x4 xr[12], xi[12];
#pragma unroll
        for (int j = 0; j < 12; ++j) { const int i = blk * 12 + j, n = dir == 0 ? i : NCH - 1 - i; xr[j] = sl[(size_t)n * 64]; xi[j] = sl[(size_t)n * 64 + 16]; }
#pragma unroll
        for (int j = 0; j < 12; ++j) { const int i = blk * 12 + j, n = dir == 0 ? i : NCH - 1 - i;
            u32x2 wr_, wi_; wr_.x = cvt_pk_bf16(sr[0], sr[1]); wr_.y = cvt_pk_bf16(sr[2], sr[3]); wi_.x = cvt_pk_bf16(si[0], si[1]); wi_.y = cvt_pk_bf16(si[2], si[3]);
            *(u32x2*)(so + (size_t)n * LDU) = wr_; *(u32x2*)(so + (size_t)n * LDU + 64) = wi_;
            const f32x4 nr = Lr * sr - Li * si + xr[j], ni = Lr * si + Li * sr + xi[j]; sr = nr; si = ni; }
    }
}

constexpr int MLS = 72;
__device__ __forceinline__ f32x4 mma_tile(const LAS bf16_t* A, const LAS bf16_t* Bt, int fr, int fq, f32x4 acc) {
#pragma unroll
    for (int kk = 0; kk < 2; ++kk) { const bf16x8 a = *(const LAS bf16x8*)(A + fr * MLS + kk * 32 + fq * 8); const bf16x8 b = *(const LAS bf16x8*)(Bt + fr * MLS + kk * 32 + fq * 8);
        acc = __builtin_amdgcn_mfma_f32_16x16x32_bf16(a, b, acc, 0, 0, 0); }
    return acc;
}
__device__ __forceinline__ void phase_mlstm(const Params& P, LAS unsigned char* lds, int l) {
    LAUNDER_Z();
    const int tid = tid_l(), lane = tid & 63, w = tid >> 6, fr = lane & 15, fq = lane >> 4; unsigned char* ws = P.ws + zz;
    LAS bf16_t* Qs = (LAS bf16_t*)lds;
    LAS bf16_t* Ks = Qs + 64 * MLS;
    LAS bf16_t* Kw = Ks + 64 * MLS;
    LAS bf16_t* Ss = Kw + 64 * MLS;
    LAS bf16_t* Vt = Ss + 64 * MLS;
    LAS bf16_t* Ct = Vt + 160 * MLS;
    LAS float* den = (LAS float*)(Ct + 160 * MLS);
    LAS float* CW = den + 64;
    const bf16_t* Z = (const bf16_t*)(ws + WS_Z); const float* Gt = (const float*)(ws + WS_G);
    const int nmb = gridDim.x >= 256 ? 128 : gridDim.x;
    if (bid_l() >= nmb) return;
    for (int item = bid_l(); item < 128; item += nmb) {
        const int dir = item & 1, hd = (item >> 1) & 7, b = item >> 4;
        __syncthreads();
        for (int e = tid; e < 160 * MLS; e += 512) Ct[e] = 0;
        for (int e = tid; e < 32 * MLS; e += 512) Vt[128 * MLS + e] = (e < 64) ? (bf16_t)0x3F80 : (bf16_t)0;
        f32x4 Cst[5];
#pragma unroll
        for (int j = 0; j < 5; ++j) Cst[j] = (f32x4){0.f, 0.f, 0.f, 0.f};
        float m_prev = -1e30f;
        const float gb_i = PIN(17)[l * 32 + (2 * dir) * 8 + hd], gb_f = PIN(17)[l * 32 + (2 * dir + 1) * 8 + hd];
        bf16_t* Hout = (bf16_t*)(ws + WS_HFB) + (size_t)dir * MP * 1024;
        for (int e = tid; e < 512; e += 512) { const int rr = e >> 7, c = e & 127; const int colz = (c < 64 ? hd * 64 + c : 512 + hd * 64 + (c - 64));
            CW[e] = rr < 3 ? PIN(15)[(size_t)l * 3 * 1024 + rr * 1024 + colz] : PIN(16)[(size_t)l * 1024 + colz]; }
        const int wu = __builtin_amdgcn_readfirstlane(w);
        const int colz = (wu < 4 ? hd * 64 + wu * 16 : 512 + hd * 64 + (wu - 4) * 16);
        const int myoff = dir == 0 ? lane : 63 - lane;
        const int gcol_i = (2 * dir) * 8 + hd, gcol_f = (2 * dir + 1) * 8 + hd;
        u32x4 pz[8]; float pg_i, pg_f;
#define ML_PREFETCH(cx) do { const int n_ = dir == 0 ? (cx) : 32 - (cx); const size_t r_ = (size_t)(b * LP + n_ * 64 + myoff); \
            const bf16_t* zp_ = Z + r_ * 3072 + colz; const bf16_t* vp_ = Z + r_ * 3072 + 1024 + hd * 128 + wu * 16; \
            pz[0] = *(const u32x4*)(zp_ - 3072); pz[1] = *(const u32x4*)(zp_ - 3072 + 8); pz[2] = *(const u32x4*)(zp_); pz[3] = *(const u32x4*)(zp_ + 8); \
            pz[4] = *(const u32x4*)(zp_ + 3072); pz[5] = *(const u32x4*)(zp_ + 3072 + 8); pz[6] = *(const u32x4*)(vp_); pz[7] = *(const u32x4*)(vp_ + 8); \
            pg_i = Gt[r_ * 32 + gcol_i]; pg_f = Gt[r_ * 32 + gcol_f]; } while (0)
        ML_PREFETCH(0);
        __syncthreads();
        for (int cix = 0; cix < 33; ++cix) {
            const int n = dir == 0 ? cix : 32 - cix;
            const int rowbase = b * LP + n * 64;
            u32x4 cz[8];
#pragma unroll
            for (int j = 0; j < 8; ++j) cz[j] = pz[j];
            const float cg_i = pg_i, cg_f = pg_f;
            if (cix + 1 < 33) ML_PREFETCH(cix + 1);
            const bool mypad = (n * 64 + myoff) < PADF;
            float li = cg_i + gb_i;
            const float xf = cg_f + gb_f;
            float lf = fminf(xf, 0.f) - log1pf(__expf(-fabsf(xf)));
            if (mypad) { li = -1e30f; lf = 0.f; }
            float bc = lf;
#pragma unroll
            for (int o = 1; o < 64; o <<= 1) { const float t = shi(bc, lane - o); if (lane >= o) bc += t; }
            const float gsum = shi(bc, 63);
            const float m_loc = wave_max(gsum - bc + li, lane);
            const float wloc = __expf(gsum - bc + li - m_loc);
            const float cv = li - bc;
            float pm = cv;
#pragma unroll
            for (int o = 1; o < 64; o <<= 1) { const float t = shi(pm, lane - o); if (lane >= o) pm = fmaxf(pm, t); }
            const float Mt = fmaxf(m_prev, pm);
            const float sint = __expf(m_prev - Mt);
            const float einv = __expf(-(bc + Mt));
            const float m_new = fmaxf(gsum + m_prev, m_loc);
            const float s_old = __expf(gsum + m_prev - m_new), s_loc = __expf(m_loc - m_new);
            {
                const int i = lane; const bool pad = mypad;
                const unsigned um[8] = {cz[0].x, cz[0].y, cz[0].z, cz[0].w, cz[1].x, cz[1].y, cz[1].z, cz[1].w};
                const unsigned u0[8] = {cz[2].x, cz[2].y, cz[2].z, cz[2].w, cz[3].x, cz[3].y, cz[3].z, cz[3].w};
                const unsigned up[8] = {cz[4].x, cz[4].y, cz[4].z, cz[4].w, cz[5].x, cz[5].y, cz[5].z, cz[5].w};
                float qv[16];
#pragma unroll
                for (int j4 = 0; j4 < 4; ++j4) {
                    const f32x4 w0 = *(const LAS f32x4*)(CW + 0 * 128 + wu * 16 + j4 * 4), w1 = *(const LAS f32x4*)(CW + 1 * 128 + wu * 16 + j4 * 4), w2 = *(const LAS f32x4*)(CW + 2 * 128 + wu * 16 + j4 * 4), bb = *(const LAS f32x4*)(CW + 3 * 128 + wu * 16 + j4 * 4);
#pragma unroll
                    for (int jj = 0; jj < 2; ++jj) { const int j = j4 * 2 + jj;
                        const float x0 = bb[2 * jj] + w0[2 * jj] * bf_lo(um[j]) + w1[2 * jj] * bf_lo(u0[j]) + w2[2 * jj] * bf_lo(up[j]);
                        const float x1 = bb[2 * jj + 1] + w0[2 * jj + 1] * bf_hi(um[j]) + w1[2 * jj + 1] * bf_hi(u0[j]) + w2[2 * jj + 1] * bf_hi(up[j]);
                        qv[2 * j] = pad ? 0.f : siluf_(x0); qv[2 * j + 1] = pad ? 0.f : siluf_(x1); } }
                if (wu < 4) {
                    u32x4 o0, o1; o0.x = cvt_pk_bf16(qv[0] * 0.125f, qv[1] * 0.125f); o0.y = cvt_pk_bf16(qv[2] * 0.125f, qv[3] * 0.125f); o0.z = cvt_pk_bf16(qv[4] * 0.125f, qv[5] * 0.125f); o0.w = cvt_pk_bf16(qv[6] * 0.125f, qv[7] * 0.125f);
                    o1.x = cvt_pk_bf16(qv[8] * 0.125f, qv[9] * 0.125f); o1.y = cvt_pk_bf16(qv[10] * 0.125f, qv[11] * 0.125f); o1.z = cvt_pk_bf16(qv[12] * 0.125f, qv[13] * 0.125f); o1.w = cvt_pk_bf16(qv[14] * 0.125f, qv[15] * 0.125f);
                    *(LAS u32x4*)(Qs + i * MLS + wu * 16) = o0; *(LAS u32x4*)(Qs + i * MLS + wu * 16 + 8) = o1;
                } else {
                    const int d0 = (wu - 4) * 16;
                    u32x4 o0, o1; o0.x = cvt_pk_bf16(qv[0], qv[1]); o0.y = cvt_pk_bf16(qv[2], qv[3]); o0.z = cvt_pk_bf16(qv[4], qv[5]); o0.w = cvt_pk_bf16(qv[6], qv[7]);
                    o1.x = cvt_pk_bf16(qv[8], qv[9]); o1.y = cvt_pk_bf16(qv[10], qv[11]); o1.z = cvt_pk_bf16(qv[12], qv[13]); o1.w = cvt_pk_bf16(qv[14], qv[15]);
                    *(LAS u32x4*)(Ks + i * MLS + d0) = o0; *(LAS u32x4*)(Ks + i * MLS + d0 + 8) = o1;
#pragma unroll
                    for (int j = 0; j < 16; ++j) Kw[(d0 + j) * MLS + i] = f2bf(qv[j] * wloc);
                }
                const unsigned uv[8] = {cz[6].x, cz[6].y, cz[6].z, cz[6].w, cz[7].x, cz[7].y, cz[7].z, cz[7].w};
#pragma unroll
                for (int j = 0; j < 8; ++j) { Vt[(wu * 16 + 2 * j) * MLS + i] = pad ? (bf16_t)0 : (bf16_t)(uv[j] & 0xffffu); Vt[(wu * 16 + 2 * j + 1) * MLS + i] = pad ? (bf16_t)0 : (bf16_t)(uv[j] >> 16); }
            }
            __syncthreads();
            {
                const int st = w & 3;
#pragma unroll
                for (int jj = 0; jj < 2; ++jj) { const int tt = (w >> 2) * 2 + jj;
                    f32x4 a = (f32x4){0.f, 0.f, 0.f, 0.f};
                    a = mma_tile(Ks + st * 16 * MLS, Qs + tt * 16 * MLS, fr, fq, a);
                    const int t = tt * 16 + fr, s0 = st * 16 + 4 * fq; const float Mtt = shi(Mt, t);
                    f32x4 o;
#pragma unroll
                    for (int j = 0; j < 4; ++j) { const float cs = shi(cv, s0 + j); o[j] = (s0 + j <= t) ? a[j] * __expf(cs - Mtt) : 0.f; }
                    u32x2 pk; pk.x = cvt_pk_bf16(o[0], o[1]); pk.y = cvt_pk_bf16(o[2], o[3]);
                    *(LAS u32x2*)(Ss + t * MLS + s0) = pk; }
            }
            __syncthreads();
            f32x4 num[5];
            const int tt = w & 3, tC = tt * 16 + fr; const float sint_t = shi(sint, tC), einv_t = shi(einv, tC);
#pragma unroll
            for (int j = 0; j < 5; ++j) { const int dvt = (w >> 2) * 5 + j;
                f32x4 a1 = (f32x4){0.f, 0.f, 0.f, 0.f}, a2 = (f32x4){0.f, 0.f, 0.f, 0.f};
                a1 = mma_tile(Vt + dvt * 16 * MLS, Ss + tt * 16 * MLS, fr, fq, a1);
                a2 = mma_tile(Ct + dvt * 16 * MLS, Qs + tt * 16 * MLS, fr, fq, a2);
                num[j] = a1 + a2 * sint_t;
                if (dvt == 8 && fq == 0) den[tC] = num[j][0]; }
            __syncthreads();
            {
                const float dn = den[tC]; const float inv = 1.0f / fmaxf(fabsf(dn), einv_t);
                const int off = dir == 0 ? tC : 63 - tC; const size_t r = (size_t)rowbase + off;
#pragma unroll
                for (int j = 0; j < 5; ++j) { const int dvt = (w >> 2) * 5 + j;
                    if (dvt < 8) store_bf4(Hout + r * 1024 + hd * 128 + dvt * 16 + 4 * fq, num[j] * inv); }
            }
            {
                const int dkt = w & 3;
#pragma unroll
                for (int j = 0; j < 5; ++j) { const int dvt = (w >> 2) * 5 + j;
                    f32x4 a = (f32x4){0.f, 0.f, 0.f, 0.f};
                    a = mma_tile(Kw + dkt * 16 * MLS, Vt + dvt * 16 * MLS, fr, fq, a);
                    Cst[j] = Cst[j] * s_old + a * s_loc;
                    u32x2 pk; pk.x = cvt_pk_bf16(Cst[j][0], Cst[j][1]); pk.y = cvt_pk_bf16(Cst[j][2], Cst[j][3]);
                    *(LAS u32x2*)(Ct + (dvt * 16 + fr) * MLS + dkt * 16 + 4 * fq) = pk; }
            }
            m_prev = m_new;
            __syncthreads();
        }
    }
}

__device__ __forceinline__ void phase_finalize(const Params& P, int l) {
    LAUNDER_Z();
    const int tid = tid_l(), lane = tid & 63, gw = bid_l() * 8 + (tid >> 6), NGW = gridDim.x * 8; unsigned char* ws = P.ws + zz;
    const bf16_t* YG = (const bf16_t*)(ws + WS_YGLU); const bf16_t* HF = (const bf16_t*)(ws + WS_HFB); const bf16_t* HB = HF + (size_t)MP * 1024;
    const bf16_t* Z = (const bf16_t*)(ws + WS_Z); bf16_t* Y = (bf16_t*)(ws + WS_Y);
    float g1[16], g2[16];
    { const f32x4* p1 = (const f32x4*)(PIN(14) + (size_t)l * 1024 + lane * 16); const f32x4* p2 = (const f32x4*)(PIN(18) + (size_t)l * 1024 + lane * 16);
#pragma unroll
      for (int j = 0; j < 4; ++j) { const f32x4 a = p1[j], b = p2[j]; g1[4 * j] = a[0]; g1[4 * j + 1] = a[1]; g1[4 * j + 2] = a[2]; g1[4 * j + 3] = a[3]; g2[4 * j] = b[0]; g2[4 * j + 1] = b[1]; g2[4 * j + 2] = b[2]; g2[4 * j + 3] = b[3]; } }
    for (int r = gw; r < MP; r += NGW) {
        u32x4* yo = (u32x4*)(Y + (size_t)r * LDH);
        if ((r % LP) < PADF) { unsigned z0 = 0u; asm volatile("" : "+v"(z0)); for (int j = 0; j < 4; ++j) yo[lane + 64 * j] = (u32x4){z0, z0, z0, z0}; continue; }
        const size_t o = (size_t)r * 1024 + lane * 16;
        const u32x4 f0 = *(const u32x4*)(HF + o), f1 = *(const u32x4*)(HF + o + 8), b0 = *(const u32x4*)(HB + o), b1 = *(const u32x4*)(HB + o + 8);
        const u32x4 q0 = *(const u32x4*)(Z + (size_t)r * 3072 + 2048 + lane * 16), q1 = *(const u32x4*)(Z + (size_t)r * 3072 + 2048 + lane * 16 + 8);
        {
            const u32x4 a0 = *(const u32x4*)(YG + (size_t)r * 1024 + lane * 16), a1 = *(const u32x4*)(YG + (size_t)r * 1024 + lane * 16 + 8);
            const unsigned uu[8] = {a0.x, a0.y, a0.z, a0.w, a1.x, a1.y, a1.z, a1.w}; float v[16]; float s = 0.f;
#pragma unroll
            for (int j = 0; j < 8; ++j) { v[2 * j] = bf_lo(uu[j]); v[2 * j + 1] = bf_hi(uu[j]); s += v[2 * j] * v[2 * j] + v[2 * j + 1] * v[2 * j + 1]; }
            const float rs = rsqrtf(wave_sum(s, lane) * (1.0f / 1024.0f) + EPSN);
            const float* g = g1;
            u32x4 o0, o1; o0.x = cvt_pk_bf16(v[0] * rs * g[0], v[1] * rs * g[1]); o0.y = cvt_pk_bf16(v[2] * rs * g[2], v[3] * rs * g[3]); o0.z = cvt_pk_bf16(v[4] * rs * g[4], v[5] * rs * g[5]); o0.w = cvt_pk_bf16(v[6] * rs * g[6], v[7] * rs * g[7]);
            o1.x = cvt_pk_bf16(v[8] * rs * g[8], v[9] * rs * g[9]); o1.y = cvt_pk_bf16(v[10] * rs * g[10], v[11] * rs * g[11]); o1.z = cvt_pk_bf16(v[12] * rs * g[12], v[13] * rs * g[13]); o1.w = cvt_pk_bf16(v[14] * rs * g[14], v[15] * rs * g[15]);
            yo[lane * 2] = o0; yo[lane * 2 + 1] = o1;
        }
        {
            const unsigned uf[8] = {f0.x, f0.y, f0.z, f0.w, f1.x, f1.y, f1.z, f1.w}, ub[8] = {b0.x, b0.y, b0.z, b0.w, b1.x, b1.y, b1.z, b1.w}, uo[8] = {q0.x, q0.y, q0.z, q0.w, q1.x, q1.y, q1.z, q1.w};
            float v[16]; float s = 0.f;
#pragma unroll
            for (int j = 0; j < 8; ++j) { v[2 * j] = bf_lo(uf[j]) + bf_lo(ub[j]); v[2 * j + 1] = bf_hi(uf[j]) + bf_hi(ub[j]); s += v[2 * j] * v[2 * j] + v[2 * j + 1] * v[2 * j + 1]; }
            s += shx(s, 1, lane); s += shx(s, 2, lane); s += shx(s, 4, lane);
            const float rs = rsqrtf(s * (1.0f / 128.0f) + EPSN);
            const float* g = g2;
            float ov[16];
#pragma unroll
            for (int j = 0; j < 8; ++j) { ov[2 * j] = sigmoidf_(bf_lo(uo[j])) * v[2 * j] * rs * g[2 * j]; ov[2 * j + 1] = sigmoidf_(bf_hi(uo[j])) * v[2 * j + 1] * rs * g[2 * j + 1]; }
            u32x4 o0, o1; o0.x = cvt_pk_bf16(ov[0], ov[1]); o0.y = cvt_pk_bf16(ov[2], ov[3]); o0.z = cvt_pk_bf16(ov[4], ov[5]); o0.w = cvt_pk_bf16(ov[6], ov[7]);
            o1.x = cvt_pk_bf16(ov[8], ov[9]); o1.y = cvt_pk_bf16(ov[10], ov[11]); o1.z = cvt_pk_bf16(ov[12], ov[13]); o1.w = cvt_pk_bf16(ov[14], ov[15]);
            yo[128 + lane * 2] = o0; yo[128 + lane * 2 + 1] = o1;
        }
    }
}

__device__ __forceinline__ void phase_final(const Params& P) {
    LAUNDER_Z();
    const int lane = tid_l() & 63, gw = bid_l() * 8 + (tid_l() >> 6), NGW = gridDim.x * 8;
    const float* H = (const float*)(P.ws + zz + WS_H);
    for (int q = gw; q < NB * 2048; q += NGW) {
        const int b = q >> 11, t = q & 2047; const size_t r = (size_t)b * LP + 64 + t;
        const f32x4* xr = (const f32x4*)(H + r * DM) + lane; const f32x4* gr = (const f32x4*)PIN(26) + lane; f32x4* o = (f32x4*)(P.out + zz + (size_t)q * DM) + lane;
        f32x4 v[8]; float s = 0.f;
#pragma unroll
        for (int j = 0; j < 8; ++j) { v[j] = xr[64 * j]; s += (v[j][0] * v[j][0] + v[j][1] * v[j][1]) + (v[j][2] * v[j][2] + v[j][3] * v[j][3]); }
        const float rs = rsqrtf(wave_sum(s, lane) * (1.0f / DM) + EPSN);
#pragma unroll
        for (int j = 0; j < 8; ++j) o[64 * j] = v[j] * rs * gr[64 * j];
    }
}

#define XB_TMO      128
#define XB_XCNT(j)  (256  + 64 * (j))
#define XB_XSUB(j)  (1280 + 64 * (j))
#define XB_XGEN(j)  (2304 + 64 * (j))
#define XB_TOP      3328
#define XB_TOPGEN   3392
#define XCD_BAR_WORDS 3456
#define XB_SPIN_CAP (1u << 22)
__device__ __forceinline__ unsigned xb_ld(unsigned* p)              { return __hip_atomic_load(p, __ATOMIC_RELAXED, __HIP_MEMORY_SCOPE_AGENT); }
__device__ __forceinline__ unsigned xb_add(unsigned* p, unsigned v) { return __hip_atomic_fetch_add(p, v, __ATOMIC_RELAXED, __HIP_MEMORY_SCOPE_AGENT); }
__device__ __forceinline__ unsigned xb_xcc_id() { return (unsigned)__builtin_amdgcn_s_getreg((3 << 11) | 20) & 0xFu; }
#define XB_SPIN(cond, bar) do { unsigned _sp = 0; while (cond) { __builtin_amdgcn_s_sleep(1); \
    if ((++_sp & 255u) == 0u) { if (xb_ld(&(bar)[XB_TMO])) break; if (_sp > XB_SPIN_CAP) { atomicAdd(&(bar)[XB_TMO], 1u); break; } } } } while (0)
__device__ __forceinline__ void xcd_barrier(unsigned* bar, volatile LAS unsigned* st, unsigned G) {
    asm volatile("s_waitcnt vmcnt(0)" ::: "memory");
    __syncthreads();
    if (tid_l() == 0) {
        __builtin_amdgcn_s_waitcnt(0);
        const unsigned x = xb_xcc_id();
        unsigned nloc = st[0], nx = st[1];
        if (nloc == 0u) {
            unsigned sum, cnt, mine, sp = 0u;
            for (;;) {
                sum = 0u; cnt = 0u; mine = 0u;
#pragma unroll
                for (unsigned j = 0; j < 16; ++j) { const unsigned c = xb_ld(&bar[XB_XCNT(j)]); sum += c; cnt += (c > 0u) ? 1u : 0u; mine = (j == x) ? c : mine; }
                if (sum == G) break;
                __builtin_amdgcn_s_sleep(1);
                if ((++sp & 255u) == 0u) { if (xb_ld(&bar[XB_TMO])) break; if (sp > XB_SPIN_CAP) { atomicAdd(&bar[XB_TMO], 1u); break; } }
            }
            nloc = mine > 0u ? mine : 1u; nx = cnt > 0u ? cnt : 1u; st[0] = nloc; st[1] = nx;
        }
        const unsigned old = xb_add(&bar[XB_XSUB(x)], 1u);
        const unsigned gen = old / nloc;
        if (old + 1u == (gen + 1u) * nloc) {
            __builtin_amdgcn_fence(__ATOMIC_RELEASE, "agent");
            asm volatile("s_waitcnt vmcnt(0)" ::: "memory");
            const unsigned og = xb_add(&bar[XB_TOP], 1u);
            const unsigned tg = og / nx;
            if (og + 1u == (tg + 1u) * nx) xb_add(&bar[XB_TOPGEN], 1u);
            else XB_SPIN(xb_ld(&bar[XB_TOPGEN]) == tg, bar);
            __builtin_amdgcn_fence(__ATOMIC_ACQUIRE, "agent");
            xb_add(&bar[XB_XGEN(x)], 1u);
            asm volatile("s_waitcnt vmcnt(0)" ::: "memory");
        } else {
            XB_SPIN(xb_ld(&bar[XB_XGEN(x)]) == gen, bar);
            __builtin_amdgcn_fence(__ATOMIC_ACQUIRE, "agent");
            asm volatile("s_waitcnt vmcnt(0)" ::: "memory");
        }
    }
    __syncthreads();
}

__global__ void __launch_bounds__(512, 2) mk_fwd(Params P) {
    extern __shared__ __attribute__((aligned(16))) unsigned char lds_raw[];
    LAS unsigned char* lds = (LAS unsigned char*)lds_raw;
    cg::grid_group grid = cg::this_grid();
    volatile LAS unsigned* xst = (volatile LAS unsigned*)(lds + 131072);
    if (threadIdx.x < 4) xst[threadIdx.x] = 0u;
    __syncthreads();
    unsigned char* ws = P.ws;
    for (int ph = P.ph_lo; ph < P.ph_hi; ++ph) {
        if (ph == 0) {
            if (bid_l() == 0) { for (int i = tid_l(); i < 8192 + 1024 + XCD_BAR_WORDS; i += 512) ((unsigned*)ws)[i] = 0u; }
            phase_init_rows(P);
            for (int pr = bid_l(); pr < DEPTH * 64; pr += gridDim.x) s5_precompute(P, lds, pr >> 6, pr & 63);
            __syncthreads();
            convert_weights(P, lds, 0, bid_l() * 8 + (tid_l() >> 6), gridDim.x * 8, tid_l() >> 6, tid_l() & 63);
        }
        else if (ph == NPHASES - 1) phase_final(P);
        else {
            const int l = (ph - 1) / NPH_L, k = (ph - 1) % NPH_L;
            GemmDesc d; d.layer = l; d.nB = 1; d.sA = 0; d.sB = 0; d.A = nullptr; d.Bt = nullptr; d.lda = d.ldb = d.K = 256; d.nM = d.nN = 1; d.epi = 0; d.ssi = 0; d.amode = 0; d.split = 0; d.perm = 0; d.ubase = 0; d.umax = 0x7fffffff; d.gG = gridDim.x; d.gc = bid_l(); bool isg = false;
            const unsigned char* wb = (l & 1) ? (const unsigned char*)P.out : ws + WS_WSET;
            switch (k) {
            case 0: { const int gt = bid_l() * 512 + tid_l(), NGT = gridDim.x * 512; zero_rows16((bf16_t*)(ws + WS_Z) - 3072, 384, gt, NGT); zero_rows16((bf16_t*)(ws + WS_Z) + (size_t)MP * 3072, 384, gt, NGT); }
                d.A = (const bf16_t*)(ws + WS_HN); d.Bt = (const bf16_t*)(wb + WO_WIN); d.lda = LDH; d.ldb = LDH; d.K = DM; d.nM = MP / 256; d.nN = DINP / 256; d.epi = EPI_WIN; d.ssi = 2 * l; d.perm = 1; isg = true; break;
            case 1:
                if (bid_l() < 128) phase_mlstm(P, lds, l);
                else {
                    d.gG = gridDim.x - 128; d.gc = bid_l() - 128;
                    d.A = (const bf16_t*)(ws + WS_UA); d.Bt = (const bf16_t*)(ws + WS_WST) + (size_t)l * 64 * (256 * LDWS); d.lda = LDU; d.ldb = LDWS; d.K = 256; d.nM = S5ROWP / 256; d.nN = 1; d.nB = 64; d.sA = (size_t)S5ROWP * LDU; d.sB = 256 * LDWS; d.epi = EPI_S5A;
                    gemm_phase(P, lds, d);
                    xcd_barrier((unsigned*)ws + 8192 + 1024, xst + 2, gridDim.x - 128);
                    phase_s5_scan(P, l, 128);
                    xcd_barrier((unsigned*)ws + 8192 + 1024, xst + 2, gridDim.x - 128);
                    d.Bt = (const bf16_t*)(ws + WS_TO) + (size_t)l * 64 * (256 * LDTO); d.ldb = LDTO; d.K = 512; d.sB = 256 * LDTO; d.epi = EPI_S5C; d.perm = 1;
                    gemm_phase(P, lds, d);
                    xcd_barrier((unsigned*)ws + 8192 + 1024, xst + 2, gridDim.x - 128);
                    d.A = (const bf16_t*)(ws + WS_YGELU); d.Bt = (const bf16_t*)(wb + WO_WGLU); d.lda = LDG; d.ldb = LDG; d.K = 1024; d.nM = MP / 256; d.nN = 4; d.nB = 1; d.sA = 0; d.sB = 0; d.epi = EPI_GLU; d.perm = 1; d.umax = 2 * (gridDim.x - 128); isg = true;
                    if (bid_l() == 128 && tid_l() == 0) __hip_atomic_store((unsigned*)ws + 128, (unsigned)(l + 1), __ATOMIC_RELAXED, __HIP_MEMORY_SCOPE_AGENT);
                }
                break;
            case 2: phase_finalize(P, l); break;
            case 3: d.A = (const bf16_t*)(ws + WS_Y); d.Bt = (const bf16_t*)(wb + WO_WOUT); d.lda = LDH; d.ldb = LDH; d.K = DM; d.nM = MP / 256; d.nN = 8; d.epi = EPI_RES; d.ssi = 2 * l + 1; d.split = 4; d.perm = 1; isg = true; break;
            case 4: d.A = (const bf16_t*)(ws + WS_HN) - LDH; d.Bt = (const bf16_t*)(wb + WO_WGU); d.lda = LDH; d.ldb = LDH; d.K = DM; d.nM = 69; d.nN = 44; d.epi = EPI_FFN; d.ssi = 2 * l + 1; d.amode = 1; d.perm = 1; isg = true; break;
            case 5: d.A = (const bf16_t*)(ws + WS_ACT); d.Bt = (const bf16_t*)(wb + WO_WDN); d.lda = LDF; d.ldb = LDF; d.K = DFF; d.nM = MP / 256; d.nN = 8; d.epi = EPI_RES; d.ssi = 2 * l + 2; d.split = 4; d.perm = 1; isg = true; break;
            }
            if (isg) gemm_phase(P, lds, d);
            if (k == 0 && l + 1 < DEPTH) {
                const int nun = (MP / 256) * (DINP / 256), nbusy = nun - (nun / (int)gridDim.x) * (int)gridDim.x; const int t_ = tid_l(); __syncthreads();
                if (bid_l() >= nbusy) convert_weights(P, lds, l + 1, (bid_l() - nbusy) * 8 + (t_ >> 6), (gridDim.x - nbusy) * 8, t_ >> 6, t_ & 63, 0, CV_SPLIT1);
            }
            if (k == 1 && l + 1 < DEPTH && bid_l() < 128) {
                const int t_ = tid_l(); __syncthreads();
                convert_weights(P, lds, l + 1, bid_l() * 8 + (t_ >> 6), 128 * 8, t_ >> 6, t_ & 63, CV_SPLIT1, CV_SPLIT2);
            }
            if (k == 1 && bid_l() < 128) {
                const int ntail = (MP / 256) * 4 - 2 * ((int)gridDim.x - 128);
                if ((int)bid_l() < ntail) {
                    __syncthreads();
                    if (tid_l() == 0) { unsigned sp = 0; while (__hip_atomic_load((unsigned*)ws + 128, __ATOMIC_RELAXED, __HIP_MEMORY_SCOPE_AGENT) < (unsigned)(l + 1)) { __builtin_amdgcn_s_sleep(4); if (++sp > (1u << 24)) break; }
                        __builtin_amdgcn_fence(__ATOMIC_ACQUIRE, "agent"); asm volatile("s_waitcnt vmcnt(0)" ::: "memory"); }
                    __syncthreads();
                    d.A = (const bf16_t*)(ws + WS_YGELU); d.Bt = (const bf16_t*)(wb + WO_WGLU); d.lda = LDG; d.ldb = LDG; d.K = 1024; d.nM = MP / 256; d.nN = 4; d.nB = 1; d.sA = 0; d.sB = 0; d.epi = EPI_GLU; d.perm = 1;
                    d.ubase = 2 * ((int)gridDim.x - 128); d.umax = 0x7fffffff; d.gG = ntail; d.gc = bid_l();
                    gemm_phase(P, lds, d);
                }
            }
            if (k == 5 && l + 1 < DEPTH) {
                const int nun = (MP / 256) * 8, nfull = (nun / (int)gridDim.x) * (int)gridDim.x, nbusy = (nun - nfull) * 4;
                const int t_ = tid_l(); __syncthreads();
                if (nbusy == 0 || nbusy >= (int)gridDim.x) convert_weights(P, lds, l + 1, bid_l() * 8 + (t_ >> 6), gridDim.x * 8, t_ >> 6, t_ & 63, CV_SPLIT2);
                else if (bid_l() >= nbusy) convert_weights(P, lds, l + 1, (bid_l() - nbusy) * 8 + (t_ >> 6), (gridDim.x - nbusy) * 8, t_ >> 6, t_ & 63, CV_SPLIT2);
            }
        }
        if (ph + 1 < P.ph_hi) { if (ph == 0) { grid.sync(); if (threadIdx.x == 0) { (void)xb_add((unsigned*)ws + 1024 + XB_XCNT(xb_xcc_id()), 1u); if (blockIdx.x >= 128) (void)xb_add((unsigned*)ws + 8192 + 1024 + XB_XCNT(xb_xcc_id()), 1u); } } else xcd_barrier((unsigned*)ws + 1024, xst, gridDim.x); }
    }
}

extern "C" void kernel_launch(void* const* d_in, const int* in_sizes, int n_in, void* d_out, int out_size, void* d_ws, size_t ws_size, hipStream_t stream) {
    static int grid = 0;
    if (grid == 0) {
        int dev = 0, cus = 0, per_cu = 0;
        hipGetDevice(&dev); hipDeviceGetAttribute(&cus, hipDeviceAttributeMultiprocessorCount, dev);
        if (hipFuncSetAttribute((const void*)mk_fwd, hipFuncAttributeMaxDynamicSharedMemorySize, LDS_BYTES) != hipSuccess) { fprintf(stderr, "kernel_launch: hipFuncSetAttribute failed\n"); grid = -1; return; }
        if (hipOccupancyMaxActiveBlocksPerMultiprocessor(&per_cu, (const void*)mk_fwd, 512, LDS_BYTES) != hipSuccess || per_cu < 1) { fprintf(stderr, "kernel_launch: occupancy query says %d\n", per_cu); per_cu = 1; }
        (void)hipGetLastError();
        grid = cus;
        if (ws_size < WS_END) fprintf(stderr, "kernel_launch: workspace too small: %zu < %zu\n", ws_size, (size_t)WS_END);
    }
    if (grid < 0) return;
    Params p{};
    for (int i = 0; i < 27; ++i) p.in[i] = (const float*)d_in[i];
    p.out = (float*)d_out; p.ws = (unsigned char*)d_ws; p.ph_lo = 0; p.ph_hi = NPHASES;
    void* args[] = {&p};
    hipError_t e = hipLaunchCooperativeKernel((const void*)mk_fwd, dim3(grid), dim3(512), args, LDS_BYTES, stream);
    if (e != hipSuccess) fprintf(stderr, "cooperative launch failed: %s (grid %d)\n", hipGetErrorString(e), grid);
}
```

```cpp
#include <hip/hip_runtime.h>
#include <hip/hip_cooperative_groups.h>
#include <cstdio>
namespace cg = cooperative_groups;

#define LAS __attribute__((address_space(3)))
typedef unsigned short bf16_t;
typedef short bf16x8 __attribute__((ext_vector_type(8)));
typedef float f32x4 __attribute__((ext_vector_type(4)));
typedef unsigned u32x4 __attribute__((ext_vector_type(4)));
typedef unsigned u32x2 __attribute__((ext_vector_type(2)));

constexpr int DM = 2048, NB = 8, LP = 2112, PADF = 48, MP = NB * LP;
constexpr int DIN = 4128, DINP = 4352, DFF = 5632, DEPTH = 4;
constexpr int NCH = LP / 16;
constexpr int S5ROWS = NB * NCH;
constexpr int S5ROWP = 1280;
constexpr float EPSN = 1e-6f;
constexpr int LDH = 2112, LDF = 5696, LDG = 1088, LDU = 576, LDWS = 320, LDTO = 576;
constexpr int CV_SPLIT1 = 7075, CV_SPLIT2 = 14150;
constexpr int NPH_L = 6, NPHASES = 2 + DEPTH * NPH_L;

constexpr size_t MiB = 1u << 20;
constexpr size_t WO_WIN = 0 * MiB, WO_WGLU = 18 * MiB, WO_WOUT = 21 * MiB, WO_WGU = 30 * MiB, WO_WDN = 76 * MiB;
constexpr size_t WS_WSET = 1 * MiB;
constexpr size_t WS_WST = 100 * MiB, WS_TO = 140 * MiB, WS_H = 212 * MiB, WS_HN = 344 * MiB + 8192, WS_G = 413 * MiB, WS_Y = 416 * MiB;
constexpr size_t WS_UA = 485 * MiB, WS_Z = 576 * MiB, WS_SLOC = 676 * MiB, WS_YGELU = 676 * MiB, WS_YGLU = 716 * MiB, WS_HFB = 756 * MiB;
constexpr size_t WS_GT = 486 * MiB, WS_ACT = 669 * MiB, WS_SS = 854 * MiB, WS_END = 856 * MiB;
constexpr int LDS_BYTES = 147456;

struct Params { const float* in[27]; float* out; unsigned char* ws; int ph_lo, ph_hi; };

#define LAUNDER_Z() int zz = 0; asm volatile("" : "+s"(zz))
#define PIN(i) (P.in[(i) + zz])
__device__ __forceinline__ int tid_l() { int w = __builtin_amdgcn_readfirstlane(threadIdx.x >> 6); asm volatile("" : "+s"(w)); int ln = __builtin_amdgcn_mbcnt_hi(~0u, __builtin_amdgcn_mbcnt_lo(~0u, 0u)); asm volatile("" : "+v"(ln)); return w * 64 + ln; }
__device__ __forceinline__ int bid_l() { int t = blockIdx.x; asm volatile("" : "+s"(t)); return t; }
__device__ __forceinline__ unsigned cvt_pk_bf16(float lo, float hi) { unsigned r; asm volatile("v_cvt_pk_bf16_f32 %0, %1, %2" : "=v"(r) : "v"(lo), "v"(hi)); return r; }
__device__ __forceinline__ float bf_lo(unsigned w) { return __uint_as_float(w << 16); }
__device__ __forceinline__ float bf_hi(unsigned w) { return __uint_as_float(w & 0xffff0000u); }
__device__ __forceinline__ float bf2f(bf16_t b) { return __uint_as_float((unsigned)b << 16); }
__device__ __forceinline__ bf16_t f2bf(float f) { return (bf16_t)(cvt_pk_bf16(f, 0.f) & 0xffffu); }
__device__ __forceinline__ float sigmoidf_(float x) { return __builtin_amdgcn_rcpf(1.0f + __expf(-x)); }
__device__ __forceinline__ float siluf_(float x) { return x * sigmoidf_(x); }
__device__ __forceinline__ float gelu_tanh(float x) { const float u = 0.7978845608028654f * (x + 0.044715f * x * x * x); const float t = 1.0f - 2.0f * __builtin_amdgcn_rcpf(__expf(2.0f * u) + 1.0f); return 0.5f * x * (1.0f + t); }
__device__ __forceinline__ float shx(float v, int o, int lane) { return __int_as_float(__builtin_amdgcn_ds_bpermute((lane ^ o) << 2, __float_as_int(v))); }
__device__ __forceinline__ float shi(float v, int idx) { return __int_as_float(__builtin_amdgcn_ds_bpermute(idx << 2, __float_as_int(v))); }
__device__ __forceinline__ float wave_sum(float v, int lane) {
#pragma unroll
    for (int o = 1; o < 64; o <<= 1) v += shx(v, o, lane);
    return v;
}
__device__ __forceinline__ float wave_max(float v, int lane) {
#pragma unroll
    for (int o = 1; o < 64; o <<= 1) v = fmaxf(v, shx(v, o, lane));
    return v;
}

constexpr int BM = 256, BK = 64, HALF = 128, HTB = HALF * BK * 2;
__device__ __forceinline__ int lds_byte(int r, int c) { const int st = (r >> 4) * 2 + (c >> 5), rr = r & 15, cc = c & 31, ob = rr * 64 + cc * 2; return st * 1024 + (ob ^ (((ob >> 9) & 1) << 5)); }
__device__ __forceinline__ void stage_rc(int b, int& R, int& C) { const int st = b / 1024, sb = b % 1024, swz = sb ^ (((sb >> 9) & 1) << 5); R = (st >> 1) * 16 + swz / 64; C = (st & 1) * 32 + (swz % 64) / 2; }

struct Unit { int pm, pn, b, piece, tu, k0, nt; };
struct GemmDesc { const bf16_t* A; const bf16_t* Bt; int lda, ldb, K, nM, nN, nB; size_t sA, sB; int epi, layer, ssi, amode, gG, gc, split, ubase, umax, perm; };
enum { EPI_WIN = 0, EPI_S5A = 1, EPI_S5C = 2, EPI_GLU = 3, EPI_RES = 4, EPI_FFN = 5 };

__device__ __forceinline__ bool next_unit(const GemmDesc& d, int i, int G, int c, Unit& u) {
    const int per = d.nM * d.nN; long L = (long)d.ubase + (long)i * G + c; const int ntf = d.K / BK;
    if (L >= d.umax) return false;
    u.piece = -1; u.tu = 0; u.k0 = 0; u.nt = ntf;
    if (d.split > 0) { const int nfull = (per / G) * G;
        if (L >= nfull) { const long q = L - nfull; if (q >= (long)(per - nfull) * d.split) return false;
            u.tu = (int)(q / d.split); u.piece = (int)(q % d.split); u.nt = ntf / d.split; u.k0 = u.piece * u.nt; L = nfull + u.tu; } }
    if (L >= (long)per * d.nB) return false;
    u.b = (int)(L / per); int wgid = (int)(L % per);
    { const int q = per / 8, r = per % 8, xcd = wgid % 8, off = wgid / 8; wgid = (xcd < r ? xcd * (q + 1) : r * (q + 1) + (xcd - r) * q) + off; }
    const int nig = 8 * d.nN, gid = wgid / nig, fm = gid * 8, gsz = (d.nM - fm) < 8 ? (d.nM - fm) : 8;
    u.pm = fm + ((wgid % nig) % gsz); u.pn = (wgid % nig) / gsz; return true;
}

__device__ __forceinline__ void store_bf4(bf16_t* p, f32x4 v) { u32x2 w; w.x = cvt_pk_bf16(v[0], v[1]); w.y = cvt_pk_bf16(v[2], v[3]); *(u32x2*)p = w; }
__device__ __forceinline__ f32x4 load_bf4(const bf16_t* p) { const u32x2 w = *(const u32x2*)p; return (f32x4){bf_lo(w.x), bf_hi(w.x), bf_lo(w.y), bf_hi(w.y)}; }

typedef unsigned long long u64;
constexpr float SSCALE = 16777216.0f;
__device__ __forceinline__ float row_rs(const u64* ss, int r) { return rsqrtf((float)ss[r] * (1.0f / SSCALE) * (1.0f / DM) + EPSN); }
__device__ __forceinline__ void gemm_epilogue(const Params& P, const GemmDesc& d, const f32x4 (&acc)[2][2][4][2], const Unit& u, int wr, int wc, int fr, int fq) {
    LAUNDER_Z(); unsigned char* ws = P.ws + zz; const int l = d.layer;
    int lane;
    { const int t2 = tid_l(); const int w2 = __builtin_amdgcn_readfirstlane(t2 >> 6); wr = w2 >> 2; wc = w2 & 3; lane = t2 & 63; fr = lane & 15; fq = lane >> 4; }
    const int rbase = u.pm * BM + wr * 64 + fr, cbase = u.pn * BM + wc * 32 + 4 * fq;
    if (d.epi == EPI_RES) {
        const int cb8 = u.pn * BM + wc * 32 + 8 * fq;
        float* hb = (float*)(ws + WS_H) + (size_t)rbase * DM + cb8; bf16_t* nb = (bf16_t*)(ws + WS_HN) + (size_t)rbase * LDH + cb8;
        u64* ssp = (u64*)(ws + WS_SS) + (size_t)d.ssi * MP + rbase;
#pragma unroll
        for (int ai = 0; ai < 2; ++ai)
#pragma unroll
        for (int mh = 0; mh < 2; ++mh) {
            f32x4 t[2][2][2];
            float* hp = hb + (size_t)(ai * HALF + mh * 32) * DM; asm volatile("" : "+v"(hp));
#pragma unroll
            for (int m = 0; m < 2; ++m)
#pragma unroll
                for (int bj = 0; bj < 2; ++bj)
#pragma unroll
                    for (int n = 0; n < 2; ++n) t[m][bj][n] = *(const f32x4*)(hp + (size_t)(m * 16) * DM + bj * HALF + n * 4);
            float sq[2] = {0.f, 0.f};
#pragma unroll
            for (int m = 0; m < 2; ++m)
#pragma unroll
                for (int bj = 0; bj < 2; ++bj)
#pragma unroll
                    for (int n = 0; n < 2; ++n) { const f32x4 hv = t[m][bj][n] + acc[ai][bj][mh * 2 + m][n]; t[m][bj][n] = hv;
                        __builtin_nontemporal_store(hv, (f32x4*)(hp + (size_t)(m * 16) * DM + bj * HALF + n * 4));
                        sq[m] += (hv[0] * hv[0] + hv[1] * hv[1]) + (hv[2] * hv[2] + hv[3] * hv[3]); }
            bf16_t* np = nb + (size_t)(ai * HALF + mh * 32) * LDH; asm volatile("" : "+v"(np));
#pragma unroll
            for (int m = 0; m < 2; ++m) {
#pragma unroll
                for (int bj = 0; bj < 2; ++bj) { u32x4 o; o.x = cvt_pk_bf16(t[m][bj][0][0], t[m][bj][0][1]); o.y = cvt_pk_bf16(t[m][bj][0][2], t[m][bj][0][3]); o.z = cvt_pk_bf16(t[m][bj][1][0], t[m][bj][1][1]); o.w = cvt_pk_bf16(t[m][bj][1][2], t[m][bj][1][3]);
                    *(u32x4*)(np + (size_t)(m * 16) * LDH + bj * HALF) = o; }
                float q = sq[m]; q += shx(q, 16, lane); q += shx(q, 32, lane);
                if (fq == 0) atomicAdd(ssp + ai * HALF + mh * 32 + m * 16, (u64)(q * SSCALE));
            }
        }
        return;
    }
    if (d.epi == EPI_FFN) {
        const int ccol = u.pn * 128 + wc * 32 + 8 * fq;
        const float* cwb = PIN(23) + (size_t)l * 3 * DFF + ccol; const float* cbb = PIN(24) + (size_t)l * DFF + ccol;
        const u64* ssb = (const u64*)(ws + WS_SS) + (size_t)d.ssi * MP;
#pragma unroll
        for (int ai = 0; ai < 2; ++ai) {
            const int row0 = u.pm * 248 + (ai * 2 + wr) * 62 - 1 + fr;
            float rsv[4];
#pragma unroll
            for (int m = 0; m < 4; ++m) { int rc = row0 + m * 16; rc = rc < 0 ? 0 : (rc > MP - 1 ? MP - 1 : rc); rsv[m] = row_rs(ssb, rc); }
            bf16_t* ab = (bf16_t*)(ws + WS_ACT) + (size_t)row0 * LDF + ccol;
            u32x2 keep[4];
#pragma unroll
            for (int n = 0; n < 2; ++n) {
                const f32x4 w0 = *(const f32x4*)(cwb + n * 4), w1 = *(const f32x4*)(cwb + DFF + n * 4), w2 = *(const f32x4*)(cwb + 2 * DFF + n * 4), cb = *(const f32x4*)(cbb + n * 4);
                f32x4 X[4], RR[4], RL[4];
#pragma unroll
                for (int m = 0; m < 4; ++m) { X[m] = acc[ai][0][m][n] * rsv[m];
#pragma unroll
                    for (int j = 0; j < 4; ++j) { RR[m][j] = __int_as_float(__builtin_amdgcn_update_dpp(0, __float_as_int(X[m][j]), 0x121, 0xf, 0xf, false));
                                                  RL[m][j] = __int_as_float(__builtin_amdgcn_update_dpp(0, __float_as_int(X[m][j]), 0x12f, 0xf, 0xf, false)); } }
#pragma unroll
                for (int m = 0; m < 4; ++m) {
                    const f32x4 prev = (fr > 0) ? RR[m] : RR[m > 0 ? m - 1 : 0];
                    const f32x4 next = (fr < 15) ? RL[m] : RL[m < 3 ? m + 1 : 3];
                    const f32x4 gt = cb + w0 * prev + w1 * X[m] + w2 * next; const f32x4 v = acc[ai][1][m][n] * rsv[m];
                    const int lr = m * 16 + fr, row = row0 + m * 16;
                    u32x2 pk; pk.x = cvt_pk_bf16(siluf_(gt[0]) * v[0], siluf_(gt[1]) * v[1]); pk.y = cvt_pk_bf16(siluf_(gt[2]) * v[2], siluf_(gt[3]) * v[3]);
                    if (n == 0) keep[m] = pk;
                    else if (lr >= 1 && lr <= 62 && row < MP) { u32x4 o; o.x = keep[m].x; o.y = keep[m].y; o.z = pk.x; o.w = pk.y; __builtin_nontemporal_store(o, (u32x4*)(ab + (size_t)(m * 16) * LDF)); } }
            }
        }
        return;
    }
    if (d.epi == EPI_GLU) {
        const int c8 = u.pn * BM + wc * 32 + 8 * fq;
        const bf16_t* yb = (const bf16_t*)(ws + WS_YGELU) + (size_t)rbase * LDG + c8; bf16_t* ob = (bf16_t*)(ws + WS_YGLU) + (size_t)rbase * 1024 + c8;
        const float* bb = PIN(13) + (size_t)l * 1024 + c8;
#pragma unroll
        for (int bj = 0; bj < 2; ++bj) {
            f32x4 bg[2];
#pragma unroll
            for (int n = 0; n < 2; ++n) bg[n] = *(const f32x4*)(bb + bj * HALF + n * 4);
#pragma unroll
            for (int ai = 0; ai < 2; ++ai) {
                u32x4 y[4];
                const bf16_t* yq = yb + (size_t)(ai * HALF) * LDG + bj * HALF; asm volatile("" : "+v"(yq));
#pragma unroll
                for (int m = 0; m < 4; ++m) y[m] = *(const u32x4*)(yq + (size_t)(m * 16) * LDG);
#pragma unroll
                for (int m = 0; m < 4; ++m) { const f32x4 v0 = acc[ai][bj][m][0] + bg[0], v1 = acc[ai][bj][m][1] + bg[1]; const u32x4 yy = y[m]; u32x4 o;
                    o.x = cvt_pk_bf16(bf_lo(yy.x) * sigmoidf_(v0[0]), bf_hi(yy.x) * sigmoidf_(v0[1])); o.y = cvt_pk_bf16(bf_lo(yy.y) * sigmoidf_(v0[2]), bf_hi(yy.y) * sigmoidf_(v0[3]));
                    o.z = cvt_pk_bf16(bf_lo(yy.z) * sigmoidf_(v1[0]), bf_hi(yy.z) * sigmoidf_(v1[1])); o.w = cvt_pk_bf16(bf_lo(yy.w) * sigmoidf_(v1[2]), bf_hi(yy.w) * sigmoidf_(v1[3]));
                    *(u32x4*)(ob + (size_t)(ai * HALF + m * 16) * 1024 + bj * HALF) = o; }
            }
        }
        return;
    }
    if (d.epi == EPI_S5C) {
#pragma unroll
        for (int ai = 0; ai < 2; ++ai)
#pragma unroll
        for (int m = 0; m < 4; ++m) {
            const int r = rbase + ai * HALF + m * 16;
            if (r < S5ROWS) { const int b = r / NCH, nn = r - b * NCH;
#pragma unroll
                for (int bj = 0; bj < 2; ++bj) { const int c8 = bj * HALF + wc * 32 + 8 * fq, tl = c8 >> 4, ch = c8 & 15; const size_t row = (size_t)b * LP + nn * 16 + tl;
                    const f32x4 v0 = acc[ai][bj][m][0], v1 = acc[ai][bj][m][1]; u32x4 o;
                    o.x = cvt_pk_bf16(gelu_tanh(v0[0]), gelu_tanh(v0[1])); o.y = cvt_pk_bf16(gelu_tanh(v0[2]), gelu_tanh(v0[3])); o.z = cvt_pk_bf16(gelu_tanh(v1[0]), gelu_tanh(v1[1])); o.w = cvt_pk_bf16(gelu_tanh(v1[2]), gelu_tanh(v1[3]));
                    *(u32x4*)((bf16_t*)(ws + WS_YGELU) + row * LDG + u.b * 16 + ch) = o; } }
        }
        return;
    }
    if (d.epi == EPI_WIN) {
        const u64* ssb = (const u64*)(ws + WS_SS) + (size_t)d.ssi * MP;
#pragma unroll
        for (int ai = 0; ai < 2; ++ai)
#pragma unroll
        for (int m = 0; m < 4; ++m) {
            const int r = rbase + ai * HALF + m * 16; const float rsc = row_rs(ssb, r);
#pragma unroll
            for (int bj = 0; bj < 2; ++bj) {
                const int c8 = u.pn * BM + bj * HALF + wc * 32 + 8 * fq;
                const f32x4 v0 = acc[ai][bj][m][0] * rsc, v1 = acc[ai][bj][m][1] * rsc;
                if (u.pn < 16) { u32x4 o; o.x = cvt_pk_bf16(v0[0], v0[1]); o.y = cvt_pk_bf16(v0[2], v0[3]); o.z = cvt_pk_bf16(v1[0], v1[1]); o.w = cvt_pk_bf16(v1[2], v1[3]);
                    if (u.pn < 4) { const int g = c8 >> 4, ch = c8 & 15, b = r / LP, pos = r - b * LP, cr = b * NCH + (pos >> 4), tl = pos & 15;
                        *(u32x4*)((bf16_t*)(ws + WS_UA) + ((size_t)g * S5ROWP + cr) * LDU + tl * 16 + ch) = o; }
                    else *(u32x4*)((bf16_t*)(ws + WS_Z) + (size_t)r * 3072 + (c8 - 1024)) = o; }
                else if (c8 - 4096 < 32) { float* gp = (float*)(ws + WS_G) + (size_t)r * 32 + (c8 - 4096); *(f32x4*)gp = v0; *(f32x4*)(gp + 4) = v1; }
            }
        }
        return;
    }
#pragma unroll
    for (int ai = 0; ai < 2; ++ai)
#pragma unroll
    for (int m = 0; m < 4; ++m) {
        const int r = rbase + ai * HALF + m * 16;
        const float rsc = (d.epi == EPI_WIN) ? row_rs((const u64*)(ws + WS_SS) + (size_t)d.ssi * MP, r) : 1.0f;
#pragma unroll
        for (int bj = 0; bj < 2; ++bj)
#pragma unroll
        for (int n = 0; n < 2; ++n) {
            const int c0 = cbase + bj * HALF + n * 16;
            const f32x4 v = acc[ai][bj][m][n] * rsc;
            switch (d.epi) {
            case EPI_WIN: {
                if (u.pn < 4) { const int g = c0 >> 4, ch = c0 & 15, b = r / LP, pos = r - b * LP, cr = b * NCH + (pos >> 4), tl = pos & 15;
                    store_bf4((bf16_t*)(ws + WS_UA) + ((size_t)g * S5ROWP + cr) * LDU + tl * 16 + ch, v); }
                else if (u.pn < 16) store_bf4((bf16_t*)(ws + WS_Z) + (size_t)r * 3072 + (c0 - 1024), v);
                else if (c0 - 4096 < 32) *(f32x4*)((float*)(ws + WS_G) + (size_t)r * 32 + (c0 - 4096)) = v;
            } break;
            case EPI_S5A: *(f32x4*)((float*)(ws + WS_SLOC) + ((size_t)u.b * S5ROWP + r) * 256 + c0) = v; break;
            case EPI_S5C: {
                if (r < S5ROWS) { const int b = r / NCH, nn = r - b * NCH, tl = c0 >> 4, ch = c0 & 15; const size_t row = (size_t)b * LP + nn * 16 + tl;
                    store_bf4((bf16_t*)(ws + WS_YGELU) + row * LDG + u.b * 16 + ch, (f32x4){gelu_tanh(v[0]), gelu_tanh(v[1]), gelu_tanh(v[2]), gelu_tanh(v[3])}); }
            } break;
            default: break;
            }
        }
    }
}

__device__ __forceinline__ void gemm_phase(const Params& P, LAS unsigned char* lds, const GemmDesc d) {
    const int tid = tid_l(), wid = __builtin_amdgcn_readfirstlane(tid >> 6), lane = tid & 63, wr = wid >> 2, wc = wid & 3, fr = lane & 15, fq = lane >> 4;
    const int K = d.K, nt = K / BK; const int G = d.gG, cblk = d.gc;
    unsigned voffA[2], voffB[2];
#pragma unroll
    for (int i = 0; i < 2; ++i) { int R, C; stage_rc(tid * 16 + i * 8192, R, C); const int Ra = (d.amode && R >= 64) ? R - 2 : R; voffA[i] = (unsigned)(Ra * d.lda + C) * 2u; const int Rb = d.perm ? ((R & ~31) + 8 * ((R & 15) >> 2) + 4 * ((R & 31) >> 4) + (R & 3)) : R; voffB[i] = (unsigned)(Rb * d.ldb + C) * 2u; }
    const size_t kstep = (size_t)(BK * 2);
    const size_t hstepA = (size_t)(d.amode ? 124 : HALF) * d.lda * 2, hstepB = (size_t)HALF * d.ldb * 2;
    const unsigned ldsw = (unsigned)wid * 1024u;
    const int aoff = lds_byte(wr * 64 + fr, fq * 8), boff = lds_byte(wc * 32 + fr, fq * 8);
#define PG8_SA(b, h) (((b) * 2 + (h)) * HTB)
#define PG8_SB(b, h) ((4 + (b) * 2 + (h)) * HTB)
#define PG8_STAGE(bufoff, gbase, voff) do { _Pragma("unroll") for (int _i = 0; _i < 2; ++_i) \
        __builtin_amdgcn_global_load_lds((const unsigned*)((const char*)(gbase) + (voff)[_i]), (LAS unsigned*)(lds + (bufoff) + ldsw + _i * 8192), 16, 0, 0); } while (0)
#define PG8_LDA(dst, b, h) do { _Pragma("unroll") for (int m = 0; m < 4; ++m) _Pragma("unroll") for (int k = 0; k < 2; ++k) dst[m][k] = *(const LAS bf16x8*)(lds + PG8_SA(b, h) + aoff + m * 2048 + k * 1024); } while (0)
#define PG8_LDB(dst, b, h) do { _Pragma("unroll") for (int n = 0; n < 2; ++n) _Pragma("unroll") for (int k = 0; k < 2; ++k) dst[n][k] = *(const LAS bf16x8*)(lds + PG8_SB(b, h) + boff + n * 2048 + k * 1024); } while (0)
#define PG8_MMA(ai, bj, At, Bt) do { __builtin_amdgcn_s_setprio(1); _Pragma("unroll") for (int m = 0; m < 4; ++m) _Pragma("unroll") for (int n = 0; n < 2; ++n) _Pragma("unroll") for (int k = 0; k < 2; ++k) \
        acc[ai][bj][m][n] = __builtin_amdgcn_mfma_f32_16x16x32_bf16(Bt[n][k], At[m][k], acc[ai][bj][m][n], 0, 0, 0); __builtin_amdgcn_s_setprio(0); } while (0)
#define PG8_WAIT_V(n) asm volatile("s_waitcnt vmcnt(" #n ")" ::: "memory")
#define PG8_WAIT_L(n) asm volatile("s_waitcnt lgkmcnt(" #n ")" ::: "memory")
#define PG8_BAR __builtin_amdgcn_s_barrier()
#define PG8_SCHED __builtin_amdgcn_sched_barrier(0)
    Unit cur, nxt; int ui = 0;
    if (!next_unit(d, 0, G, cblk, cur)) return;
    f32x4 acc[2][2][4][2];
#pragma unroll
    for (int a = 0; a < 2; ++a)
#pragma unroll
        for (int b = 0; b < 2; ++b)
#pragma unroll
            for (int m = 0; m < 4; ++m)
#pragma unroll
                for (int n = 0; n < 2; ++n) acc[a][b][m][n] = (f32x4){0.f, 0.f, 0.f, 0.f};
    bf16x8 At[4][2], B0[2][2], B1[2][2];
    const char* cA = (const char*)d.A + ((size_t)cur.b * d.sA) * 2 + (size_t)cur.pm * 2 * hstepA + (size_t)cur.k0 * kstep;
    const char* cB = (const char*)d.Bt + ((size_t)cur.b * d.sB) * 2 + (size_t)cur.pn * 2 * hstepB + (size_t)cur.k0 * kstep;
    PG8_STAGE(PG8_SB(0, 0), cB, voffB); PG8_STAGE(PG8_SA(0, 0), cA, voffA); PG8_STAGE(PG8_SB(0, 1), cB + hstepB, voffB); PG8_STAGE(PG8_SA(0, 1), cA + hstepA, voffA);
    if (wr == 1) PG8_BAR;
    PG8_WAIT_V(4); PG8_BAR;
    PG8_STAGE(PG8_SB(1, 0), cB + kstep, voffB); PG8_STAGE(PG8_SA(1, 0), cA + kstep, voffA); PG8_STAGE(PG8_SB(1, 1), cB + hstepB + kstep, voffB);
    PG8_WAIT_V(6); PG8_BAR;
    for (;;) {
        const bool has_next = next_unit(d, ui + 1, G, cblk, nxt);
        const char* nA = has_next ? (const char*)d.A + ((size_t)nxt.b * d.sA) * 2 + (size_t)nxt.pm * 2 * hstepA + (size_t)nxt.k0 * kstep : cA;
        const char* nB = has_next ? (const char*)d.Bt + ((size_t)nxt.b * d.sB) * 2 + (size_t)nxt.pn * 2 * hstepB + (size_t)nxt.k0 * kstep : cB;
        const int ntu = cur.nt;
        for (int t = 0; t < ntu; t += 2) {
            const bool last = (t == ntu - 2);
            const char* a1 = cA + (size_t)(t + 1) * kstep;
            const char* a2 = last ? nA : cA + (size_t)(t + 2) * kstep; const char* b2 = last ? nB : cB + (size_t)(t + 2) * kstep;
            const char* a3 = a2 + kstep; const char* b3 = b2 + kstep;
            PG8_LDB(B0, 0, 0); PG8_SCHED; PG8_LDA(At, 0, 0); PG8_STAGE(PG8_SA(1, 1), a1 + hstepA, voffA);
            PG8_WAIT_L(8); PG8_BAR; PG8_WAIT_L(0); PG8_MMA(0, 0, At, B0); PG8_BAR; PG8_SCHED;
            PG8_LDB(B1, 0, 1); PG8_STAGE(PG8_SB(0, 0), b2, voffB);
            PG8_BAR; PG8_WAIT_L(0); PG8_MMA(0, 1, At, B1); PG8_BAR;
            PG8_LDA(At, 0, 1); PG8_STAGE(PG8_SA(0, 0), a2, voffA);
            PG8_BAR; PG8_WAIT_L(0); PG8_MMA(1, 0, At, B0); PG8_BAR; PG8_SCHED;
            PG8_STAGE(PG8_SB(0, 1), b2 + hstepB, voffB);
            PG8_WAIT_V(6); PG8_BAR; PG8_MMA(1, 1, At, B1); PG8_BAR;
            PG8_LDB(B0, 1, 0); PG8_SCHED; PG8_LDA(At, 1, 0); PG8_STAGE(PG8_SA(0, 1), a2 + hstepA, voffA);
            PG8_WAIT_L(8); PG8_BAR; PG8_WAIT_L(0); PG8_MMA(0, 0, At, B0); PG8_BAR; PG8_SCHED;
            PG8_LDB(B1, 1, 1); PG8_STAGE(PG8_SB(1, 0), b3, voffB);
            PG8_BAR; PG8_WAIT_L(0); PG8_MMA(0, 1, At, B1); PG8_BAR;
            PG8_LDA(At, 1, 1); PG8_STAGE(PG8_SA(1, 0), a3, voffA);
            PG8_BAR; PG8_WAIT_L(0); PG8_MMA(1, 0, At, B0); PG8_BAR; PG8_SCHED;
            PG8_STAGE(PG8_SB(1, 1), b3 + hstepB, voffB);
            PG8_WAIT_V(6); PG8_BAR; PG8_MMA(1, 1, At, B1); PG8_BAR;
        }
        bool do_epi = true;
        if (cur.piece >= 0) {
            LAUNDER_Z();
            const int t3 = tid_l(); const int w3 = __builtin_amdgcn_readfirstlane(t3 >> 6), l3 = t3 & 63;
            const size_t pstride = (size_t)8 * 32 * 64;
            f32x4* slab = (f32x4*)(P.ws + zz + WS_UA) + ((size_t)(cur.tu * d.split) * 8 + w3) * 32 * 64 + l3;
            {   f32x4* mine = slab + (size_t)cur.piece * pstride;
#pragma unroll
                for (int idx = 0; idx < 32; ++idx) { asm volatile("global_store_dwordx4 %0, %1, off sc1\n\ts_nop 1" :: "v"(mine), "v"(acc[idx >> 4][(idx >> 3) & 1][(idx >> 1) & 3][idx & 1]) : "memory"); mine += 64; } }
            asm volatile("s_waitcnt vmcnt(0)" ::: "memory");
            unsigned old = 0u;
            if (l3 == 0) old = __hip_atomic_fetch_add((unsigned*)(P.ws + zz) + 8192 + cur.tu * 8 + w3, 1u, __ATOMIC_RELAXED, __HIP_MEMORY_SCOPE_AGENT);
            old = (unsigned)__builtin_amdgcn_readfirstlane((int)old);
            do_epi = ((old % (unsigned)d.split) == (unsigned)d.split - 1u);
            if (do_epi) {
                __builtin_amdgcn_fence(__ATOMIC_ACQUIRE, "agent");
                asm volatile("s_waitcnt vmcnt(0)" ::: "memory");
                const f32x4* p = slab;
#pragma unroll
                for (int i4 = 0; i4 < 8; ++i4) { f32x4 t4[4][4];
#pragma unroll
                    for (int j = 0; j < 4; ++j) { asm volatile("" : "+v"(p));
#pragma unroll
                        for (int q = 0; q < 4; ++q) t4[j][q] = p[(size_t)q * pstride];
                        p += 64; }
#pragma unroll
                    for (int j = 0; j < 4; ++j) { const int idx = i4 * 4 + j; acc[idx >> 4][(idx >> 3) & 1][(idx >> 1) & 3][idx & 1] = ((t4[j][0] + t4[j][1]) + t4[j][2]) + t4[j][3]; } }
            }
        }
        if (do_epi) gemm_epilogue(P, d, acc, cur, wr, wc, fr, fq);
        if (!has_next) break;
#pragma unroll
        for (int a = 0; a < 2; ++a)
#pragma unroll
            for (int b = 0; b < 2; ++b)
#pragma unroll
                for (int m = 0; m < 4; ++m)
#pragma unroll
                    for (int n = 0; n < 2; ++n) acc[a][b][m][n] = (f32x4){0.f, 0.f, 0.f, 0.f};
        cur = nxt; cA = nA; cB = nB; ++ui;
    }
    PG8_WAIT_V(0);
    if (wr == 0) PG8_BAR;
    PG8_BAR;
#undef PG8_SA
#undef PG8_SB
#undef PG8_STAGE
#undef PG8_LDA
#undef PG8_LDB
#undef PG8_MMA
#undef PG8_WAIT_V
#undef PG8_WAIT_L
#undef PG8_BAR
#undef PG8_SCHED
}

__device__ __forceinline__ void transpose_item(const float* W, int K, int N, bf16_t* WT, int ldw, LAS float* scr, int item, int lane, const float* gsc, int rowmap = 0) {
    const int nblk = N / 32, kb = item / nblk, nb = item % nblk, k0 = 64 * kb, n0 = 32 * nb;
    float wv[32];
#pragma unroll
    for (int i = 0; i < 32; ++i) { const int kk = 2 * i + (lane >> 5); wv[i] = W[(size_t)(k0 + kk) * N + n0 + (lane & 31)]; }
#pragma unroll
    for (int i = 0; i < 32; ++i) { const int kk = 2 * i + (lane >> 5); const float gg = gsc ? gsc[k0 + kk] : 1.0f; scr[kk * 33 + (lane & 31)] = wv[i] * gg; }
    asm volatile("s_waitcnt lgkmcnt(0)" ::: "memory");
    const int c = lane & 7;
#pragma unroll
    for (int j = 0; j < 4; ++j) { const int n = (lane >> 3) + 8 * j; const LAS float* s = scr + (8 * c) * 33 + n;
        u32x4 o; o.x = cvt_pk_bf16(s[0 * 33], s[1 * 33]); o.y = cvt_pk_bf16(s[2 * 33], s[3 * 33]); o.z = cvt_pk_bf16(s[4 * 33], s[5 * 33]); o.w = cvt_pk_bf16(s[6 * 33], s[7 * 33]);
        const int nr = n0 + n; const int dr = rowmap ? ((nr >> 7) * 256 + (nr & 127) + (rowmap == 2 ? 128 : 0)) : nr;
        *(u32x4*)(WT + (size_t)dr * ldw + k0 + 8 * c) = o; }
    asm volatile("s_waitcnt lgkmcnt(0)" ::: "memory");
}

__device__ __forceinline__ void norm_row_bf16(const float* hrow, const float* g, bf16_t* orow, int lane, bool pad) {
    u32x2* o8 = (u32x2*)orow + lane;
    if (pad) {
#pragma unroll
        for (int j = 0; j < 8; ++j) o8[64 * j] = (u32x2){0u, 0u};
        return; }
    const f32x4* xr = (const f32x4*)hrow + lane; const f32x4* gr = (const f32x4*)g + lane;
    f32x4 v[8]; float s = 0.f;
#pragma unroll
    for (int j = 0; j < 8; ++j) { v[j] = xr[64 * j]; s += (v[j][0] * v[j][0] + v[j][1] * v[j][1]) + (v[j][2] * v[j][2] + v[j][3] * v[j][3]); }
    const float rs = rsqrtf(wave_sum(s, lane) * (1.0f / DM) + EPSN);
#pragma unroll
    for (int j = 0; j < 8; ++j) { const f32x4 gg = gr[64 * j]; u32x2 w; w.x = cvt_pk_bf16(v[j][0] * rs * gg[0], v[j][1] * rs * gg[1]); w.y = cvt_pk_bf16(v[j][2] * rs * gg[2], v[j][3] * rs * gg[3]); o8[64 * j] = w; }
}

__device__ __forceinline__ void zero_rows16(void* p, int n16, int gt, int NGT) { unsigned z0 = 0u; asm volatile("" : "+v"(z0)); u32x4* z = (u32x4*)p; for (int i = gt; i < n16; i += NGT) z[i] = (u32x4){z0, z0, z0, z0}; }
__device__ __forceinline__ void phase_init_rows(const Params& P) {
    LAUNDER_Z();
    const int lane = tid_l() & 63, gw = bid_l() * 8 + (tid_l() >> 6), NGW = gridDim.x * 8;
    float* H = (float*)(P.ws + zz + WS_H); bf16_t* HN = (bf16_t*)(P.ws + zz + WS_HN); u64* SS = (u64*)(P.ws + zz + WS_SS);
    float zf = 0.f; asm volatile("" : "+v"(zf));
    for (int r = gw; r < MP; r += NGW) {
        const int b = r / LP, pos = r - b * LP; f32x4* o = (f32x4*)(H + (size_t)r * DM) + lane; u32x2* o8 = (u32x2*)(HN + (size_t)r * LDH) + lane;
        if (pos < PADF) {
#pragma unroll
            for (int j = 0; j < 8; ++j) { o[64 * j] = (f32x4){zf, zf, zf, zf}; o8[64 * j] = (u32x2){__float_as_uint(zf), __float_as_uint(zf)}; }
            if (lane == 0) SS[r] = (u64)__float_as_uint(zf);
        } else {
            const float* src = pos < 64 ? PIN(1) + (size_t)(pos - PADF) * DM : PIN(0) + ((size_t)b * 2048 + (pos - 64)) * DM;
            const f32x4* s4 = (const f32x4*)src + lane; float sq = 0.f;
#pragma unroll
            for (int j = 0; j < 8; ++j) { const f32x4 v = s4[64 * j]; o[64 * j] = v; u32x2 w; w.x = cvt_pk_bf16(v[0], v[1]); w.y = cvt_pk_bf16(v[2], v[3]); o8[64 * j] = w; sq += (v[0] * v[0] + v[1] * v[1]) + (v[2] * v[2] + v[3] * v[3]); }
            sq = wave_sum(sq, lane); if (lane == 0) SS[r] = (u64)(sq * SSCALE);
        }
    }
    const int gt = bid_l() * 512 + tid_l(), NGT = gridDim.x * 512;
    for (int i = gt; i < 8 * MP; i += NGT) SS[MP + i] = (u64)__float_as_uint(zf);
    zero_rows16((bf16_t*)(P.ws + zz + WS_HN) - LDH, LDH / 8, gt, NGT); zero_rows16((bf16_t*)(P.ws + zz + WS_HN) + (size_t)MP * LDH, 256 * LDH / 8, gt, NGT);
    zero_rows16((bf16_t*)(P.ws + zz + WS_WSET + WO_WIN) + (size_t)DIN * LDH, (DINP - DIN) * LDH / 8, gt, NGT);
    zero_rows16((bf16_t*)((unsigned char*)P.out + zz + WO_WIN) + (size_t)DIN * LDH, (DINP - DIN) * LDH / 8, gt, NGT);
}

__device__ __forceinline__ void s5_precompute(const Params& P, LAS unsigned char* lds, int l, int g) {
    LAS float* lpr = (LAS float*)lds;
    LAS float* lpi = lpr + 2 * 17 * 64;
    LAS float* bbr = lpi + 2 * 17 * 64;
    LAS float* bbi = bbr + 2048;
    LAS float* ccr = bbi + 2048;
    LAS float* cci = ccr + 2048;
    LAS float* zr = cci + 2048;
    LAS float* zi = zr + 128;
    LAS float* kd = zi + 128;
    LAUNDER_Z();
    const int tid = tid_l();
    if (tid < 128) {
        const int dir = tid >> 6, p = tid & 63; const size_t o = ((size_t)(l * 2 + dir) * 64 + g) * 64 + p;
        const float are = fminf(PIN(4)[o], -1e-4f), aim = PIN(5)[o], dt = expf(PIN(6)[(size_t)(l * 2 + dir) * 64 + g]);
        const float mag = expf(are * dt); float sn, cs; sincosf(aim * dt, &sn, &cs); const float lr = mag * cs, li = mag * sn;
        { float pr = 1.0f, pi = 0.0f;
          for (int dd = 0; dd <= 16; ++dd) { lpr[(dir * 17 + dd) * 64 + p] = pr; lpi[(dir * 17 + dd) * 64 + p] = pi; const float nr = pr * lr - pi * li, ni = pr * li + pi * lr; pr = nr; pi = ni; } }
        const float den = are * are + aim * aim, pp = lr - 1.0f;
        zr[dir * 64 + p] = (pp * are + li * aim) / den; zi[dir * 64 + p] = (li * are - pp * aim) / den;
    }
    __syncthreads();
    for (int e = tid; e < 2048; e += 512) { const int dir = e >> 10, p = (e >> 4) & 63, h = e & 15; const size_t o = (((size_t)(l * 2 + dir) * 64 + g) * 64 + p) * 16 + h;
        const float br = PIN(7)[o], bi = PIN(8)[o], z_r = zr[dir * 64 + p], z_i = zi[dir * 64 + p];
        bbr[e] = z_r * br - z_i * bi; bbi[e] = z_r * bi + z_i * br; }
    for (int e = tid; e < 2048; e += 512) { const int dir = e >> 10, h = (e >> 6) & 15, p = e & 63; const size_t o = (((size_t)(l * 2 + dir) * 64 + g) * 16 + h) * 64 + p;
        ccr[e] = PIN(9)[o]; cci[e] = PIN(10)[o]; }
    __syncthreads();
    for (int e = tid; e < 8192; e += 512) { const int dir = e >> 12, dd = (e >> 8) & 15, h = (e >> 4) & 15, h2 = e & 15; float s = 0.f;
        for (int p = 0; p < 64; ++p) { const float cr = ccr[(dir * 16 + h) * 64 + p], ci = cci[(dir * 16 + h) * 64 + p], lr = lpr[(dir * 17 + dd) * 64 + p], li = lpi[(dir * 17 + dd) * 64 + p];
            const float ur = cr * lr - ci * li, ui = cr * li + ci * lr; s += ur * bbr[(dir * 64 + p) * 16 + h2] - ui * bbi[(dir * 64 + p) * 16 + h2]; }
        kd[e] = s; }
    __syncthreads();
    bf16_t* WST = (bf16_t*)(P.ws + zz + WS_WST) + ((size_t)l * 64 + g) * (256 * LDWS);
    for (int e8 = tid; e8 < 8192; e8 += 512) { const int n = e8 >> 5, k0 = (e8 & 31) * 8; const int part = n >> 6, p = n & 63, dir = part >> 1; float v[8];
#pragma unroll
        for (int j = 0; j < 8; ++j) { const int k = k0 + j, s = k >> 4, h2 = k & 15, pw = dir == 0 ? 15 - s : s; const float lr = lpr[(dir * 17 + pw) * 64 + p], li = lpi[(dir * 17 + pw) * 64 + p], br = bbr[(dir * 64 + p) * 16 + h2], bi = bbi[(dir * 64 + p) * 16 + h2];
            v[j] = (part & 1) ? (lr * bi + li * br) : (lr * br - li * bi); }
        u32x4 o; o.x = cvt_pk_bf16(v[0], v[1]); o.y = cvt_pk_bf16(v[2], v[3]); o.z = cvt_pk_bf16(v[4], v[5]); o.w = cvt_pk_bf16(v[6], v[7]);
        *(u32x4*)(WST + (size_t)n * LDWS + k0) = o; }
    bf16_t* TO = (bf16_t*)(P.ws + zz + WS_TO) + ((size_t)l * 64 + g) * (256 * LDTO);
    const float* dsk = PIN(11) + ((size_t)l * 64 + g) * 16;
    for (int e8 = tid; e8 < 16384; e8 += 512) { const int n = e8 >> 6, k0 = (e8 & 63) * 8; const int t = n >> 4, h = n & 15; float v[8];
#pragma unroll
        for (int j = 0; j < 8; ++j) { const int k = k0 + j;
            if (k < 256) { const int s = k >> 4, h2 = k & 15;
                if (t > s) v[j] = kd[((0 * 16 + (t - s)) * 16 + h) * 16 + h2];
                else if (t < s) v[j] = kd[((1 * 16 + (s - t)) * 16 + h) * 16 + h2];
                else v[j] = kd[((0 * 16 + 0) * 16 + h) * 16 + h2] + kd[((1 * 16 + 0) * 16 + h) * 16 + h2] + (h == h2 ? dsk[h] : 0.f);
            } else { const int kk = k - 256, part = kk >> 6, p = kk & 63, dir = part >> 1, pw = dir == 0 ? t + 1 : 16 - t;
                const float cr = ccr[(dir * 16 + h) * 64 + p], ci = cci[(dir * 16 + h) * 64 + p], lr = lpr[(dir * 17 + pw) * 64 + p], li = lpi[(dir * 17 + pw) * 64 + p];
                v[j] = (part & 1) ? -(cr * li + ci * lr) : (cr * lr - ci * li); } }
        u32x4 o; o.x = cvt_pk_bf16(v[0], v[1]); o.y = cvt_pk_bf16(v[2], v[3]); o.z = cvt_pk_bf16(v[4], v[5]); o.w = cvt_pk_bf16(v[6], v[7]);
        *(u32x4*)(TO + (size_t)n * LDTO + k0) = o; }
    __syncthreads();
}

__device__ __forceinline__ unsigned char* wset_base(const Params& P, int l, int zz) { return (l & 1) ? (unsigned char*)P.out + zz : P.ws + zz + WS_WSET; }
__device__ __forceinline__ void convert_weights(const Params& P, LAS unsigned char* lds, int l, int gw, int NGW, int wave, int lane, int it_lo = 0, int it_hi = 1 << 30) {
    LAUNDER_Z();
    unsigned char* wb = wset_base(P, l, zz);
    LAS float* scr = (LAS float*)(lds + wave * 16384);
    constexpr int I_IN = 32 * 129, I_GLU = 16 * 32, I_OUT = 32 * 64, I_G = 32 * 176, I_DN = 88 * 64, NIT = I_IN + I_GLU + I_OUT + 2 * I_G + I_DN;
    const int ihi = it_hi < NIT ? it_hi : NIT;
    for (int it = it_lo + gw; it < ihi; it += NGW) { int r = it;
        if (r < I_IN) { transpose_item(PIN(3) + (size_t)l * DM * DIN, DM, DIN, (bf16_t*)(wb + WO_WIN), LDH, scr, r, lane, PIN(2) + (size_t)l * DM); continue; } r -= I_IN;
        if (r < I_GLU) { transpose_item(PIN(12) + (size_t)l * 1024 * 1024, 1024, 1024, (bf16_t*)(wb + WO_WGLU), LDG, scr, r, lane, nullptr); continue; } r -= I_GLU;
        if (r < I_OUT) { transpose_item(PIN(19) + (size_t)l * DM * DM, DM, DM, (bf16_t*)(wb + WO_WOUT), LDH, scr, r, lane, nullptr); continue; } r -= I_OUT;
        if (r < I_G) { transpose_item(PIN(21) + (size_t)l * DM * DFF, DM, DFF, (bf16_t*)(wb + WO_WGU), LDH, scr, r, lane, PIN(20) + (size_t)l * DM, 1); continue; } r -= I_G;
        if (r < I_G) { transpose_item(PIN(22) + (size_t)l * DM * DFF, DM, DFF, (bf16_t*)(wb + WO_WGU), LDH, scr, r, lane, PIN(20) + (size_t)l * DM, 2); continue; } r -= I_G;
        transpose_item(PIN(25) + (size_t)l * DFF * DM, DFF, DM, (bf16_t*)(wb + WO_WDN), LDF, scr, r, lane, nullptr);
    }
}

__device__ __forceinline__ void phase_s5_scan(const Params& P, int l, int bofs) {
    LAUNDER_Z();
    const int t = tid_l(); if (t >= 128) return;
    const int idx = (bid_l() - bofs) * 128 + t; if (idx >= 16384 || idx < 0) return;
    const int p4 = idx & 15, dir = (idx >> 4) & 1, b = (idx >> 5) & 7, g = idx >> 8;
    const size_t o = ((size_t)(l * 2 + dir) * 64 + g) * 64 + 4 * p4;
    const float dt = expf(PIN(6)[(size_t)(l * 2 + dir) * 64 + g]);
    f32x4 Lr, Li;
#pragma unroll
    for (int j = 0; j < 4; ++j) { const float are = fminf(PIN(4)[o + j], -1e-4f), aim = PIN(5)[o + j]; const float mag = expf(are * dt * 16.0f); float sn, cs; sincosf(aim * dt * 16.0f, &sn, &cs); Lr[j] = mag * cs; Li[j] = mag * sn; }
    const f32x4* sl = (const f32x4*)((const float*)(P.ws + zz + WS_SLOC) + ((size_t)g * S5ROWP + b * NCH) * 256 + dir * 128 + 4 * p4);
    bf16_t* so = (bf16_t*)(P.ws + zz + WS_UA) + ((size_t)g * S5ROWP + b * NCH) * LDU + 256 + dir * 128 + 4 * p4;
    f32x4 sr = (f32x4){0.f, 0.f, 0.f, 0.f}, si = (f32x4){0.f, 0.f, 0.f, 0.f};
    for (int blk = 0; blk < 11; ++blk) {
        f32x4 xr[12], xi[12];
#pragma unroll
        for (int j = 0; j < 12; ++j) { const int i = blk * 12 + j, n = dir == 0 ? i : NCH - 1 - i; xr[j] = sl[(size_t)n * 64]; xi[j] = sl[(size_t)n * 64 + 16]; }
#pragma unroll
        for (int j = 0; j < 12; ++j) { const int i = blk * 12 + j, n = dir == 0 ? i : NCH - 1 - i;
            u32x2 wr_, wi_; wr_.x = cvt_pk_bf16(sr[0], sr[1]); wr_.y = cvt_pk_bf16(sr[2], sr[3]); wi_.x = cvt_pk_bf16(si[0], si[1]); wi_.y = cvt_pk_bf16(si[2], si[3]);
            *(u32x2*)(so + (size_t)n * LDU) = wr_; *(u32x2*)(so + (size_t)n * LDU + 64) = wi_;
            const f32x4 nr = Lr * sr - Li * si + xr[j], ni = Lr * si + Li * sr + xi[j]; sr = nr; si = ni; }
    }
}

constexpr int MLS = 72;
__device__ __forceinline__ f32x4 mma_tile(const LAS bf16_t* A, const LAS bf16_t* Bt, int fr, int fq, f32x4 acc) {
#pragma unroll
    for (int kk = 0; kk < 2; ++kk) { const bf16x8 a = *(const LAS bf16x8*)(A + fr * MLS + kk * 32 + fq * 8); const bf16x8 b = *(const LAS bf16x8*)(Bt + fr * MLS + kk * 32 + fq * 8);
        acc = __builtin_amdgcn_mfma_f32_16x16x32_bf16(a, b, acc, 0, 0, 0); }
    return acc;
}
__device__ __forceinline__ void phase_mlstm(const Params& P, LAS unsigned char* lds, int l) {
    LAUNDER_Z();
    const int tid = tid_l(), lane = tid & 63, w = tid >> 6, fr = lane & 15, fq = lane >> 4; unsigned char* ws = P.ws + zz;
    LAS bf16_t* Qs = (LAS bf16_t*)lds;
    LAS bf16_t* Ks = Qs + 64 * MLS;
    LAS bf16_t* Kw = Ks + 64 * MLS;
    LAS bf16_t* Ss = Kw + 64 * MLS;
    LAS bf16_t* Vt = Ss + 64 * MLS;
    LAS bf16_t* Ct = Vt + 160 * MLS;
    LAS float* den = (LAS float*)(Ct + 160 * MLS);
    LAS float* CW = den + 64;
    const bf16_t* Z = (const bf16_t*)(ws + WS_Z); const float* Gt = (const float*)(ws + WS_G);
    const int nmb = gridDim.x >= 256 ? 128 : gridDim.x;
    if (bid_l() >= nmb) return;
    for (int item = bid_l(); item < 128; item += nmb) {
        const int dir = item & 1, hd = (item >> 1) & 7, b = item >> 4;
        __syncthreads();
        for (int e = tid; e < 160 * MLS; e += 512) Ct[e] = 0;
        for (int e = tid; e < 32 * MLS; e += 512) Vt[128 * MLS + e] = (e < 64) ? (bf16_t)0x3F80 : (bf16_t)0;
        f32x4 Cst[5];
#pragma unroll
        for (int j = 0; j < 5; ++j) Cst[j] = (f32x4){0.f, 0.f, 0.f, 0.f};
        float m_prev = -1e30f;
        const float gb_i = PIN(17)[l * 32 + (2 * dir) * 8 + hd], gb_f = PIN(17)[l * 32 + (2 * dir + 1) * 8 + hd];
        bf16_t* Hout = (bf16_t*)(ws + WS_HFB) + (size_t)dir * MP * 1024;
        for (int e = tid; e < 512; e += 512) { const int rr = e >> 7, c = e & 127; const int colz = (c < 64 ? hd * 64 + c : 512 + hd * 64 + (c - 64));
            CW[e] = rr < 3 ? PIN(15)[(size_t)l * 3 * 1024 + rr * 1024 + colz] : PIN(16)[(size_t)l * 1024 + colz]; }
        const int wu = __builtin_amdgcn_readfirstlane(w);
        const int colz = (wu < 4 ? hd * 64 + wu * 16 : 512 + hd * 64 + (wu - 4) * 16);
        const int myoff = dir == 0 ? lane : 63 - lane;
        const int gcol_i = (2 * dir) * 8 + hd, gcol_f = (2 * dir + 1) * 8 + hd;
        u32x4 pz[8]; float pg_i, pg_f;
#define ML_PREFETCH(cx) do { const int n_ = dir == 0 ? (cx) : 32 - (cx); const size_t r_ = (size_t)(b * LP + n_ * 64 + myoff); \
            const bf16_t* zp_ = Z + r_ * 3072 + colz; const bf16_t* vp_ = Z + r_ * 3072 + 1024 + hd * 128 + wu * 16; \
            pz[0] = *(const u32x4*)(zp_ - 3072); pz[1] = *(const u32x4*)(zp_ - 3072 + 8); pz[2] = *(const u32x4*)(zp_); pz[3] = *(const u32x4*)(zp_ + 8); \
            pz[4] = *(const u32x4*)(zp_ + 3072); pz[5] = *(const u32x4*)(zp_ + 3072 + 8); pz[6] = *(const u32x4*)(vp_); pz[7] = *(const u32x4*)(vp_ + 8); \
            pg_i = Gt[r_ * 32 + gcol_i]; pg_f = Gt[r_ * 32 + gcol_f]; } while (0)
        ML_PREFETCH(0);
        __syncthreads();
        for (int cix = 0; cix < 33; ++cix) {
            const int n = dir == 0 ? cix : 32 - cix;
            const int rowbase = b * LP + n * 64;
            u32x4 cz[8];
#pragma unroll
            for (int j = 0; j < 8; ++j) cz[j] = pz[j];
            const float cg_i = pg_i, cg_f = pg_f;
            if (cix + 1 < 33) ML_PREFETCH(cix + 1);
            const bool mypad = (n * 64 + myoff) < PADF;
            float li = cg_i + gb_i;
            const float xf = cg_f + gb_f;
            float lf = fminf(xf, 0.f) - log1pf(__expf(-fabsf(xf)));
            if (mypad) { li = -1e30f; lf = 0.f; }
            float bc = lf;
#pragma unroll
            for (int o = 1; o < 64; o <<= 1) { const float t = shi(bc, lane - o); if (lane >= o) bc += t; }
            const float gsum = shi(bc, 63);
            const float m_loc = wave_max(gsum - bc + li, lane);
            const float wloc = __expf(gsum - bc + li - m_loc);
            const float cv = li - bc;
            float pm = cv;
#pragma unroll
            for (int o = 1; o < 64; o <<= 1) { const float t = shi(pm, lane - o); if (lane >= o) pm = fmaxf(pm, t); }
            const float Mt = fmaxf(m_prev, pm);
            const float sint = __expf(m_prev - Mt);
            const float einv = __expf(-(bc + Mt));
            const float m_new = fmaxf(gsum + m_prev, m_loc);
            const float s_old = __expf(gsum + m_prev - m_new), s_loc = __expf(m_loc - m_new);
            {
                const int i = lane; const bool pad = mypad;
                const unsigned um[8] = {cz[0].x, cz[0].y, cz[0].z, cz[0].w, cz[1].x, cz[1].y, cz[1].z, cz[1].w};
                const unsigned u0[8] = {cz[2].x, cz[2].y, cz[2].z, cz[2].w, cz[3].x, cz[3].y, cz[3].z, cz[3].w};
                const unsigned up[8] = {cz[4].x, cz[4].y, cz[4].z, cz[4].w, cz[5].x, cz[5].y, cz[5].z, cz[5].w};
                float qv[16];
#pragma unroll
                for (int j4 = 0; j4 < 4; ++j4) {
                    const f32x4 w0 = *(const LAS f32x4*)(CW + 0 * 128 + wu * 16 + j4 * 4), w1 = *(const LAS f32x4*)(CW + 1 * 128 + wu * 16 + j4 * 4), w2 = *(const LAS f32x4*)(CW + 2 * 128 + wu * 16 + j4 * 4), bb = *(const LAS f32x4*)(CW + 3 * 128 + wu * 16 + j4 * 4);
#pragma unroll
                    for (int jj = 0; jj < 2; ++jj) { const int j = j4 * 2 + jj;
                        const float x0 = bb[2 * jj] + w0[2 * jj] * bf_lo(um[j]) + w1[2 * jj] * bf_lo(u0[j]) + w2[2 * jj] * bf_lo(up[j]);
                        const float x1 = bb[2 * jj + 1] + w0[2 * jj + 1] * bf_hi(um[j]) + w1[2 * jj + 1] * bf_hi(u0[j]) + w2[2 * jj + 1] * bf_hi(up[j]);
                        qv[2 * j] = pad ? 0.f : siluf_(x0); qv[2 * j + 1] = pad ? 0.f : siluf_(x1); } }
                if (wu < 4) {
                    u32x4 o0, o1; o0.x = cvt_pk_bf16(qv[0] * 0.125f, qv[1] * 0.125f); o0.y = cvt_pk_bf16(qv[2] * 0.125f, qv[3] * 0.125f); o0.z = cvt_pk_bf16(qv[4] * 0.125f, qv[5] * 0.125f); o0.w = cvt_pk_bf16(qv[6] * 0.125f, qv[7] * 0.125f);
                    o1.x = cvt_pk_bf16(qv[8] * 0.125f, qv[9] * 0.125f); o1.y = cvt_pk_bf16(qv[10] * 0.125f, qv[11] * 0.125f); o1.z = cvt_pk_bf16(qv[12] * 0.125f, qv[13] * 0.125f); o1.w = cvt_pk_bf16(qv[14] * 0.125f, qv[15] * 0.125f);
                    *(LAS u32x4*)(Qs + i * MLS + wu * 16) = o0; *(LAS u32x4*)(Qs + i * MLS + wu * 16 + 8) = o1;
                } else {
                    const int d0 = (wu - 4) * 16;
                    u32x4 o0, o1; o0.x = cvt_pk_bf16(qv[0], qv[1]); o0.y = cvt_pk_bf16(qv[2], qv[3]); o0.z = cvt_pk_bf16(qv[4], qv[5]); o0.w = cvt_pk_bf16(qv[6], qv[7]);
                    o1.x = cvt_pk_bf16(qv[8], qv[9]); o1.y = cvt_pk_bf16(qv[10], qv[11]); o1.z = cvt_pk_bf16(qv[12], qv[13]); o1.w = cvt_pk_bf16(qv[14], qv[15]);
                    *(LAS u32x4*)(Ks + i * MLS + d0) = o0; *(LAS u32x4*)(Ks + i * MLS + d0 + 8) = o1;
#pragma unroll
                    for (int j = 0; j < 16; ++j) Kw[(d0 + j) * MLS + i] = f2bf(qv[j] * wloc);
                }
                const unsigned uv[8] = {cz[6].x, cz[6].y, cz[6].z, cz[6].w, cz[7].x, cz[7].y, cz[7].z, cz[7].w};
#pragma unroll
                for (int j = 0; j < 8; ++j) { Vt[(wu * 16 + 2 * j) * MLS + i] = pad ? (bf16_t)0 : (bf16_t)(uv[j] & 0xffffu); Vt[(wu * 16 + 2 * j + 1) * MLS + i] = pad ? (bf16_t)0 : (bf16_t)(uv[j] >> 16); }
            }
            __syncthreads();
            {
                const int st = w & 3;
#pragma unroll
                for (int jj = 0; jj < 2; ++jj) { const int tt = (w >> 2) * 2 + jj;
                    f32x4 a = (f32x4){0.f, 0.f, 0.f, 0.f};
                    a = mma_tile(Ks + st * 16 * MLS, Qs + tt * 16 * MLS, fr, fq, a);
                    const int t = tt * 16 + fr, s0 = st * 16 + 4 * fq; const float Mtt = shi(Mt, t);
                    f32x4 o;
#pragma unroll
                    for (int j = 0; j < 4; ++j) { const float cs = shi(cv, s0 + j); o[j] = (s0 + j <= t) ? a[j] * __expf(cs - Mtt) : 0.f; }
                    u32x2 pk; pk.x = cvt_pk_bf16(o[0], o[1]); pk.y = cvt_pk_bf16(o[2], o[3]);
                    *(LAS u32x2*)(Ss + t * MLS + s0) = pk; }
            }
            __syncthreads();
            f32x4 num[5];
            const int tt = w & 3, tC = tt * 16 + fr; const float sint_t = shi(sint, tC), einv_t = shi(einv, tC);
#pragma unroll
            for (int j = 0; j < 5; ++j) { const int dvt = (w >> 2) * 5 + j;
                f32x4 a1 = (f32x4){0.f, 0.f, 0.f, 0.f}, a2 = (f32x4){0.f, 0.f, 0.f, 0.f};
                a1 = mma_tile(Vt + dvt * 16 * MLS, Ss + tt * 16 * MLS, fr, fq, a1);
                a2 = mma_tile(Ct + dvt * 16 * MLS, Qs + tt * 16 * MLS, fr, fq, a2);
                num[j] = a1 + a2 * sint_t;
                if (dvt == 8 && fq == 0) den[tC] = num[j][0]; }
            __syncthreads();
            {
                const float dn = den[tC]; const float inv = 1.0f / fmaxf(fabsf(dn), einv_t);
                const int off = dir == 0 ? tC : 63 - tC; const size_t r = (size_t)rowbase + off;
#pragma unroll
                for (int j = 0; j < 5; ++j) { const int dvt = (w >> 2) * 5 + j;
                    if (dvt < 8) store_bf4(Hout + r * 1024 + hd * 128 + dvt * 16 + 4 * fq, num[j] * inv); }
            }
            {
                const int dkt = w & 3;
#pragma unroll
                for (int j = 0; j < 5; ++j) { const int dvt = (w >> 2) * 5 + j;
                    f32x4 a = (f32x4){0.f, 0.f, 0.f, 0.f};
                    a = mma_tile(Kw + dkt * 16 * MLS, Vt + dvt * 16 * MLS, fr, fq, a);
                    Cst[j] = Cst[j] * s_old + a * s_loc;
                    u32x2 pk; pk.x = cvt_pk_bf16(Cst[j][0], Cst[j][1]); pk.y = cvt_pk_bf16(Cst[j][2], Cst[j][3]);
                    *(LAS u32x2*)(Ct + (dvt * 16 + fr) * MLS + dkt * 16 + 4 * fq) = pk; }
            }
            m_prev = m_new;
            __syncthreads();
        }
    }
}

__device__ __forceinline__ void phase_finalize(const Params& P, int l) {
    LAUNDER_Z();
    const int tid = tid_l(), lane = tid & 63, gw = bid_l() * 8 + (tid >> 6), NGW = gridDim.x * 8; unsigned char* ws = P.ws + zz;
    const bf16_t* YG = (const bf16_t*)(ws + WS_YGLU); const bf16_t* HF = (const bf16_t*)(ws + WS_HFB); const bf16_t* HB = HF + (size_t)MP * 1024;
    const bf16_t* Z = (const bf16_t*)(ws + WS_Z); bf16_t* Y = (bf16_t*)(ws + WS_Y);
    float g1[16], g2[16];
    { const f32x4* p1 = (const f32x4*)(PIN(14) + (size_t)l * 1024 + lane * 16); const f32x4* p2 = (const f32x4*)(PIN(18) + (size_t)l * 1024 + lane * 16);
#pragma unroll
      for (int j = 0; j < 4; ++j) { const f32x4 a = p1[j], b = p2[j]; g1[4 * j] = a[0]; g1[4 * j + 1] = a[1]; g1[4 * j + 2] = a[2]; g1[4 * j + 3] = a[3]; g2[4 * j] = b[0]; g2[4 * j + 1] = b[1]; g2[4 * j + 2] = b[2]; g2[4 * j + 3] = b[3]; } }
    for (int r = gw; r < MP; r += NGW) {
        u32x4* yo = (u32x4*)(Y + (size_t)r * LDH);
        if ((r % LP) < PADF) { unsigned z0 = 0u; asm volatile("" : "+v"(z0)); for (int j = 0; j < 4; ++j) yo[lane + 64 * j] = (u32x4){z0, z0, z0, z0}; continue; }
        const size_t o = (size_t)r * 1024 + lane * 16;
        const u32x4 f0 = *(const u32x4*)(HF + o), f1 = *(const u32x4*)(HF + o + 8), b0 = *(const u32x4*)(HB + o), b1 = *(const u32x4*)(HB + o + 8);
        const u32x4 q0 = *(const u32x4*)(Z + (size_t)r * 3072 + 2048 + lane * 16), q1 = *(const u32x4*)(Z + (size_t)r * 3072 + 2048 + lane * 16 + 8);
        {
            const u32x4 a0 = *(const u32x4*)(YG + (size_t)r * 1024 + lane * 16), a1 = *(const u32x4*)(YG + (size_t)r * 1024 + lane * 16 + 8);
            const unsigned uu[8] = {a0.x, a0.y, a0.z, a0.w, a1.x, a1.y, a1.z, a1.w}; float v[16]; float s = 0.f;
#pragma unroll
            for (int j = 0; j < 8; ++j) { v[2 * j] = bf_lo(uu[j]); v[2 * j + 1] = bf_hi(uu[j]); s += v[2 * j] * v[2 * j] + v[2 * j + 1] * v[2 * j + 1]; }
            const float rs = rsqrtf(wave_sum(s, lane) * (1.0f / 1024.0f) + EPSN);
            const float* g = g1;
            u32x4 o0, o1; o0.x = cvt_pk_bf16(v[0] * rs * g[0], v[1] * rs * g[1]); o0.y = cvt_pk_bf16(v[2] * rs * g[2], v[3] * rs * g[3]); o0.z = cvt_pk_bf16(v[4] * rs * g[4], v[5] * rs * g[5]); o0.w = cvt_pk_bf16(v[6] * rs * g[6], v[7] * rs * g[7]);
            o1.x = cvt_pk_bf16(v[8] * rs * g[8], v[9] * rs * g[9]); o1.y = cvt_pk_bf16(v[10] * rs * g[10], v[11] * rs * g[11]); o1.z = cvt_pk_bf16(v[12] * rs * g[12], v[13] * rs * g[13]); o1.w = cvt_pk_bf16(v[14] * rs * g[14], v[15] * rs * g[15]);
            yo[lane * 2] = o0; yo[lane * 2 + 1] = o1;
        }
        {
            const unsigned uf[8] = {f0.x, f0.y, f0.z, f0.w, f1.x, f1.y, f1.z, f1.w}, ub[8] = {b0.x, b0.y, b0.z, b0.w, b1.x, b1.y, b1.z, b1.w}, uo[8] = {q0.x, q0.y, q0.z, q0.w, q1.x, q1.y, q1.z, q1.w};
            float v[16]; float s = 0.f;
#pragma unroll
            for (int j = 0; j < 8; ++j) { v[2 * j] = bf_lo(uf[j]) + bf_lo(ub[j]); v[2 * j + 1] = bf_hi(uf[j]) + bf_hi(ub[j]); s += v[2 * j] * v[2 * j] + v[2 * j + 1] * v[2 * j + 1]; }
            s += shx(s, 1, lane); s += shx(s, 2, lane); s += shx(s, 4, lane);
            const float rs = rsqrtf(s * (1.0f / 128.0f) + EPSN);
            const float* g = g2;
            float ov[16];
#pragma unroll
            for (int j = 0; j < 8; ++j) { ov[2 * j] = sigmoidf_(bf_lo(uo[j])) * v[2 * j] * rs * g[2 * j]; ov[2 * j + 1] = sigmoidf_(bf_hi(uo[j])) * v[2 * j + 1] * rs * g[2 * j + 1]; }
            u32x4 o0, o1; o0.x = cvt_pk_bf16(ov[0], ov[1]); o0.y = cvt_pk_bf16(ov[2], ov[3]); o0.z = cvt_pk_bf16(ov[4], ov[5]); o0.w = cvt_pk_bf16(ov[6], ov[7]);
            o1.x = cvt_pk_bf16(ov[8], ov[9]); o1.y = cvt_pk_bf16(ov[10], ov[11]); o1.z = cvt_pk_bf16(ov[12], ov[13]); o1.w = cvt_pk_bf16(ov[14], ov[15]);
            yo[128 + lane * 2] = o0; yo[128 + lane * 2 + 1] = o1;
        }
    }
}

__device__ __forceinline__ void phase_final(const Params& P) {
    LAUNDER_Z();
    const int lane = tid_l() & 63, gw = bid_l() * 8 + (tid_l() >> 6), NGW = gridDim.x * 8;
    const float* H = (const float*)(P.ws + zz + WS_H);
    for (int q = gw; q < NB * 2048; q += NGW) {
        const int b = q >> 11, t = q & 2047; const size_t r = (size_t)b * LP + 64 + t;
        const f32x4* xr = (const f32x4*)(H + r * DM) + lane; const f32x4* gr = (const f32x4*)PIN(26) + lane; f32x4* o = (f32x4*)(P.out + zz + (size_t)q * DM) + lane;
        f32x4 v[8]; float s = 0.f;
#pragma unroll
        for (int j = 0; j < 8; ++j) { v[j] = xr[64 * j]; s += (v[j][0] * v[j][0] + v[j][1] * v[j][1]) + (v[j][2] * v[j][2] + v[j][3] * v[j][3]); }
        const float rs = rsqrtf(wave_sum(s, lane) * (1.0f / DM) + EPSN);
#pragma unroll
        for (int j = 0; j < 8; ++j) o[64 * j] = v[j] * rs * gr[64 * j];
    }
}

#define XB_TMO      128
#define XB_XCNT(j)  (256  + 64 * (j))
#define XB_XSUB(j)  (1280 + 64 * (j))
#define XB_XGEN(j)  (2304 + 64 * (j))
#define XB_TOP      3328
#define XB_TOPGEN   3392
#define XCD_BAR_WORDS 3456
#define XB_SPIN_CAP (1u << 22)
__device__ __forceinline__ unsigned xb_ld(unsigned* p)              { return __hip_atomic_load(p, __ATOMIC_RELAXED, __HIP_MEMORY_SCOPE_AGENT); }
__device__ __forceinline__ unsigned xb_add(unsigned* p, unsigned v) { return __hip_atomic_fetch_add(p, v, __ATOMIC_RELAXED, __HIP_MEMORY_SCOPE_AGENT); }
__device__ __forceinline__ unsigned xb_xcc_id() { return (unsigned)__builtin_amdgcn_s_getreg((3 << 11) | 20) & 0xFu; }
#define XB_SPIN(cond, bar) do { unsigned _sp = 0; while (cond) { __builtin_amdgcn_s_sleep(1); \
    if ((++_sp & 255u) == 0u) { if (xb_ld(&(bar)[XB_TMO])) break; if (_sp > XB_SPIN_CAP) { atomicAdd(&(bar)[XB_TMO], 1u); break; } } } } while (0)
__device__ __forceinline__ void xcd_barrier(unsigned* bar, volatile LAS unsigned* st, unsigned G) {
    asm volatile("s_waitcnt vmcnt(0)" ::: "memory");
    __syncthreads();
    if (tid_l() == 0) {
        __builtin_amdgcn_s_waitcnt(0);
        const unsigned x = xb_xcc_id();
        unsigned nloc = st[0], nx = st[1];
        if (nloc == 0u) {
            unsigned sum, cnt, mine, sp = 0u;
            for (;;) {
                sum = 0u; cnt = 0u; mine = 0u;
#pragma unroll
                for (unsigned j = 0; j < 16; ++j) { const unsigned c = xb_ld(&bar[XB_XCNT(j)]); sum += c; cnt += (c > 0u) ? 1u : 0u; mine = (j == x) ? c : mine; }
                if (sum == G) break;
                __builtin_amdgcn_s_sleep(1);
                if ((++sp & 255u) == 0u) { if (xb_ld(&bar[XB_TMO])) break; if (sp > XB_SPIN_CAP) { atomicAdd(&bar[XB_TMO], 1u); break; } }
            }
            nloc = mine > 0u ? mine : 1u; nx = cnt > 0u ? cnt : 1u; st[0] = nloc; st[1] = nx;
        }
        const unsigned old = xb_add(&bar[XB_XSUB(x)], 1u);
        const unsigned gen = old / nloc;
        if (old + 1u == (gen + 1u) * nloc) {
            __builtin_amdgcn_fence(__ATOMIC_RELEASE, "agent");
            asm volatile("s_waitcnt vmcnt(0)" ::: "memory");
            const unsigned og = xb_add(&bar[XB_TOP], 1u);
            const unsigned tg = og / nx;
            if (og + 1u == (tg + 1u) * nx) xb_add(&bar[XB_TOPGEN], 1u);
            else XB_SPIN(xb_ld(&bar[XB_TOPGEN]) == tg, bar);
            __builtin_amdgcn_fence(__ATOMIC_ACQUIRE, "agent");
            xb_add(&bar[XB_XGEN(x)], 1u);
            asm volatile("s_waitcnt vmcnt(0)" ::: "memory");
        } else {
            XB_SPIN(xb_ld(&bar[XB_XGEN(x)]) == gen, bar);
            __builtin_amdgcn_fence(__ATOMIC_ACQUIRE, "agent");
            asm volatile("s_waitcnt vmcnt(0)" ::: "memory");
        }
    }
    __syncthreads();
}

__global__ void __launch_bounds__(512, 2) mk_fwd(Params P) {
    extern __shared__ __attribute__((aligned(16))) unsigned char lds_raw[];
    LAS unsigned char* lds = (LAS unsigned char*)lds_raw;
    cg::grid_group grid = cg::this_grid();
    volatile LAS unsigned* xst = (volatile LAS unsigned*)(lds + 131072);
    if (threadIdx.x < 4) xst[threadIdx.x] = 0u;
    __syncthreads();
    unsigned char* ws = P.ws;
    for (int ph = P.ph_lo; ph < P.ph_hi; ++ph) {
        if (ph == 0) {
            if (bid_l() == 0) { for (int i = tid_l(); i < 8192 + 1024 + XCD_BAR_WORDS; i += 512) ((unsigned*)ws)[i] = 0u; }
            phase_init_rows(P);
            for (int pr = bid_l(); pr < DEPTH * 64; pr += gridDim.x) s5_precompute(P, lds, pr >> 6, pr & 63);
            __syncthreads();
            convert_weights(P, lds, 0, bid_l() * 8 + (tid_l() >> 6), gridDim.x * 8, tid_l() >> 6, tid_l() & 63);
        }
        else if (ph == NPHASES - 1) phase_final(P);
        else {
            const int l = (ph - 1) / NPH_L, k = (ph - 1) % NPH_L;
            GemmDesc d; d.layer = l; d.nB = 1; d.sA = 0; d.sB = 0; d.A = nullptr; d.Bt = nullptr; d.lda = d.ldb = d.K = 256; d.nM = d.nN = 1; d.epi = 0; d.ssi = 0; d.amode = 0; d.split = 0; d.perm = 0; d.ubase = 0; d.umax = 0x7fffffff; d.gG = gridDim.x; d.gc = bid_l(); bool isg = false;
            const unsigned char* wb = (l & 1) ? (const unsigned char*)P.out : ws + WS_WSET;
            switch (k) {
            case 0: { const int gt = bid_l() * 512 + tid_l(), NGT = gridDim.x * 512; zero_rows16((bf16_t*)(ws + WS_Z) - 3072, 384, gt, NGT); zero_rows16((bf16_t*)(ws + WS_Z) + (size_t)MP * 3072, 384, gt, NGT); }
                d.A = (const bf16_t*)(ws + WS_HN); d.Bt = (const bf16_t*)(wb + WO_WIN); d.lda = LDH; d.ldb = LDH; d.K = DM; d.nM = MP / 256; d.nN = DINP / 256; d.epi = EPI_WIN; d.ssi = 2 * l; d.perm = 1; isg = true; break;
            case 1:
                if (bid_l() < 128) phase_mlstm(P, lds, l);
                else {
                    d.gG = gridDim.x - 128; d.gc = bid_l() - 128;
                    d.A = (const bf16_t*)(ws + WS_UA); d.Bt = (const bf16_t*)(ws + WS_WST) + (size_t)l * 64 * (256 * LDWS); d.lda = LDU; d.ldb = LDWS; d.K = 256; d.nM = S5ROWP / 256; d.nN = 1; d.nB = 64; d.sA = (size_t)S5ROWP * LDU; d.sB = 256 * LDWS; d.epi = EPI_S5A;
                    gemm_phase(P, lds, d);
                    xcd_barrier((unsigned*)ws + 8192 + 1024, xst + 2, gridDim.x - 128);
                    phase_s5_scan(P, l, 128);
                    xcd_barrier((unsigned*)ws + 8192 + 1024, xst + 2, gridDim.x - 128);
                    d.Bt = (const bf16_t*)(ws + WS_TO) + (size_t)l * 64 * (256 * LDTO); d.ldb = LDTO; d.K = 512; d.sB = 256 * LDTO; d.epi = EPI_S5C; d.perm = 1;
                    gemm_phase(P, lds, d);
                    xcd_barrier((unsigned*)ws + 8192 + 1024, xst + 2, gridDim.x - 128);
                    d.A = (const bf16_t*)(ws + WS_YGELU); d.Bt = (const bf16_t*)(wb + WO_WGLU); d.lda = LDG; d.ldb = LDG; d.K = 1024; d.nM = MP / 256; d.nN = 4; d.nB = 1; d.sA = 0; d.sB = 0; d.epi = EPI_GLU; d.perm = 1; d.umax = 2 * (gridDim.x - 128); isg = true;
                    if (bid_l() == 128 && tid_l() == 0) __hip_atomic_store((unsigned*)ws + 128, (unsigned)(l + 1), __ATOMIC_RELAXED, __HIP_MEMORY_SCOPE_AGENT);
                }
                break;
            case 2: phase_finalize(P, l); break;
            case 3: d.A = (const bf16_t*)(ws + WS_Y); d.Bt = (const bf16_t*)(wb + WO_WOUT); d.lda = LDH; d.ldb = LDH; d.K = DM; d.nM = MP / 256; d.nN = 8; d.epi = EPI_RES; d.ssi = 2 * l + 1; d.split = 4; d.perm = 1; isg = true; break;
            case 4: d.A = (const bf16_t*)(ws + WS_HN) - LDH; d.Bt = (const bf16_t*)(wb + WO_WGU); d.lda = LDH; d.ldb = LDH; d.K = DM; d.nM = 69; d.nN = 44; d.epi = EPI_FFN; d.ssi = 2 * l + 1; d.amode = 1; d.perm = 1; isg = true; break;
            case 5: d.A = (const bf16_t*)(ws + WS_ACT); d.Bt = (const bf16_t*)(wb + WO_WDN); d.lda = LDF; d.ldb = LDF; d.K = DFF; d.nM = MP / 256; d.nN = 8; d.epi = EPI_RES; d.ssi = 2 * l + 2; d.split = 4; d.perm = 1; isg = true; break;
            }
            if (isg) gemm_phase(P, lds, d);
            if (k == 0 && l + 1 < DEPTH) {
                const int nun = (MP / 256) * (DINP / 256), nbusy = nun - (nun / (int)gridDim.x) * (int)gridDim.x; const int t_ = tid_l(); __syncthreads();
                if (bid_l() >= nbusy) convert_weights(P, lds, l + 1, (bid_l() - nbusy) * 8 + (t_ >> 6), (gridDim.x - nbusy) * 8, t_ >> 6, t_ & 63, 0, CV_SPLIT1);
            }
            if (k == 1 && l + 1 < DEPTH && bid_l() < 128) {
                const int t_ = tid_l(); __syncthreads();
                convert_weights(P, lds, l + 1, bid_l() * 8 + (t_ >> 6), 128 * 8, t_ >> 6, t_ & 63, CV_SPLIT1, CV_SPLIT2);
            }
            if (k == 1 && bid_l() < 128) {
                const int ntail = (MP / 256) * 4 - 2 * ((int)gridDim.x - 128);
                if ((int)bid_l() < ntail) {
                    __syncthreads();
                    if (tid_l() == 0) { unsigned sp = 0; while (__hip_atomic_load((unsigned*)ws + 128, __ATOMIC_RELAXED, __HIP_MEMORY_SCOPE_AGENT) < (unsigned)(l + 1)) { __builtin_amdgcn_s_sleep(4); if (++sp > (1u << 24)) break; }
                        __builtin_amdgcn_fence(__ATOMIC_ACQUIRE, "agent"); asm volatile("s_waitcnt vmcnt(0)" ::: "memory"); }
                    __syncthreads();
                    d.A = (const bf16_t*)(ws + WS_YGELU); d.Bt = (const bf16_t*)(wb + WO_WGLU); d.lda = LDG; d.ldb = LDG; d.K = 1024; d.nM = MP / 256; d.nN = 4; d.nB = 1; d.sA = 0; d.sB = 0; d.epi = EPI_GLU; d.perm = 1;
                    d.ubase = 2 * ((int)gridDim.x - 128); d.umax = 0x7fffffff; d.gG = ntail; d.gc = bid_l();
                    gemm_phase(P, lds, d);
                }
            }
            if (k == 5 && l + 1 < DEPTH) {
                const int nun = (MP / 256) * 8, nfull = (nun / (int)gridDim.x) * (int)gridDim.x, nbusy = (nun - nfull) * 4;
                const int t_ = tid_l(); __syncthreads();
                if (nbusy == 0 || nbusy >= (int)gridDim.x) convert_weights(P, lds, l + 1, bid_l() * 8 + (t_ >> 6), gridDim.x * 8, t_ >> 6, t_ & 63, CV_SPLIT2);
                else if (bid_l() >= nbusy) convert_weights(P, lds, l + 1, (bid_l() - nbusy) * 8 + (t_ >> 6), (gridDim.x - nbusy) * 8, t_ >> 6, t_ & 63, CV_SPLIT2);
            }
        }
        if (ph + 1 < P.ph_hi) { if (ph == 0) { grid.sync(); if (threadIdx.x == 0) { (void)xb_add((unsigned*)ws + 1024 + XB_XCNT(xb_xcc_id()), 1u); if (blockIdx.x >= 128) (void)xb_add((unsigned*)ws + 8192 + 1024 + XB_XCNT(xb_xcc_id()), 1u); } } else xcd_barrier((unsigned*)ws + 1024, xst, gridDim.x); }
    }
}

extern "C" void kernel_launch(void* const* d_in, const int* in_sizes, int n_in, void* d_out, int out_size, void* d_ws, size_t ws_size, hipStream_t stream) {
    static int grid = 0;
    if (grid == 0) {
        int dev = 0, cus = 0, per_cu = 0;
        hipGetDevice(&dev); hipDeviceGetAttribute(&cus, hipDeviceAttributeMultiprocessorCount, dev);
        if (hipFuncSetAttribute((const void*)mk_fwd, hipFuncAttributeMaxDynamicSharedMemorySize, LDS_BYTES) != hipSuccess) { fprintf(stderr, "kernel_launch: hipFuncSetAttribute failed\n"); grid = -1; return; }
        if (hipOccupancyMaxActiveBlocksPerMultiprocessor(&per_cu, (const void*)mk_fwd, 512, LDS_BYTES) != hipSuccess || per_cu < 1) { fprintf(stderr, "kernel_launch: occupancy query says %d\n", per_cu); per_cu = 1; }
        (void)hipGetLastError();
        grid = cus;
        if (ws_size < WS_END) fprintf(stderr, "kernel_launch: workspace too small: %zu < %zu\n", ws_size, (size_t)WS_END);
    }
    if (grid < 0) return;
    Params p{};
    for (int i = 0; i < 27; ++i) p.in[i] = (const float*)d_in[i];
    p.out = (float*)d_out; p.ws = (unsigned char*)d_ws; p.ph_lo = 0; p.ph_hi = NPHASES;
    void* args[] = {&p};
    hipError_t e = hipLaunchCooperativeKernel((const void*)mk_fwd, dim3(grid), dim3(512), args, LDS_BYTES, stream);
    if (e != hipSuccess) fprintf(stderr, "cooperative launch failed: %s (grid %d)\n", hipGetErrorString(e), grid);
}
```

```cpp
#include <hip/hip_runtime.h>
#include <hip/hip_cooperative_groups.h>
#include <cstdio>
namespace cg = cooperative_groups;

#define LAS __attribute__((address_space(3)))
typedef unsigned short bf16_t;
typedef short bf16x8 __attribute__((ext_vector_type(8)));
typedef float f32x4 __attribute__((ext_vector_type(4)));
typedef unsigned u32x4 __attribute__((ext_vector_type(4)));
typedef unsigned u32x2 __attribute__((ext_vector_type(2)));

constexpr int DM = 2048, NB = 8, LP = 2112, PADF = 48, MP = NB * LP;
constexpr int DIN = 4128, DINP = 4352, DFF = 5632, DEPTH = 4;
constexpr int NCH = LP / 16;
constexpr int S5ROWS = NB * NCH;
constexpr int S5ROWP = 1280;
constexpr float EPSN = 1e-6f;
constexpr int LDH = 2112, LDF = 5696, LDG = 1088, LDU = 576, LDWS = 320, LDTO = 576;
constexpr int CV_SPLIT1 = 7075, CV_SPLIT2 = 14150;
constexpr int NPH_L = 6, NPHASES = 2 + DEPTH * NPH_L;

constexpr size_t MiB = 1u << 20;
constexpr size_t WO_WIN = 0 * MiB, WO_WGLU = 18 * MiB, WO_WOUT = 21 * MiB, WO_WGU = 30 * MiB, WO_WDN = 76 * MiB;
constexpr size_t WS_WSET = 1 * MiB;
constexpr size_t WS_WST = 100 * MiB, WS_TO = 140 * MiB, WS_H = 212 * MiB, WS_HN = 344 * MiB + 8192, WS_G = 413 * MiB, WS_Y = 416 * MiB;
constexpr size_t WS_UA = 485 * MiB, WS_Z = 576 * MiB, WS_SLOC = 676 * MiB, WS_YGELU = 676 * MiB, WS_YGLU = 716 * MiB, WS_HFB = 756 * MiB;
constexpr size_t WS_GT = 486 * MiB, WS_ACT = 669 * MiB, WS_SS = 854 * MiB, WS_END = 856 * MiB;
constexpr int LDS_BYTES = 147456;

struct Params { const float* in[27]; float* out; unsigned char* ws; int ph_lo, ph_hi; };

#define LAUNDER_Z() int zz = 0; asm volatile("" : "+s"(zz))
#define PIN(i) (P.in[(i) + zz])
__device__ __forceinline__ int tid_l() { int w = __builtin_amdgcn_readfirstlane(threadIdx.x >> 6); asm volatile("" : "+s"(w)); int ln = __builtin_amdgcn_mbcnt_hi(~0u, __builtin_amdgcn_mbcnt_lo(~0u, 0u)); asm volatile("" : "+v"(ln)); return w * 64 + ln; }
__device__ __forceinline__ int bid_l() { int t = blockIdx.x; asm volatile("" : "+s"(t)); return t; }
__device__ __forceinline__ unsigned cvt_pk_bf16(float lo, float hi) { unsigned r; asm("v_cvt_pk_bf16_f32 %0, %1, %2" : "=v"(r) : "v"(lo), "v"(hi)); return r; }
__device__ __forceinline__ float bf_lo(unsigned w) { return __uint_as_float(w << 16); }
__device__ __forceinline__ float bf_hi(unsigned w) { return __uint_as_float(w & 0xffff0000u); }
__device__ __forceinline__ float bf2f(bf16_t b) { return __uint_as_float((unsigned)b << 16); }
__device__ __forceinline__ bf16_t f2bf(float f) { return (bf16_t)(cvt_pk_bf16(f, 0.f) & 0xffffu); }
__device__ __forceinline__ float sigmoidf_(float x) { return __builtin_amdgcn_rcpf(1.0f + __expf(-x)); }
__device__ __forceinline__ float siluf_(float x) { return x * sigmoidf_(x); }
__device__ __forceinline__ float gelu_tanh(float x) { const float u = 0.7978845608028654f * (x + 0.044715f * x * x * x); return x * __builtin_amdgcn_rcpf(1.0f + __expf(-2.0f * u)); }
__device__ __forceinline__ float shx(float v, int o, int lane) { return __int_as_float(__builtin_amdgcn_ds_bpermute((lane ^ o) << 2, __float_as_int(v))); }
__device__ __forceinline__ float shi(float v, int idx) { return __int_as_float(__builtin_amdgcn_ds_bpermute(idx << 2, __float_as_int(v))); }
__device__ __forceinline__ float wave_sum(float v, int lane) {
#pragma unroll
    for (int o = 1; o < 64; o <<= 1) v += shx(v, o, lane);
    return v;
}
__device__ __forceinline__ float wave_max(float v, int lane) {
#pragma unroll
    for (int o = 1; o < 64; o <<= 1) v = fmaxf(v, shx(v, o, lane));
    return v;
}

constexpr int BM = 256, BK = 64, HALF = 128, HTB = HALF * BK * 2;
__device__ __forceinline__ int lds_byte(int r, int c) { const int st = (r >> 4) * 2 + (c >> 5), rr = r & 15, cc = c & 31, ob = rr * 64 + cc * 2; return st * 1024 + (ob ^ (((ob >> 9) & 1) << 5)); }
__device__ __forceinline__ void stage_rc(int b, int& R, int& C) { const int st = b / 1024, sb = b % 1024, swz = sb ^ (((sb >> 9) & 1) << 5); R = (st >> 1) * 16 + swz / 64; C = (st & 1) * 32 + (swz % 64) / 2; }

struct Unit { int pm, pn, b, piece, tu, k0, nt; };
struct GemmDesc { const bf16_t* A; const bf16_t* Bt; int lda, ldb, K, nM, nN, nB; size_t sA, sB; int epi, layer, ssi, amode, gG, gc, split, ubase, umax, perm; };
enum { EPI_WIN = 0, EPI_S5A = 1, EPI_S5C = 2, EPI_GLU = 3, EPI_RES = 4, EPI_FFN = 5 };

__device__ __forceinline__ bool next_unit(const GemmDesc& d, int i, int G, int c, Unit& u) {
    const int per = d.nM * d.nN; long L = (long)d.ubase + (long)i * G + c; const int ntf = d.K / BK;
    if (L >= d.umax) return false;
    u.piece = -1; u.tu = 0; u.k0 = 0; u.nt = ntf;
    if (d.split > 0) { const int nfull = (per / G) * G;
        if (L >= nfull) { const long q = L - nfull; if (q >= (long)(per - nfull) * d.split) return false;
            u.tu = (int)(q / d.split); u.piece = (int)(q % d.split); u.nt = ntf / d.split; u.k0 = u.piece * u.nt; L = nfull + u.tu; } }
    if (L >= (long)per * d.nB) return false;
    u.b = (int)(L / per); int wgid = (int)(L % per);
    { const int q = per / 8, r = per % 8, xcd = wgid % 8, off = wgid / 8; wgid = (xcd < r ? xcd * (q + 1) : r * (q + 1) + (xcd - r) * q) + off; }
    const int nig = 8 * d.nN, gid = wgid / nig, fm = gid * 8, gsz = (d.nM - fm) < 8 ? (d.nM - fm) : 8;
    u.pm = fm + ((wgid % nig) % gsz); u.pn = (wgid % nig) / gsz; return true;
}

__device__ __forceinline__ void store_bf4(bf16_t* p, f32x4 v) { u32x2 w; w.x = cvt_pk_bf16(v[0], v[1]); w.y = cvt_pk_bf16(v[2], v[3]); *(u32x2*)p = w; }
__device__ __forceinline__ f32x4 load_bf4(const bf16_t* p) { const u32x2 w = *(const u32x2*)p; return (f32x4){bf_lo(w.x), bf_hi(w.x), bf_lo(w.y), bf_hi(w.y)}; }

typedef unsigned long long u64;
constexpr float SSCALE = 16777216.0f;
__device__ __forceinline__ float row_rs(const u64* ss, int r) { return __builtin_amdgcn_rsqf((float)ss[r] * (1.0f / (SSCALE * DM)) + EPSN); }
__device__ __forceinline__ void gemm_epilogue(const Params& P, const GemmDesc& d, const f32x4 (&acc)[2][2][4][2], const Unit& u, int wr, int wc, int fr, int fq) {
    LAUNDER_Z(); unsigned char* ws = P.ws + zz; const int l = d.layer;
    int lane;
    { const int t2 = tid_l(); const int w2 = __builtin_amdgcn_readfirstlane(t2 >> 6); wr = w2 >> 2; wc = w2 & 3; lane = t2 & 63; fr = lane & 15; fq = lane >> 4; }
    const int rbase = u.pm * BM + wr * 64 + fr, cbase = u.pn * BM + wc * 32 + 4 * fq;
    if (d.epi == EPI_RES) {
        const int cb8 = u.pn * BM + wc * 32 + 8 * fq;
        float* hb = (float*)(ws + WS_H) + (size_t)rbase * DM + cb8; bf16_t* nb = (bf16_t*)(ws + WS_HN) + (size_t)rbase * LDH + cb8;
        u64* ssp = (u64*)(ws + WS_SS) + (size_t)d.ssi * MP + rbase;
#pragma unroll
        for (int ai = 0; ai < 2; ++ai)
#pragma unroll
        for (int mh = 0; mh < 2; ++mh) {
            f32x4 t[2][2][2];
            float* hp = hb + (size_t)(ai * HALF + mh * 32) * DM; asm volatile("" : "+v"(hp));
#pragma unroll
            for (int m = 0; m < 2; ++m)
#pragma unroll
                for (int bj = 0; bj < 2; ++bj)
#pragma unroll
                    for (int n = 0; n < 2; ++n) t[m][bj][n] = *(const f32x4*)(hp + (size_t)(m * 16) * DM + bj * HALF + n * 4);
            float sq[2] = {0.f, 0.f};
#pragma unroll
            for (int m = 0; m < 2; ++m)
#pragma unroll
                for (int bj = 0; bj < 2; ++bj)
#pragma unroll
                    for (int n = 0; n < 2; ++n) { const f32x4 hv = t[m][bj][n] + acc[ai][bj][mh * 2 + m][n]; t[m][bj][n] = hv;
                        __builtin_nontemporal_store(hv, (f32x4*)(hp + (size_t)(m * 16) * DM + bj * HALF + n * 4));
                        sq[m] += (hv[0] * hv[0] + hv[1] * hv[1]) + (hv[2] * hv[2] + hv[3] * hv[3]); }
            bf16_t* np = nb + (size_t)(ai * HALF + mh * 32) * LDH; asm volatile("" : "+v"(np));
#pragma unroll
            for (int m = 0; m < 2; ++m) {
#pragma unroll
                for (int bj = 0; bj < 2; ++bj) { u32x4 o; o.x = cvt_pk_bf16(t[m][bj][0][0], t[m][bj][0][1]); o.y = cvt_pk_bf16(t[m][bj][0][2], t[m][bj][0][3]); o.z = cvt_pk_bf16(t[m][bj][1][0], t[m][bj][1][1]); o.w = cvt_pk_bf16(t[m][bj][1][2], t[m][bj][1][3]);
                    *(u32x4*)(np + (size_t)(m * 16) * LDH + bj * HALF) = o; }
                float q = sq[m]; q += shx(q, 16, lane); q += shx(q, 32, lane);
                if (fq == 0) atomicAdd(ssp + ai * HALF + mh * 32 + m * 16, (u64)(q * SSCALE));
            }
        }
        return;
    }
    if (d.epi == EPI_FFN) {
        const int ccol = u.pn * 128 + wc * 32 + 8 * fq;
        const float* cwb = PIN(23) + (size_t)l * 3 * DFF + ccol; const float* cbb = PIN(24) + (size_t)l * DFF + ccol;
        const u64* ssb = (const u64*)(ws + WS_SS) + (size_t)d.ssi * MP;
#pragma unroll
        for (int ai = 0; ai < 2; ++ai) {
            const int row0 = u.pm * 248 + (ai * 2 + wr) * 62 - 1 + fr;
            float rsv[4];
#pragma unroll
            for (int m = 0; m < 4; ++m) { int rc = row0 + m * 16; rc = rc < 0 ? 0 : (rc > MP - 1 ? MP - 1 : rc); rsv[m] = row_rs(ssb, rc); }
            bf16_t* ab = (bf16_t*)(ws + WS_ACT) + (size_t)row0 * LDF + ccol;
            u32x2 keep[4];
#pragma unroll
            for (int n = 0; n < 2; ++n) {
                const f32x4 w0 = *(const f32x4*)(cwb + n * 4), w1 = *(const f32x4*)(cwb + DFF + n * 4), w2 = *(const f32x4*)(cwb + 2 * DFF + n * 4), cb = *(const f32x4*)(cbb + n * 4);
                f32x4 X[4], RR[4], RL[4];
#pragma unroll
                for (int m = 0; m < 4; ++m) { X[m] = acc[ai][0][m][n] * rsv[m];
#pragma unroll
                    for (int j = 0; j < 4; ++j) { RR[m][j] = __int_as_float(__builtin_amdgcn_update_dpp(0, __float_as_int(X[m][j]), 0x121, 0xf, 0xf, false));
                                                  RL[m][j] = __int_as_float(__builtin_amdgcn_update_dpp(0, __float_as_int(X[m][j]), 0x12f, 0xf, 0xf, false)); } }
#pragma unroll
                for (int m = 0; m < 4; ++m) {
                    const f32x4 prev = (fr > 0) ? RR[m] : RR[m > 0 ? m - 1 : 0];
                    const f32x4 next = (fr < 15) ? RL[m] : RL[m < 3 ? m + 1 : 3];
                    const f32x4 gt = cb + w0 * prev + w1 * X[m] + w2 * next; const f32x4 v = acc[ai][1][m][n] * rsv[m];
                    const int lr = m * 16 + fr, row = row0 + m * 16;
                    u32x2 pk; pk.x = cvt_pk_bf16(siluf_(gt[0]) * v[0], siluf_(gt[1]) * v[1]); pk.y = cvt_pk_bf16(siluf_(gt[2]) * v[2], siluf_(gt[3]) * v[3]);
                    if (n == 0) keep[m] = pk;
                    else if (lr >= 1 && lr <= 62 && row < MP) { u32x4 o; o.x = keep[m].x; o.y = keep[m].y; o.z = pk.x; o.w = pk.y; __builtin_nontemporal_store(o, (u32x4*)(ab + (size_t)(m * 16) * LDF)); } }
            }
        }
        return;
    }
    if (d.epi == EPI_GLU) {
        const int c8 = u.pn * BM + wc * 32 + 8 * fq;
        const bf16_t* yb = (const bf16_t*)(ws + WS_YGELU) + (size_t)rbase * LDG + c8; bf16_t* ob = (bf16_t*)(ws + WS_YGLU) + (size_t)rbase * 1024 + c8;
        const float* bb = PIN(13) + (size_t)l * 1024 + c8;
#pragma unroll
        for (int bj = 0; bj < 2; ++bj) {
            f32x4 bg[2];
#pragma unroll
            for (int n = 0; n < 2; ++n) bg[n] = *(const f32x4*)(bb + bj * HALF + n * 4);
#pragma unroll
            for (int ai = 0; ai < 2; ++ai) {
                u32x4 y[4];
                const bf16_t* yq = yb + (size_t)(ai * HALF) * LDG + bj * HALF; asm volatile("" : "+v"(yq));
#pragma unroll
                for (int m = 0; m < 4; ++m) y[m] = *(const u32x4*)(yq + (size_t)(m * 16) * LDG);
#pragma unroll
                for (int m = 0; m < 4; ++m) { const f32x4 v0 = acc[ai][bj][m][0] + bg[0], v1 = acc[ai][bj][m][1] + bg[1]; const u32x4 yy = y[m]; u32x4 o;
                    o.x = cvt_pk_bf16(bf_lo(yy.x) * sigmoidf_(v0[0]), bf_hi(yy.x) * sigmoidf_(v0[1])); o.y = cvt_pk_bf16(bf_lo(yy.y) * sigmoidf_(v0[2]), bf_hi(yy.y) * sigmoidf_(v0[3]));
                    o.z = cvt_pk_bf16(bf_lo(yy.z) * sigmoidf_(v1[0]), bf_hi(yy.z) * sigmoidf_(v1[1])); o.w = cvt_pk_bf16(bf_lo(yy.w) * sigmoidf_(v1[2]), bf_hi(yy.w) * sigmoidf_(v1[3]));
                    *(u32x4*)(ob + (size_t)(ai * HALF + m * 16) * 1024 + bj * HALF) = o; }
            }
        }
        return;
    }
    if (d.epi == EPI_S5C) {
#pragma unroll
        for (int ai = 0; ai < 2; ++ai)
#pragma unroll
        for (int m = 0; m < 4; ++m) {
            const int r = rbase + ai * HALF + m * 16;
            if (r < S5ROWS) { const int b = r / NCH, nn = r - b * NCH;
#pragma unroll
                for (int bj = 0; bj < 2; ++bj) { const int c8 = bj * HALF + wc * 32 + 8 * fq, tl = c8 >> 4, ch = c8 & 15; const size_t row = (size_t)b * LP + nn * 16 + tl;
                    const f32x4 v0 = acc[ai][bj][m][0], v1 = acc[ai][bj][m][1]; u32x4 o;
                    o.x = cvt_pk_bf16(gelu_tanh(v0[0]), gelu_tanh(v0[1])); o.y = cvt_pk_bf16(gelu_tanh(v0[2]), gelu_tanh(v0[3])); o.z = cvt_pk_bf16(gelu_tanh(v1[0]), gelu_tanh(v1[1])); o.w = cvt_pk_bf16(gelu_tanh(v1[2]), gelu_tanh(v1[3]));
                    *(u32x4*)((bf16_t*)(ws + WS_YGELU) + row * LDG + u.b * 16 + ch) = o; } }
        }
        return;
    }
    if (d.epi == EPI_WIN) {
        const u64* ssb = (const u64*)(ws + WS_SS) + (size_t)d.ssi * MP;
#pragma unroll
        for (int ai = 0; ai < 2; ++ai)
#pragma unroll
        for (int m = 0; m < 4; ++m) {
            const int r = rbase + ai * HALF + m * 16; const float rsc = row_rs(ssb, r);
#pragma unroll
            for (int bj = 0; bj < 2; ++bj) {
                const int c8 = u.pn * BM + bj * HALF + wc * 32 + 8 * fq;
                const f32x4 v0 = acc[ai][bj][m][0] * rsc, v1 = acc[ai][bj][m][1] * rsc;
                if (u.pn < 16) { u32x4 o; o.x = cvt_pk_bf16(v0[0], v0[1]); o.y = cvt_pk_bf16(v0[2], v0[3]); o.z = cvt_pk_bf16(v1[0], v1[1]); o.w = cvt_pk_bf16(v1[2], v1[3]);
                    if (u.pn < 4) { const int g = c8 >> 4, ch = c8 & 15, b = r / LP, pos = r - b * LP, cr = b * NCH + (pos >> 4), tl = pos & 15;
                        *(u32x4*)((bf16_t*)(ws + WS_UA) + ((size_t)g * S5ROWP + cr) * LDU + tl * 16 + ch) = o; }
                    else *(u32x4*)((bf16_t*)(ws + WS_Z) + (size_t)r * 3072 + (c8 - 1024)) = o; }
                else if (c8 - 4096 < 32) { float* gp = (float*)(ws + WS_G) + (size_t)r * 32 + (c8 - 4096); *(f32x4*)gp = v0; *(f32x4*)(gp + 4) = v1; }
            }
        }
        return;
    }
#pragma unroll
    for (int ai = 0; ai < 2; ++ai)
#pragma unroll
    for (int m = 0; m < 4; ++m) {
        const int r = rbase + ai * HALF + m * 16;
        const float rsc = (d.epi == EPI_WIN) ? row_rs((const u64*)(ws + WS_SS) + (size_t)d.ssi * MP, r) : 1.0f;
#pragma unroll
        for (int bj = 0; bj < 2; ++bj)
#pragma unroll
        for (int n = 0; n < 2; ++n) {
            const int c0 = cbase + bj * HALF + n * 16;
            const f32x4 v = acc[ai][bj][m][n] * rsc;
            switch (d.epi) {
            case EPI_WIN: {
                if (u.pn < 4) { const int g = c0 >> 4, ch = c0 & 15, b = r / LP, pos = r - b * LP, cr = b * NCH + (pos >> 4), tl = pos & 15;
                    store_bf4((bf16_t*)(ws + WS_UA) + ((size_t)g * S5ROWP + cr) * LDU + tl * 16 + ch, v); }
                else if (u.pn < 16) store_bf4((bf16_t*)(ws + WS_Z) + (size_t)r * 3072 + (c0 - 1024), v);
                else if (c0 - 4096 < 32) *(f32x4*)((float*)(ws + WS_G) + (size_t)r * 32 + (c0 - 4096)) = v;
            } break;
            case EPI_S5A: *(f32x4*)((float*)(ws + WS_SLOC) + ((size_t)u.b * S5ROWP + r) * 256 + c0) = v; break;
            case EPI_S5C: {
                if (r < S5ROWS) { const int b = r / NCH, nn = r - b * NCH, tl = c0 >> 4, ch = c0 & 15; const size_t row = (size_t)b * LP + nn * 16 + tl;
                    store_bf4((bf16_t*)(ws + WS_YGELU) + row * LDG + u.b * 16 + ch, (f32x4){gelu_tanh(v[0]), gelu_tanh(v[1]), gelu_tanh(v[2]), gelu_tanh(v[3])}); }
            } break;
            default: break;
            }
        }
    }
}

__device__ __forceinline__ void gemm_phase(const Params& P, LAS unsigned char* lds, const GemmDesc d) {
    const int tid = tid_l(), wid = __builtin_amdgcn_readfirstlane(tid >> 6), lane = tid & 63, wr = wid >> 2, wc = wid & 3, fr = lane & 15, fq = lane >> 4;
    const int K = d.K, nt = K / BK; const int G = d.gG, cblk = d.gc;
    unsigned voffA[2], voffB[2];
#pragma unroll
    for (int i = 0; i < 2; ++i) { int R, C; stage_rc(tid * 16 + i * 8192, R, C); const int Ra = (d.amode && R >= 64) ? R - 2 : R; voffA[i] = (unsigned)(Ra * d.lda + C) * 2u; const int Rb = d.perm ? ((R & ~31) + 8 * ((R & 15) >> 2) + 4 * ((R & 31) >> 4) + (R & 3)) : R; voffB[i] = (unsigned)(Rb * d.ldb + C) * 2u; }
    const size_t kstep = (size_t)(BK * 2);
    const size_t hstepA = (size_t)(d.amode ? 124 : HALF) * d.lda * 2, hstepB = (size_t)HALF * d.ldb * 2;
    const unsigned ldsw = (unsigned)wid * 1024u;
    const int aoff = lds_byte(wr * 64 + fr, fq * 8), boff = lds_byte(wc * 32 + fr, fq * 8);
#define PG8_SA(b, h) (((b) * 2 + (h)) * HTB)
#define PG8_SB(b, h) ((4 + (b) * 2 + (h)) * HTB)
#define PG8_STAGE(bufoff, gbase, voff) do { _Pragma("unroll") for (int _i = 0; _i < 2; ++_i) \
        __builtin_amdgcn_global_load_lds((const unsigned*)((const char*)(gbase) + (voff)[_i]), (LAS unsigned*)(lds + (bufoff) + ldsw + _i * 8192), 16, 0, 0); } while (0)
#define PG8_LDA(dst, b, h) do { _Pragma("unroll") for (int m = 0; m < 4; ++m) _Pragma("unroll") for (int k = 0; k < 2; ++k) dst[m][k] = *(const LAS bf16x8*)(lds + PG8_SA(b, h) + aoff + m * 2048 + k * 1024); } while (0)
#define PG8_LDB(dst, b, h) do { _Pragma("unroll") for (int n = 0; n < 2; ++n) _Pragma("unroll") for (int k = 0; k < 2; ++k) dst[n][k] = *(const LAS bf16x8*)(lds + PG8_SB(b, h) + boff + n * 2048 + k * 1024); } while (0)
#define PG8_MMA(ai, bj, At, Bt) do { __builtin_amdgcn_s_setprio(1); _Pragma("unroll") for (int m = 0; m < 4; ++m) _Pragma("unroll") for (int n = 0; n < 2; ++n) _Pragma("unroll") for (int k = 0; k < 2; ++k) \
        acc[ai][bj][m][n] = __builtin_amdgcn_mfma_f32_16x16x32_bf16(Bt[n][k], At[m][k], acc[ai][bj][m][n], 0, 0, 0); __builtin_amdgcn_s_setprio(0); } while (0)
#define PG8_WAIT_V(n) asm volatile("s_waitcnt vmcnt(" #n ")" ::: "memory")
#define PG8_WAIT_L(n) asm volatile("s_waitcnt lgkmcnt(" #n ")" ::: "memory")
#define PG8_BAR __builtin_amdgcn_s_barrier()
#define PG8_SCHED __builtin_amdgcn_sched_barrier(0)
    Unit cur, nxt; int ui = 0;
    if (!next_unit(d, 0, G, cblk, cur)) return;
    f32x4 acc[2][2][4][2];
#pragma unroll
    for (int a = 0; a < 2; ++a)
#pragma unroll
        for (int b = 0; b < 2; ++b)
#pragma unroll
            for (int m = 0; m < 4; ++m)
#pragma unroll
                for (int n = 0; n < 2; ++n) acc[a][b][m][n] = (f32x4){0.f, 0.f, 0.f, 0.f};
    bf16x8 At[4][2], B0[2][2], B1[2][2];
    const char* cA = (const char*)d.A + ((size_t)cur.b * d.sA) * 2 + (size_t)cur.pm * 2 * hstepA + (size_t)cur.k0 * kstep;
    const char* cB = (const char*)d.Bt + ((size_t)cur.b * d.sB) * 2 + (size_t)cur.pn * 2 * hstepB + (size_t)cur.k0 * kstep;
    PG8_STAGE(PG8_SB(0, 0), cB, voffB); PG8_STAGE(PG8_SA(0, 0), cA, voffA); PG8_STAGE(PG8_SB(0, 1), cB + hstepB, voffB); PG8_STAGE(PG8_SA(0, 1), cA + hstepA, voffA);
    if (wr == 1) PG8_BAR;
    PG8_WAIT_V(4); PG8_BAR;
    PG8_STAGE(PG8_SB(1, 0), cB + kstep, voffB); PG8_STAGE(PG8_SA(1, 0), cA + kstep, voffA); PG8_STAGE(PG8_SB(1, 1), cB + hstepB + kstep, voffB);
    PG8_WAIT_V(6); PG8_BAR;
    for (;;) {
        const bool has_next = next_unit(d, ui + 1, G, cblk, nxt);
        const char* nA = has_next ? (const char*)d.A + ((size_t)nxt.b * d.sA) * 2 + (size_t)nxt.pm * 2 * hstepA + (size_t)nxt.k0 * kstep : cA;
        const char* nB = has_next ? (const char*)d.Bt + ((size_t)nxt.b * d.sB) * 2 + (size_t)nxt.pn * 2 * hstepB + (size_t)nxt.k0 * kstep : cB;
        const int ntu = cur.nt;
        for (int t = 0; t < ntu; t += 2) {
            const bool last = (t == ntu - 2);
            const char* a1 = cA + (size_t)(t + 1) * kstep;
            const char* a2 = last ? nA : cA + (size_t)(t + 2) * kstep; const char* b2 = last ? nB : cB + (size_t)(t + 2) * kstep;
            const char* a3 = a2 + kstep; const char* b3 = b2 + kstep;
            PG8_LDB(B0, 0, 0); PG8_SCHED; PG8_LDA(At, 0, 0); PG8_STAGE(PG8_SA(1, 1), a1 + hstepA, voffA);
            PG8_WAIT_L(8); PG8_BAR; PG8_WAIT_L(0); PG8_MMA(0, 0, At, B0); PG8_BAR; PG8_SCHED;
            PG8_LDB(B1, 0, 1); PG8_STAGE(PG8_SB(0, 0), b2, voffB);
            PG8_BAR; PG8_WAIT_L(0); PG8_MMA(0, 1, At, B1); PG8_BAR;
            PG8_LDA(At, 0, 1); PG8_STAGE(PG8_SA(0, 0), a2, voffA);
            PG8_BAR; PG8_WAIT_L(0); PG8_MMA(1, 0, At, B0); PG8_BAR; PG8_SCHED;
            PG8_STAGE(PG8_SB(0, 1), b2 + hstepB, voffB);
            PG8_WAIT_V(6); PG8_BAR; PG8_MMA(1, 1, At, B1); PG8_BAR;
            PG8_LDB(B0, 1, 0); PG8_SCHED; PG8_LDA(At, 1, 0); PG8_STAGE(PG8_SA(0, 1), a2 + hstepA, voffA);
            PG8_WAIT_L(8); PG8_BAR; PG8_WAIT_L(0); PG8_MMA(0, 0, At, B0); PG8_BAR; PG8_SCHED;
            PG8_LDB(B1, 1, 1); PG8_STAGE(PG8_SB(1, 0), b3, voffB);
            PG8_BAR; PG8_WAIT_L(0); PG8_MMA(0, 1, At, B1); PG8_BAR;
            PG8_LDA(At, 1, 1); PG8_STAGE(PG8_SA(1, 0), a3, voffA);
            PG8_BAR; PG8_WAIT_L(0); PG8_MMA(1, 0, At, B0); PG8_BAR; PG8_SCHED;
            PG8_STAGE(PG8_SB(1, 1), b3 + hstepB, voffB);
            PG8_WAIT_V(6); PG8_BAR; PG8_MMA(1, 1, At, B1); PG8_BAR;
        }
        bool do_epi = true;
        if (cur.piece >= 0) {
            LAUNDER_Z();
            const int t3 = tid_l(); const int w3 = __builtin_amdgcn_readfirstlane(t3 >> 6), l3 = t3 & 63;
            const size_t pstride = (size_t)8 * 32 * 64;
            f32x4* slab = (f32x4*)(P.ws + zz + WS_UA) + ((size_t)(cur.tu * d.split) * 8 + w3) * 32 * 64 + l3;
            {   f32x4* mine = slab + (size_t)cur.piece * pstride;
#pragma unroll
                for (int idx = 0; idx < 32; ++idx) { asm volatile("global_store_dwordx4 %0, %1, off sc1\n\ts_nop 1" :: "v"(mine), "v"(acc[idx >> 4][(idx >> 3) & 1][(idx >> 1) & 3][idx & 1]) : "memory"); mine += 64; } }
            asm volatile("s_waitcnt vmcnt(0)" ::: "memory");
            unsigned old = 0u;
            if (l3 == 0) old = __hip_atomic_fetch_add((unsigned*)(P.ws + zz) + 8192 + cur.tu * 8 + w3, 1u, __ATOMIC_RELAXED, __HIP_MEMORY_SCOPE_AGENT);
            old = (unsigned)__builtin_amdgcn_readfirstlane((int)old);
            do_epi = ((old % (unsigned)d.split) == (unsigned)d.split - 1u);
            if (do_epi) {
                __builtin_amdgcn_fence(__ATOMIC_ACQUIRE, "agent");
                asm volatile("s_waitcnt vmcnt(0)" ::: "memory");
                const f32x4* p = slab;
#pragma unroll
                for (int i4 = 0; i4 < 8; ++i4) { f32x4 t4[4][4];
#pragma unroll
                    for (int j = 0; j < 4; ++j) { asm volatile("" : "+v"(p));
#pragma unroll
                        for (int q = 0; q < 4; ++q) t4[j][q] = p[(size_t)q * pstride];
                        p += 64; }
#pragma unroll
                    for (int j = 0; j < 4; ++j) { const int idx = i4 * 4 + j; acc[idx >> 4][(idx >> 3) & 1][(idx >> 1) & 3][idx & 1] = ((t4[j][0] + t4[j][1]) + t4[j][2]) + t4[j][3]; } }
            }
        }
        if (do_epi) gemm_epilogue(P, d, acc, cur, wr, wc, fr, fq);
        if (!has_next) break;
#pragma unroll
        for (int a = 0; a < 2; ++a)
#pragma unroll
            for (int b = 0; b < 2; ++b)
#pragma unroll
                for (int m = 0; m < 4; ++m)
#pragma unroll
                    for (int n = 0; n < 2; ++n) acc[a][b][m][n] = (f32x4){0.f, 0.f, 0.f, 0.f};
        cur = nxt; cA = nA; cB = nB; ++ui;
    }
    PG8_WAIT_V(0);
    if (wr == 0) PG8_BAR;
    PG8_BAR;
#undef PG8_SA
#undef PG8_SB
#undef PG8_STAGE
#undef PG8_LDA
#undef PG8_LDB
#undef PG8_MMA
#undef PG8_WAIT_V
#undef PG8_WAIT_L
#undef PG8_BAR
#undef PG8_SCHED
}

__device__ __forceinline__ void transpose_item(const float* W, int K, int N, bf16_t* WT, int ldw, LAS float* scr, int item, int lane, const float* gsc, int rowmap = 0) {
    const int nblk = N / 32, kb = item / nblk, nb = item % nblk, k0 = 64 * kb, n0 = 32 * nb;
    float wv[32];
#pragma unroll
    for (int i = 0; i < 32; ++i) { const int kk = 2 * i + (lane >> 5); wv[i] = W[(size_t)(k0 + kk) * N + n0 + (lane & 31)]; }
#pragma unroll
    for (int i = 0; i < 32; ++i) { const int kk = 2 * i + (lane >> 5); const float gg = gsc ? gsc[k0 + kk] : 1.0f; scr[kk * 33 + (lane & 31)] = wv[i] * gg; }
    asm volatile("s_waitcnt lgkmcnt(0)" ::: "memory");
    const int c = lane & 7;
#pragma unroll
    for (int j = 0; j < 4; ++j) { const int n = (lane >> 3) + 8 * j; const LAS float* s = scr + (8 * c) * 33 + n;
        u32x4 o; o.x = cvt_pk_bf16(s[0 * 33], s[1 * 33]); o.y = cvt_pk_bf16(s[2 * 33], s[3 * 33]); o.z = cvt_pk_bf16(s[4 * 33], s[5 * 33]); o.w = cvt_pk_bf16(s[6 * 33], s[7 * 33]);
        const int nr = n0 + n; const int dr = rowmap ? ((nr >> 7) * 256 + (nr & 127) + (rowmap == 2 ? 128 : 0)) : nr;
        *(u32x4*)(WT + (size_t)dr * ldw + k0 + 8 * c) = o; }
    asm volatile("s_waitcnt lgkmcnt(0)" ::: "memory");
}

__device__ __forceinline__ void norm_row_bf16(const float* hrow, const float* g, bf16_t* orow, int lane, bool pad) {
    u32x2* o8 = (u32x2*)orow + lane;
    if (pad) {
#pragma unroll
        for (int j = 0; j < 8; ++j) o8[64 * j] = (u32x2){0u, 0u};
        return; }
    const f32x4* xr = (const f32x4*)hrow + lane; const f32x4* gr = (const f32x4*)g + lane;
    f32x4 v[8]; float s = 0.f;
#pragma unroll
    for (int j = 0; j < 8; ++j) { v[j] = xr[64 * j]; s += (v[j][0] * v[j][0] + v[j][1] * v[j][1]) + (v[j][2] * v[j][2] + v[j][3] * v[j][3]); }
    const float rs = __builtin_amdgcn_rsqf(wave_sum(s, lane) * (1.0f / DM) + EPSN);
#pragma unroll
    for (int j = 0; j < 8; ++j) { const f32x4 gg = gr[64 * j]; u32x2 w; w.x = cvt_pk_bf16(v[j][0] * rs * gg[0], v[j][1] * rs * gg[1]); w.y = cvt_pk_bf16(v[j][2] * rs * gg[2], v[j][3] * rs * gg[3]); o8[64 * j] = w; }
}

__device__ __forceinline__ void zero_rows16(void* p, int n16, int gt, int NGT) { unsigned z0 = 0u; asm volatile("" : "+v"(z0)); u32x4* z = (u32x4*)p; for (int i = gt; i < n16; i += NGT) z[i] = (u32x4){z0, z0, z0, z0}; }
__device__ __forceinline__ void phase_init_rows(const Params& P) {
    LAUNDER_Z();
    const int lane = tid_l() & 63, gw = bid_l() * 8 + (tid_l() >> 6), NGW = gridDim.x * 8;
    float* H = (float*)(P.ws + zz + WS_H); bf16_t* HN = (bf16_t*)(P.ws + zz + WS_HN); u64* SS = (u64*)(P.ws + zz + WS_SS);
    float zf = 0.f; asm volatile("" : "+v"(zf));
    for (int r = gw; r < MP; r += NGW) {
        const int b = r / LP, pos = r - b * LP; f32x4* o = (f32x4*)(H + (size_t)r * DM) + lane; u32x2* o8 = (u32x2*)(HN + (size_t)r * LDH) + lane;
        if (pos < PADF) {
#pragma unroll
            for (int j = 0; j < 8; ++j) { o[64 * j] = (f32x4){zf, zf, zf, zf}; o8[64 * j] = (u32x2){__float_as_uint(zf), __float_as_uint(zf)}; }
            if (lane == 0) SS[r] = (u64)__float_as_uint(zf);
        } else {
            const float* src = pos < 64 ? PIN(1) + (size_t)(pos - PADF) * DM : PIN(0) + ((size_t)b * 2048 + (pos - 64)) * DM;
            const f32x4* s4 = (const f32x4*)src + lane; float sq = 0.f;
#pragma unroll
            for (int j = 0; j < 8; ++j) { const f32x4 v = s4[64 * j]; o[64 * j] = v; u32x2 w; w.x = cvt_pk_bf16(v[0], v[1]); w.y = cvt_pk_bf16(v[2], v[3]); o8[64 * j] = w; sq += (v[0] * v[0] + v[1] * v[1]) + (v[2] * v[2] + v[3] * v[3]); }
            sq = wave_sum(sq, lane); if (lane == 0) SS[r] = (u64)(sq * SSCALE);
        }
    }
    const int gt = bid_l() * 512 + tid_l(), NGT = gridDim.x * 512;
    for (int i = gt; i < 8 * MP; i += NGT) SS[MP + i] = (u64)__float_as_uint(zf);
    zero_rows16((bf16_t*)(P.ws + zz + WS_HN) - LDH, LDH / 8, gt, NGT); zero_rows16((bf16_t*)(P.ws + zz + WS_HN) + (size_t)MP * LDH, 256 * LDH / 8, gt, NGT);
    zero_rows16((bf16_t*)(P.ws + zz + WS_WSET + WO_WIN) + (size_t)DIN * LDH, (DINP - DIN) * LDH / 8, gt, NGT);
    zero_rows16((bf16_t*)((unsigned char*)P.out + zz + WO_WIN) + (size_t)DIN * LDH, (DINP - DIN) * LDH / 8, gt, NGT);
}

__device__ __forceinline__ void s5_precompute(const Params& P, LAS unsigned char* lds, int l, int g) {
    LAS float* lpr = (LAS float*)lds;
    LAS float* lpi = lpr + 2 * 17 * 64;
    LAS float* bbr = lpi + 2 * 17 * 64;
    LAS float* bbi = bbr + 2048;
    LAS float* ccr = bbi + 2048;
    LAS float* cci = ccr + 2048;
    LAS float* zr = cci + 2048;
    LAS float* zi = zr + 128;
    LAS float* kd = zi + 128;
    LAUNDER_Z();
    const int tid = tid_l();
    if (tid < 128) {
        const int dir = tid >> 6, p = tid & 63; const size_t o = ((size_t)(l * 2 + dir) * 64 + g) * 64 + p;
        const float are = fminf(PIN(4)[o], -1e-4f), aim = PIN(5)[o], dt = expf(PIN(6)[(size_t)(l * 2 + dir) * 64 + g]);
        const float mag = expf(are * dt); float sn, cs; sincosf(aim * dt, &sn, &cs); const float lr = mag * cs, li = mag * sn;
        { float pr = 1.0f, pi = 0.0f;
          for (int dd = 0; dd <= 16; ++dd) { lpr[(dir * 17 + dd) * 64 + p] = pr; lpi[(dir * 17 + dd) * 64 + p] = pi; const float nr = pr * lr - pi * li, ni = pr * li + pi * lr; pr = nr; pi = ni; } }
        const float den = are * are + aim * aim, pp = lr - 1.0f;
        zr[dir * 64 + p] = (pp * are + li * aim) / den; zi[dir * 64 + p] = (li * are - pp * aim) / den;
    }
    __syncthreads();
    for (int e = tid; e < 2048; e += 512) { const int dir = e >> 10, p = (e >> 4) & 63, h = e & 15; const size_t o = (((size_t)(l * 2 + dir) * 64 + g) * 64 + p) * 16 + h;
        const float br = PIN(7)[o], bi = PIN(8)[o], z_r = zr[dir * 64 + p], z_i = zi[dir * 64 + p];
        bbr[e] = z_r * br - z_i * bi; bbi[e] = z_r * bi + z_i * br; }
    for (int e = tid; e < 2048; e += 512) { const int dir = e >> 10, h = (e >> 6) & 15, p = e & 63; const size_t o = (((size_t)(l * 2 + dir) * 64 + g) * 16 + h) * 64 + p;
        ccr[e] = PIN(9)[o]; cci[e] = PIN(10)[o]; }
    __syncthreads();
    for (int e = tid; e < 8192; e += 512) { const int dir = e >> 12, dd = (e >> 8) & 15, h = (e >> 4) & 15, h2 = e & 15; float s = 0.f;
        for (int p = 0; p < 64; ++p) { const float cr = ccr[(dir * 16 + h) * 64 + p], ci = cci[(dir * 16 + h) * 64 + p], lr = lpr[(dir * 17 + dd) * 64 + p], li = lpi[(dir * 17 + dd) * 64 + p];
            const float ur = cr * lr - ci * li, ui = cr * li + ci * lr; s += ur * bbr[(dir * 64 + p) * 16 + h2] - ui * bbi[(dir * 64 + p) * 16 + h2]; }
        kd[e] = s; }
    __syncthreads();
    bf16_t* WST = (bf16_t*)(P.ws + zz + WS_WST) + ((size_t)l * 64 + g) * (256 * LDWS);
    for (int e8 = tid; e8 < 8192; e8 += 512) { const int n = e8 >> 5, k0 = (e8 & 31) * 8; const int part = n >> 6, p = n & 63, dir = part >> 1; float v[8];
#pragma unroll
        for (int j = 0; j < 8; ++j) { const int k = k0 + j, s = k >> 4, h2 = k & 15, pw = dir == 0 ? 15 - s : s; const float lr = lpr[(dir * 17 + pw) * 64 + p], li = lpi[(dir * 17 + pw) * 64 + p], br = bbr[(dir * 64 + p) * 16 + h2], bi = bbi[(dir * 64 + p) * 16 + h2];
            v[j] = (part & 1) ? (lr * bi + li * br) : (lr * br - li * bi); }
        u32x4 o; o.x = cvt_pk_bf16(v[0], v[1]); o.y = cvt_pk_bf16(v[2], v[3]); o.z = cvt_pk_bf16(v[4], v[5]); o.w = cvt_pk_bf16(v[6], v[7]);
        *(u32x4*)(WST + (size_t)n * LDWS + k0) = o; }
    bf16_t* TO = (bf16_t*)(P.ws + zz + WS_TO) + ((size_t)l * 64 + g) * (256 * LDTO);
    const float* dsk = PIN(11) + ((size_t)l * 64 + g) * 16;
    for (int e8 = tid; e8 < 16384; e8 += 512) { const int n = e8 >> 6, k0 = (e8 & 63) * 8; const int t = n >> 4, h = n & 15; float v[8];
#pragma unroll
        for (int j = 0; j < 8; ++j) { const int k = k0 + j;
            if (k < 256) { const int s = k >> 4, h2 = k & 15;
                if (t > s) v[j] = kd[((0 * 16 + (t - s)) * 16 + h) * 16 + h2];
                else if (t < s) v[j] = kd[((1 * 16 + (s - t)) * 16 + h) * 16 + h2];
                else v[j] = kd[((0 * 16 + 0) * 16 + h) * 16 + h2] + kd[((1 * 16 + 0) * 16 + h) * 16 + h2] + (h == h2 ? dsk[h] : 0.f);
            } else { const int kk = k - 256, part = kk >> 6, p = kk & 63, dir = part >> 1, pw = dir == 0 ? t + 1 : 16 - t;
                const float cr = ccr[(dir * 16 + h) * 64 + p], ci = cci[(dir * 16 + h) * 64 + p], lr = lpr[(dir * 17 + pw) * 64 + p], li = lpi[(dir * 17 + pw) * 64 + p];
                v[j] = (part & 1) ? -(cr * li + ci * lr) : (cr * lr - ci * li); } }
        u32x4 o; o.x = cvt_pk_bf16(v[0], v[1]); o.y = cvt_pk_bf16(v[2], v[3]); o.z = cvt_pk_bf16(v[4], v[5]); o.w = cvt_pk_bf16(v[6], v[7]);
        *(u32x4*)(TO + (size_t)n * LDTO + k0) = o; }
    __syncthreads();
}

__device__ __forceinline__ unsigned char* wset_base(const Params& P, int l, int zz) { return (l & 1) ? (unsigned char*)P.out + zz : P.ws + zz + WS_WSET; }
__device__ __forceinline__ void convert_weights(const Params& P, LAS unsigned char* lds, int l, int gw, int NGW, int wave, int lane, int it_lo = 0, int it_hi = 1 << 30) {
    LAUNDER_Z();
    unsigned char* wb = wset_base(P, l, zz);
    LAS float* scr = (LAS float*)(lds + wave * 16384);
    constexpr int I_IN = 32 * 129, I_GLU = 16 * 32, I_OUT = 32 * 64, I_G = 32 * 176, I_DN = 88 * 64, NIT = I_IN + I_GLU + I_OUT + 2 * I_G + I_DN;
    const int ihi = it_hi < NIT ? it_hi : NIT;
    for (int it = it_lo + gw; it < ihi; it += NGW) { int r = it;
        if (r < I_IN) { transpose_item(PIN(3) + (size_t)l * DM * DIN, DM, DIN, (bf16_t*)(wb + WO_WIN), LDH, scr, r, lane, PIN(2) + (size_t)l * DM); continue; } r -= I_IN;
        if (r < I_GLU) { transpose_item(PIN(12) + (size_t)l * 1024 * 1024, 1024, 1024, (bf16_t*)(wb + WO_WGLU), LDG, scr, r, lane, nullptr); continue; } r -= I_GLU;
        if (r < I_OUT) { transpose_item(PIN(19) + (size_t)l * DM * DM, DM, DM, (bf16_t*)(wb + WO_WOUT), LDH, scr, r, lane, nullptr); continue; } r -= I_OUT;
        if (r < I_G) { transpose_item(PIN(21) + (size_t)l * DM * DFF, DM, DFF, (bf16_t*)(wb + WO_WGU), LDH, scr, r, lane, PIN(20) + (size_t)l * DM, 1); continue; } r -= I_G;
        if (r < I_G) { transpose_item(PIN(22) + (size_t)l * DM * DFF, DM, DFF, (bf16_t*)(wb + WO_WGU), LDH, scr, r, lane, PIN(20) + (size_t)l * DM, 2); continue; } r -= I_G;
        transpose_item(PIN(25) + (size_t)l * DFF * DM, DFF, DM, (bf16_t*)(wb + WO_WDN), LDF, scr, r, lane, nullptr);
    }
}

__device__ __forceinline__ void phase_s5_scan(const Params& P, int l, int bofs) {
    LAUNDER_Z();
    const int t = tid_l(); if (t >= 128) return;
    const int idx = (bid_l() - bofs) * 128 + t; if (idx >= 16384 || idx < 0) return;
    const int p4 = idx & 15, dir = (idx >> 4) & 1, b = (idx >> 5) & 7, g = idx >> 8;
    const size_t o = ((size_t)(l * 2 + dir) * 64 + g) * 64 + 4 * p4;
    const float dt = expf(PIN(6)[(size_t)(l * 2 + dir) * 64 + g]);
    f32x4 Lr, Li;
#pragma unroll
    for (int j = 0; j < 4; ++j) { const float are = fminf(PIN(4)[o + j], -1e-4f), aim = PIN(5)[o + j]; const float mag = expf(are * dt * 16.0f); float sn, cs; sincosf(aim * dt * 16.0f, &sn, &cs); Lr[j] = mag * cs; Li[j] = mag * sn; }
    const f32x4* sl = (const f32x4*)((const float*)(P.ws + zz + WS_SLOC) + ((size_t)g * S5ROWP + b * NCH) * 256 + dir * 128 + 4 * p4);
    bf16_t* so = (bf16_t*)(P.ws + zz + WS_UA) + ((size_t)g * S5ROWP + b * NCH) * LDU + 256 + dir * 128 + 4 * p4;
    f32x4 sr = (f32x4){0.f, 0.f, 0.f, 0.f}, si = (f32x4){0.f, 0.f, 0.f, 0.f};
    for (int blk = 0; blk < 11; ++blk) {
        f32x4 xr[12], xi[12];
#pragma unroll
        for (int j = 0; j < 12; ++j) { const int i = blk * 12 + j, n = dir == 0 ? i : NCH - 1 - i; xr[j] = sl[(size_t)n * 64]; xi[j] = sl[(size_t)n * 64 + 16]; }
#pragma unroll
        for (int j = 0; j < 12; ++j) { const int i = blk * 12 + j, n = dir == 0 ? i : NCH - 1 - i;
            u32x2 wr_, wi_; wr_.x = cvt_pk_bf16(sr[0], sr[1]); wr_.y = cvt_pk_bf16(sr[2], sr[3]); wi_.x = cvt_pk_bf16(si[0], si[1]); wi_.y = cvt_pk_bf16(si[2], si[3]);
            *(u32x2*)(so + (size_t)n * LDU) = wr_; *(u32x2*)(so + (size_t)n * LDU + 64) = wi_;
            const f32x4 nr = Lr * sr - Li * si + xr[j], ni = Lr * si + Li * sr + xi[j]; sr = nr; si = ni; }
    }
}

constexpr int MLS = 72;
__device__ __forceinline__ f32x4 mma_tile(const LAS bf16_t* A, const LAS bf16_t* Bt, int fr, int fq, f32x4 acc) {
#pragma unroll
    for (int kk = 0; kk < 2; ++kk) { const bf16x8 a = *(const LAS bf16x8*)(A + fr * MLS + kk * 32 + fq * 8); const bf16x8 b = *(const LAS bf16x8*)(Bt + fr * MLS + kk * 32 + fq * 8);
        acc = __builtin_amdgcn_mfma_f32_16x16x32_bf16(a, b, acc, 0, 0, 0); }
    return acc;
}
__device__ __forceinline__ void phase_mlstm(const Params& P, LAS unsigned char* lds, int l) {
    LAUNDER_Z();
    const int tid = tid_l(), lane = tid & 63, w = tid >> 6, fr = lane & 15, fq = lane >> 4; unsigned char* ws = P.ws + zz;
    LAS bf16_t* Qs = (LAS bf16_t*)lds;
    LAS bf16_t* Ks = Qs + 64 * MLS;
    LAS bf16_t* Kw = Ks + 64 * MLS;
    LAS bf16_t* Ss = Kw + 64 * MLS;
    LAS bf16_t* Vt = Ss + 64 * MLS;
    LAS bf16_t* Ct = Vt + 160 * MLS;
    LAS float* den = (LAS float*)(Ct + 160 * MLS);
    LAS float* CW = den + 64;
    const bf16_t* Z = (const bf16_t*)(ws + WS_Z); const float* Gt = (const float*)(ws + WS_G);
    const int nmb = gridDim.x >= 256 ? 128 : gridDim.x;
    if (bid_l() >= nmb) return;
    for (int item = bid_l(); item < 128; item += nmb) {
        const int dir = item & 1, hd = (item >> 1) & 7, b = item >> 4;
        __syncthreads();
        for (int e = tid; e < 160 * MLS; e += 512) Ct[e] = 0;
        for (int e = tid; e < 32 * MLS; e += 512) Vt[128 * MLS + e] = (e < 64) ? (bf16_t)0x3F80 : (bf16_t)0;
        f32x4 Cst[5];
#pragma unroll
        for (int j = 0; j < 5; ++j) Cst[j] = (f32x4){0.f, 0.f, 0.f, 0.f};
        float m_prev = -1e30f;
        const float gb_i = PIN(17)[l * 32 + (2 * dir) * 8 + hd], gb_f = PIN(17)[l * 32 + (2 * dir + 1) * 8 + hd];
        bf16_t* Hout = (bf16_t*)(ws + WS_HFB) + (size_t)dir * MP * 1024;
        for (int e = tid; e < 512; e += 512) { const int rr = e >> 7, c = e & 127; const int colz = (c < 64 ? hd * 64 + c : 512 + hd * 64 + (c - 64));
            CW[e] = rr < 3 ? PIN(15)[(size_t)l * 3 * 1024 + rr * 1024 + colz] : PIN(16)[(size_t)l * 1024 + colz]; }
        const int wu = __builtin_amdgcn_readfirstlane(w);
        const int colz = (wu < 4 ? hd * 64 + wu * 16 : 512 + hd * 64 + (wu - 4) * 16);
        const int myoff = dir == 0 ? lane : 63 - lane;
        const int gcol_i = (2 * dir) * 8 + hd, gcol_f = (2 * dir + 1) * 8 + hd;
        u32x4 pz[8]; float pg_i, pg_f;
#define ML_PREFETCH(cx) do { const int n_ = dir == 0 ? (cx) : 32 - (cx); const size_t r_ = (size_t)(b * LP + n_ * 64 + myoff); \
            const bf16_t* zp_ = Z + r_ * 3072 + colz; const bf16_t* vp_ = Z + r_ * 3072 + 1024 + hd * 128 + wu * 16; \
            pz[0] = *(const u32x4*)(zp_ - 3072); pz[1] = *(const u32x4*)(zp_ - 3072 + 8); pz[2] = *(const u32x4*)(zp_); pz[3] = *(const u32x4*)(zp_ + 8); \
            pz[4] = *(const u32x4*)(zp_ + 3072); pz[5] = *(const u32x4*)(zp_ + 3072 + 8); pz[6] = *(const u32x4*)(vp_); pz[7] = *(const u32x4*)(vp_ + 8); \
            pg_i = Gt[r_ * 32 + gcol_i]; pg_f = Gt[r_ * 32 + gcol_f]; } while (0)
        ML_PREFETCH(0);
        __syncthreads();
        for (int cix = 0; cix < 33; ++cix) {
            const int n = dir == 0 ? cix : 32 - cix;
            const int rowbase = b * LP + n * 64;
            u32x4 cz[8];
#pragma unroll
            for (int j = 0; j < 8; ++j) cz[j] = pz[j];
            const float cg_i = pg_i, cg_f = pg_f;
            if (cix + 1 < 33) ML_PREFETCH(cix + 1);
            const bool mypad = (n * 64 + myoff) < PADF;
            float li = cg_i + gb_i;
            const float xf = cg_f + gb_f;
            float lf = fminf(xf, 0.f) - __logf(1.0f + __expf(-fabsf(xf)));
            if (mypad) { li = -1e30f; lf = 0.f; }
            float bc = lf;
#pragma unroll
            for (int o = 1; o < 64; o <<= 1) { const float t = shi(bc, lane - o); if (lane >= o) bc += t; }
            const float gsum = shi(bc, 63);
            const float m_loc = wave_max(gsum - bc + li, lane);
            const float wloc = __expf(gsum - bc + li - m_loc);
            const float cv = li - bc;
            float pm = cv;
#pragma unroll
            for (int o = 1; o < 64; o <<= 1) { const float t = shi(pm, lane - o); if (lane >= o) pm = fmaxf(pm, t); }
            const float Mt = fmaxf(m_prev, pm);
            const float sint = __expf(m_prev - Mt);
            const float einv = __expf(-(bc + Mt));
            const float m_new = fmaxf(gsum + m_prev, m_loc);
            const float s_old = __expf(gsum + m_prev - m_new), s_loc = __expf(m_loc - m_new);
            {
                const int i = lane; const bool pad = mypad;
                const unsigned um[8] = {cz[0].x, cz[0].y, cz[0].z, cz[0].w, cz[1].x, cz[1].y, cz[1].z, cz[1].w};
                const unsigned u0[8] = {cz[2].x, cz[2].y, cz[2].z, cz[2].w, cz[3].x, cz[3].y, cz[3].z, cz[3].w};
                const unsigned up[8] = {cz[4].x, cz[4].y, cz[4].z, cz[4].w, cz[5].x, cz[5].y, cz[5].z, cz[5].w};
                float qv[16];
#pragma unroll
                for (int j4 = 0; j4 < 4; ++j4) {
                    const f32x4 w0 = *(const LAS f32x4*)(CW + 0 * 128 + wu * 16 + j4 * 4), w1 = *(const LAS f32x4*)(CW + 1 * 128 + wu * 16 + j4 * 4), w2 = *(const LAS f32x4*)(CW + 2 * 128 + wu * 16 + j4 * 4), bb = *(const LAS f32x4*)(CW + 3 * 128 + wu * 16 + j4 * 4);
#pragma unroll
                    for (int jj = 0; jj < 2; ++jj) { const int j = j4 * 2 + jj;
                        const float x0 = bb[2 * jj] + w0[2 * jj] * bf_lo(um[j]) + w1[2 * jj] * bf_lo(u0[j]) + w2[2 * jj] * bf_lo(up[j]);
                        const float x1 = bb[2 * jj + 1] + w0[2 * jj + 1] * bf_hi(um[j]) + w1[2 * jj + 1] * bf_hi(u0[j]) + w2[2 * jj + 1] * bf_hi(up[j]);
                        qv[2 * j] = pad ? 0.f : siluf_(x0); qv[2 * j + 1] = pad ? 0.f : siluf_(x1); } }
                if (wu < 4) {
                    u32x4 o0, o1; o0.x = cvt_pk_bf16(qv[0] * 0.125f, qv[1] * 0.125f); o0.y = cvt_pk_bf16(qv[2] * 0.125f, qv[3] * 0.125f); o0.z = cvt_pk_bf16(qv[4] * 0.125f, qv[5] * 0.125f); o0.w = cvt_pk_bf16(qv[6] * 0.125f, qv[7] * 0.125f);
                    o1.x = cvt_pk_bf16(qv[8] * 0.125f, qv[9] * 0.125f); o1.y = cvt_pk_bf16(qv[10] * 0.125f, qv[11] * 0.125f); o1.z = cvt_pk_bf16(qv[12] * 0.125f, qv[13] * 0.125f); o1.w = cvt_pk_bf16(qv[14] * 0.125f, qv[15] * 0.125f);
                    *(LAS u32x4*)(Qs + i * MLS + wu * 16) = o0; *(LAS u32x4*)(Qs + i * MLS + wu * 16 + 8) = o1;
                } else {
                    const int d0 = (wu - 4) * 16;
                    u32x4 o0, o1; o0.x = cvt_pk_bf16(qv[0], qv[1]); o0.y = cvt_pk_bf16(qv[2], qv[3]); o0.z = cvt_pk_bf16(qv[4], qv[5]); o0.w = cvt_pk_bf16(qv[6], qv[7]);
                    o1.x = cvt_pk_bf16(qv[8], qv[9]); o1.y = cvt_pk_bf16(qv[10], qv[11]); o1.z = cvt_pk_bf16(qv[12], qv[13]); o1.w = cvt_pk_bf16(qv[14], qv[15]);
                    *(LAS u32x4*)(Ks + i * MLS + d0) = o0; *(LAS u32x4*)(Ks + i * MLS + d0 + 8) = o1;
#pragma unroll
                    for (int j = 0; j < 16; ++j) Kw[(d0 + j) * MLS + i] = f2bf(qv[j] * wloc);
                }
                const unsigned uv[8] = {cz[6].x, cz[6].y, cz[6].z, cz[6].w, cz[7].x, cz[7].y, cz[7].z, cz[7].w};
#pragma unroll
                for (int j = 0; j < 8; ++j) { Vt[(wu * 16 + 2 * j) * MLS + i] = pad ? (bf16_t)0 : (bf16_t)(uv[j] & 0xffffu); Vt[(wu * 16 + 2 * j + 1) * MLS + i] = pad ? (bf16_t)0 : (bf16_t)(uv[j] >> 16); }
            }
            __syncthreads();
            {
                const int st = w & 3;
#pragma unroll
                for (int jj = 0; jj < 2; ++jj) { const int tt = (w >> 2) * 2 + jj;
                    f32x4 a = (f32x4){0.f, 0.f, 0.f, 0.f};
                    a = mma_tile(Ks + st * 16 * MLS, Qs + tt * 16 * MLS, fr, fq, a);
                    const int t = tt * 16 + fr, s0 = st * 16 + 4 * fq; const float Mtt = shi(Mt, t);
                    f32x4 o;
#pragma unroll
                    for (int j = 0; j < 4; ++j) { const float cs = shi(cv, s0 + j); o[j] = (s0 + j <= t) ? a[j] * __expf(cs - Mtt) : 0.f; }
                    u32x2 pk; pk.x = cvt_pk_bf16(o[0], o[1]); pk.y = cvt_pk_bf16(o[2], o[3]);
                    *(LAS u32x2*)(Ss + t * MLS + s0) = pk; }
            }
            __syncthreads();
            f32x4 num[5];
            const int tt = w & 3, tC = tt * 16 + fr; const float sint_t = shi(sint, tC), einv_t = shi(einv, tC);
#pragma unroll
            for (int j = 0; j < 5; ++j) { const int dvt = (w >> 2) * 5 + j;
                f32x4 a1 = (f32x4){0.f, 0.f, 0.f, 0.f}, a2 = (f32x4){0.f, 0.f, 0.f, 0.f};
                a1 = mma_tile(Vt + dvt * 16 * MLS, Ss + tt * 16 * MLS, fr, fq, a1);
                a2 = mma_tile(Ct + dvt * 16 * MLS, Qs + tt * 16 * MLS, fr, fq, a2);
                num[j] = a1 + a2 * sint_t;
                if (dvt == 8 && fq == 0) den[tC] = num[j][0]; }
            __syncthreads();
            {
                const float dn = den[tC]; const float inv = __builtin_amdgcn_rcpf(fmaxf(fabsf(dn), einv_t));
                const int off = dir == 0 ? tC : 63 - tC; const size_t r = (size_t)rowbase + off;
#pragma unroll
                for (int j = 0; j < 5; ++j) { const int dvt = (w >> 2) * 5 + j;
                    if (dvt < 8) store_bf4(Hout + r * 1024 + hd * 128 + dvt * 16 + 4 * fq, num[j] * inv); }
            }
            {
                const int dkt = w & 3;
#pragma unroll
                for (int j = 0; j < 5; ++j) { const int dvt = (w >> 2) * 5 + j;
                    f32x4 a = (f32x4){0.f, 0.f, 0.f, 0.f};
                    a = mma_tile(Kw + dkt * 16 * MLS, Vt + dvt * 16 * MLS, fr, fq, a);
                    Cst[j] = Cst[j] * s_old + a * s_loc;
                    u32x2 pk; pk.x = cvt_pk_bf16(Cst[j][0], Cst[j][1]); pk.y = cvt_pk_bf16(Cst[j][2], Cst[j][3]);
                    *(LAS u32x2*)(Ct + (dvt * 16 + fr) * MLS + dkt * 16 + 4 * fq) = pk; }
            }
            m_prev = m_new;
            __syncthreads();
        }
    }
}

__device__ __forceinline__ void phase_finalize(const Params& P, int l) {
    LAUNDER_Z();
    const int tid = tid_l(), lane = tid & 63, gw = bid_l() * 8 + (tid >> 6), NGW = gridDim.x * 8; unsigned char* ws = P.ws + zz;
    const bf16_t* YG = (const bf16_t*)(ws + WS_YGLU); const bf16_t* HF = (const bf16_t*)(ws + WS_HFB); const bf16_t* HB = HF + (size_t)MP * 1024;
    const bf16_t* Z = (const bf16_t*)(ws + WS_Z); bf16_t* Y = (bf16_t*)(ws + WS_Y);
    float g1[16], g2[16];
    { const f32x4* p1 = (const f32x4*)(PIN(14) + (size_t)l * 1024 + lane * 16); const f32x4* p2 = (const f32x4*)(PIN(18) + (size_t)l * 1024 + lane * 16);
#pragma unroll
      for (int j = 0; j < 4; ++j) { const f32x4 a = p1[j], b = p2[j]; g1[4 * j] = a[0]; g1[4 * j + 1] = a[1]; g1[4 * j + 2] = a[2]; g1[4 * j + 3] = a[3]; g2[4 * j] = b[0]; g2[4 * j + 1] = b[1]; g2[4 * j + 2] = b[2]; g2[4 * j + 3] = b[3]; } }
    for (int r = gw; r < MP; r += NGW) {
        u32x4* yo = (u32x4*)(Y + (size_t)r * LDH);
        if ((r % LP) < PADF) { unsigned z0 = 0u; asm volatile("" : "+v"(z0)); for (int j = 0; j < 4; ++j) yo[lane + 64 * j] = (u32x4){z0, z0, z0, z0}; continue; }
        const size_t o = (size_t)r * 1024 + lane * 16;
        const u32x4 f0 = *(const u32x4*)(HF + o), f1 = *(const u32x4*)(HF + o + 8), b0 = *(const u32x4*)(HB + o), b1 = *(const u32x4*)(HB + o + 8);
        const u32x4 q0 = *(const u32x4*)(Z + (size_t)r * 3072 + 2048 + lane * 16), q1 = *(const u32x4*)(Z + (size_t)r * 3072 + 2048 + lane * 16 + 8);
        {
            const u32x4 a0 = *(const u32x4*)(YG + (size_t)r * 1024 + lane * 16), a1 = *(const u32x4*)(YG + (size_t)r * 1024 + lane * 16 + 8);
            const unsigned uu[8] = {a0.x, a0.y, a0.z, a0.w, a1.x, a1.y, a1.z, a1.w}; float v[16]; float s = 0.f;
#pragma unroll
            for (int j = 0; j < 8; ++j) { v[2 * j] = bf_lo(uu[j]); v[2 * j + 1] = bf_hi(uu[j]); s += v[2 * j] * v[2 * j] + v[2 * j + 1] * v[2 * j + 1]; }
            const float rs = __builtin_amdgcn_rsqf(wave_sum(s, lane) * (1.0f / 1024.0f) + EPSN);
            const float* g = g1;
            u32x4 o0, o1; o0.x = cvt_pk_bf16(v[0] * rs * g[0], v[1] * rs * g[1]); o0.y = cvt_pk_bf16(v[2] * rs * g[2], v[3] * rs * g[3]); o0.z = cvt_pk_bf16(v[4] * rs * g[4], v[5] * rs * g[5]); o0.w = cvt_pk_bf16(v[6] * rs * g[6], v[7] * rs * g[7]);
            o1.x = cvt_pk_bf16(v[8] * rs * g[8], v[9] * rs * g[9]); o1.y = cvt_pk_bf16(v[10] * rs * g[10], v[11] * rs * g[11]); o1.z = cvt_pk_bf16(v[12] * rs * g[12], v[13] * rs * g[13]); o1.w = cvt_pk_bf16(v[14] * rs * g[14], v[15] * rs * g[15]);
            yo[lane * 2] = o0; yo[lane * 2 + 1] = o1;
        }
        {
            const unsigned uf[8] = {f0.x, f0.y, f0.z, f0.w, f1.x, f1.y, f1.z, f1.w}, ub[8] = {b0.x, b0.y, b0.z, b0.w, b1.x, b1.y, b1.z, b1.w}, uo[8] = {q0.x, q0.y, q0.z, q0.w, q1.x, q1.y, q1.z, q1.w};
            float v[16]; float s = 0.f;
#pragma unroll
            for (int j = 0; j < 8; ++j) { v[2 * j] = bf_lo(uf[j]) + bf_lo(ub[j]); v[2 * j + 1] = bf_hi(uf[j]) + bf_hi(ub[j]); s += v[2 * j] * v[2 * j] + v[2 * j + 1] * v[2 * j + 1]; }
            s += shx(s, 1, lane); s += shx(s, 2, lane); s += shx(s, 4, lane);
            const float rs = __builtin_amdgcn_rsqf(s * (1.0f / 128.0f) + EPSN);
            const float* g = g2;
            float ov[16];
#pragma unroll
            for (int j = 0; j < 8; ++j) { ov[2 * j] = sigmoidf_(bf_lo(uo[j])) * v[2 * j] * rs * g[2 * j]; ov[2 * j + 1] = sigmoidf_(bf_hi(uo[j])) * v[2 * j + 1] * rs * g[2 * j + 1]; }
            u32x4 o0, o1; o0.x = cvt_pk_bf16(ov[0], ov[1]); o0.y = cvt_pk_bf16(ov[2], ov[3]); o0.z = cvt_pk_bf16(ov[4], ov[5]); o0.w = cvt_pk_bf16(ov[6], ov[7]);
            o1.x = cvt_pk_bf16(ov[8], ov[9]); o1.y = cvt_pk_bf16(ov[10], ov[11]); o1.z = cvt_pk_bf16(ov[12], ov[13]); o1.w = cvt_pk_bf16(ov[14], ov[15]);
            yo[128 + lane * 2] = o0; yo[128 + lane * 2 + 1] = o1;
        }
    }
}

__device__ __forceinline__ void phase_final(const Params& P) {
    LAUNDER_Z();
    const int lane = tid_l() & 63, gw = bid_l() * 8 + (tid_l() >> 6), NGW = gridDim.x * 8;
    const float* H = (const float*)(P.ws + zz + WS_H);
    for (int q = gw; q < NB * 2048; q += NGW) {
        const int b = q >> 11, t = q & 2047; const size_t r = (size_t)b * LP + 64 + t;
        const f32x4* xr = (const f32x4*)(H + r * DM) + lane; const f32x4* gr = (const f32x4*)PIN(26) + lane; f32x4* o = (f32x4*)(P.out + zz + (size_t)q * DM) + lane;
        f32x4 v[8]; float s = 0.f;
#pragma unroll
        for (int j = 0; j < 8; ++j) { v[j] = xr[64 * j]; s += (v[j][0] * v[j][0] + v[j][1] * v[j][1]) + (v[j][2] * v[j][2] + v[j][3] * v[j][3]); }
        const float rs = __builtin_amdgcn_rsqf(wave_sum(s, lane) * (1.0f / DM) + EPSN);
#pragma unroll
        for (int j = 0; j < 8; ++j) o[64 * j] = v[j] * rs * gr[64 * j];
    }
}

#define XB_TMO      128
#define XB_XCNT(j)  (256  + 64 * (j))
#define XB_XSUB(j)  (1280 + 64 * (j))
#define XB_XGEN(j)  (2304 + 64 * (j))
#define XB_TOP      3328
#define XB_TOPGEN   3392
#define XCD_BAR_WORDS 3456
#define XB_SPIN_CAP (1u << 22)
__device__ __forceinline__ unsigned xb_ld(unsigned* p)              { return __hip_atomic_load(p, __ATOMIC_RELAXED, __HIP_MEMORY_SCOPE_AGENT); }
__device__ __forceinline__ unsigned xb_add(unsigned* p, unsigned v) { return __hip_atomic_fetch_add(p, v, __ATOMIC_RELAXED, __HIP_MEMORY_SCOPE_AGENT); }
__device__ __forceinline__ unsigned xb_xcc_id() { return (unsigned)__builtin_amdgcn_s_getreg((3 << 11) | 20) & 0xFu; }
#define XB_SPIN(cond, bar) do { unsigned _sp = 0; while (cond) { __builtin_amdgcn_s_sleep(1); \
    if ((++_sp & 255u) == 0u) { if (xb_ld(&(bar)[XB_TMO])) break; if (_sp > XB_SPIN_CAP) { atomicAdd(&(bar)[XB_TMO], 1u); break; } } } } while (0)
__device__ __forceinline__ void xcd_barrier(unsigned* bar, volatile LAS unsigned* st, unsigned G) {
    asm volatile("s_waitcnt vmcnt(0)" ::: "memory");
    __syncthreads();
    if (tid_l() == 0) {
        __builtin_amdgcn_s_waitcnt(0);
        const unsigned x = xb_xcc_id();
        unsigned nloc = st[0], nx = st[1];
        if (nloc == 0u) {
            unsigned sum, cnt, mine, sp = 0u;
            for (;;) {
                sum = 0u; cnt = 0u; mine = 0u;
#pragma unroll
                for (unsigned j = 0; j < 16; ++j) { const unsigned c = xb_ld(&bar[XB_XCNT(j)]); sum += c; cnt += (c > 0u) ? 1u : 0u; mine = (j == x) ? c : mine; }
                if (sum == G) break;
                __builtin_amdgcn_s_sleep(1);
                if ((++sp & 255u) == 0u) { if (xb_ld(&bar[XB_TMO])) break; if (sp > XB_SPIN_CAP) { atomicAdd(&bar[XB_TMO], 1u); break; } }
            }
            nloc = mine > 0u ? mine : 1u; nx = cnt > 0u ? cnt : 1u; st[0] = nloc; st[1] = nx;
        }
        const unsigned old = xb_add(&bar[XB_XSUB(x)], 1u);
        const unsigned gen = old / nloc;
        if (old + 1u == (gen + 1u) * nloc) {
            __builtin_amdgcn_fence(__ATOMIC_RELEASE, "agent");
            asm volatile("s_waitcnt vmcnt(0)" ::: "memory");
            const unsigned og = xb_add(&bar[XB_TOP], 1u);
            const unsigned tg = og / nx;
            if (og + 1u == (tg + 1u) * nx) xb_add(&bar[XB_TOPGEN], 1u);
            else XB_SPIN(xb_ld(&bar[XB_TOPGEN]) == tg, bar);
            __builtin_amdgcn_fence(__ATOMIC_ACQUIRE, "agent");
            xb_add(&bar[XB_XGEN(x)], 1u);
            asm volatile("s_waitcnt vmcnt(0)" ::: "memory");
        } else {
            XB_SPIN(xb_ld(&bar[XB_XGEN(x)]) == gen, bar);
            __builtin_amdgcn_fence(__ATOMIC_ACQUIRE, "agent");
            asm volatile("s_waitcnt vmcnt(0)" ::: "memory");
        }
    }
    __syncthreads();
}

__global__ void __launch_bounds__(512, 2) mk_fwd(Params P) {
    extern __shared__ __attribute__((aligned(16))) unsigned char lds_raw[];
    LAS unsigned char* lds = (LAS unsigned char*)lds_raw;
    cg::grid_group grid = cg::this_grid();
    volatile LAS unsigned* xst = (volatile LAS unsigned*)(lds + 131072);
    if (threadIdx.x < 4) xst[threadIdx.x] = 0u;
    __syncthreads();
    unsigned char* ws = P.ws;
    for (int ph = P.ph_lo; ph < P.ph_hi; ++ph) {
        if (ph == 0) {
            if (bid_l() == 0) { for (int i = tid_l(); i < 8192 + 1024 + XCD_BAR_WORDS; i += 512) ((unsigned*)ws)[i] = 0u; }
            phase_init_rows(P);
            for (int pr = bid_l(); pr < DEPTH * 64; pr += gridDim.x) s5_precompute(P, lds, pr >> 6, pr & 63);
            __syncthreads();
            convert_weights(P, lds, 0, bid_l() * 8 + (tid_l() >> 6), gridDim.x * 8, tid_l() >> 6, tid_l() & 63);
        }
        else if (ph == NPHASES - 1) phase_final(P);
        else {
            const int l = (ph - 1) / NPH_L, k = (ph - 1) % NPH_L;
            GemmDesc d; d.layer = l; d.nB = 1; d.sA = 0; d.sB = 0; d.A = nullptr; d.Bt = nullptr; d.lda = d.ldb = d.K = 256; d.nM = d.nN = 1; d.epi = 0; d.ssi = 0; d.amode = 0; d.split = 0; d.perm = 0; d.ubase = 0; d.umax = 0x7fffffff; d.gG = gridDim.x; d.gc = bid_l(); bool isg = false;
            const unsigned char* wb = (l & 1) ? (const unsigned char*)P.out : ws + WS_WSET;
            switch (k) {
            case 0: { const int gt = bid_l() * 512 + tid_l(), NGT = gridDim.x * 512; zero_rows16((bf16_t*)(ws + WS_Z) - 3072, 384, gt, NGT); zero_rows16((bf16_t*)(ws + WS_Z) + (size_t)MP * 3072, 384, gt, NGT); }
                d.A = (const bf16_t*)(ws + WS_HN); d.Bt = (const bf16_t*)(wb + WO_WIN); d.lda = LDH; d.ldb = LDH; d.K = DM; d.nM = MP / 256; d.nN = DINP / 256; d.epi = EPI_WIN; d.ssi = 2 * l; d.perm = 1; isg = true; break;
            case 1:
                if (bid_l() < 128) phase_mlstm(P, lds, l);
                else {
                    d.gG = gridDim.x - 128; d.gc = bid_l() - 128;
                    d.A = (const bf16_t*)(ws + WS_UA); d.Bt = (const bf16_t*)(ws + WS_WST) + (size_t)l * 64 * (256 * LDWS); d.lda = LDU; d.ldb = LDWS; d.K = 256; d.nM = S5ROWP / 256; d.nN = 1; d.nB = 64; d.sA = (size_t)S5ROWP * LDU; d.sB = 256 * LDWS; d.epi = EPI_S5A;
                    gemm_phase(P, lds, d);
                    xcd_barrier((unsigned*)ws + 8192 + 1024, xst + 2, gridDim.x - 128);
                    phase_s5_scan(P, l, 128);
                    xcd_barrier((unsigned*)ws + 8192 + 1024, xst + 2, gridDim.x - 128);
                    d.Bt = (const bf16_t*)(ws + WS_TO) + (size_t)l * 64 * (256 * LDTO); d.ldb = LDTO; d.K = 512; d.sB = 256 * LDTO; d.epi = EPI_S5C; d.perm = 1;
                    gemm_phase(P, lds, d);
                    xcd_barrier((unsigned*)ws + 8192 + 1024, xst + 2, gridDim.x - 128);
                    d.A = (const bf16_t*)(ws + WS_YGELU); d.Bt = (const bf16_t*)(wb + WO_WGLU); d.lda = LDG; d.ldb = LDG; d.K = 1024; d.nM = MP / 256; d.nN = 4; d.nB = 1; d.sA = 0; d.sB = 0; d.epi = EPI_GLU; d.perm = 1; d.umax = 2 * (gridDim.x - 128); isg = true;
                    if (bid_l() == 128 && tid_l() == 0) __hip_atomic_store((unsigned*)ws + 128, (unsigned)(l + 1), __ATOMIC_RELAXED, __HIP_MEMORY_SCOPE_AGENT);
                }
                break;
            case 2: phase_finalize(P, l); break;
            case 3: d.A = (const bf16_t*)(ws + WS_Y); d.Bt = (const bf16_t*)(wb + WO_WOUT); d.lda = LDH; d.ldb = LDH; d.K = DM; d.nM = MP / 256; d.nN = 8; d.epi = EPI_RES; d.ssi = 2 * l + 1; d.split = 4; d.perm = 1; isg = true; break;
            case 4: d.A = (const bf16_t*)(ws + WS_HN) - LDH; d.Bt = (const bf16_t*)(wb + WO_WGU); d.lda = LDH; d.ldb = LDH; d.K = DM; d.nM = 69; d.nN = 44; d.epi = EPI_FFN; d.ssi = 2 * l + 1; d.amode = 1; d.perm = 1; isg = true; break;
            case 5: d.A = (const bf16_t*)(ws + WS_ACT); d.Bt = (const bf16_t*)(wb + WO_WDN); d.lda = LDF; d.ldb = LDF; d.K = DFF; d.nM = MP / 256; d.nN = 8; d.epi = EPI_RES; d.ssi = 2 * l + 2; d.split = 4; d.perm = 1; isg = true; break;
            }
            if (isg) gemm_phase(P, lds, d);
            if (k == 0 && l + 1 < DEPTH) {
                const int nun = (MP / 256) * (DINP / 256), nbusy = nun - (nun / (int)gridDim.x) * (int)gridDim.x; const int t_ = tid_l(); __syncthreads();
                if (bid_l() >= nbusy) convert_weights(P, lds, l + 1, (bid_l() - nbusy) * 8 + (t_ >> 6), (gridDim.x - nbusy) * 8, t_ >> 6, t_ & 63, 0, CV_SPLIT1);
            }
            if (k == 1 && l + 1 < DEPTH && bid_l() < 128) {
                const int t_ = tid_l(); __syncthreads();
                convert_weights(P, lds, l + 1, bid_l() * 8 + (t_ >> 6), 128 * 8, t_ >> 6, t_ & 63, CV_SPLIT1, CV_SPLIT2);
            }
            if (k == 1 && bid_l() < 128) {
                const int ntail = (MP / 256) * 4 - 2 * ((int)gridDim.x - 128);
                if ((int)bid_l() < ntail) {
                    __syncthreads();
                    if (tid_l() == 0) { unsigned sp = 0; while (__hip_atomic_load((unsigned*)ws + 128, __ATOMIC_RELAXED, __HIP_MEMORY_SCOPE_AGENT) < (unsigned)(l + 1)) { __builtin_amdgcn_s_sleep(4); if (++sp > (1u << 24)) break; }
                        __builtin_amdgcn_fence(__ATOMIC_ACQUIRE, "agent"); asm volatile("s_waitcnt vmcnt(0)" ::: "memory"); }
                    __syncthreads();
                    d.A = (const bf16_t*)(ws + WS_YGELU); d.Bt = (const bf16_t*)(wb + WO_WGLU); d.lda = LDG; d.ldb = LDG; d.K = 1024; d.nM = MP / 256; d.nN = 4; d.nB = 1; d.sA = 0; d.sB = 0; d.epi = EPI_GLU; d.perm = 1;
                    d.ubase = 2 * ((int)gridDim.x - 128); d.umax = 0x7fffffff; d.gG = ntail; d.gc = bid_l();
                    gemm_phase(P, lds, d);
                }
            }
            if (k == 5 && l + 1 < DEPTH) {
                const int nun = (MP / 256) * 8, nfull = (nun / (int)gridDim.x) * (int)gridDim.x, nbusy = (nun - nfull) * 4;
                const int t_ = tid_l(); __syncthreads();
                if (nbusy == 0 || nbusy >= (int)gridDim.x) convert_weights(P, lds, l + 1, bid_l() * 8 + (t_ >> 6), gridDim.x * 8, t_ >> 6, t_ & 63, CV_SPLIT2);
                else if (bid_l() >= nbusy) convert_weights(P, lds, l + 1, (bid_l() - nbusy) * 8 + (t_ >> 6), (gridDim.x - nbusy) * 8, t_ >> 6, t_ & 63, CV_SPLIT2);
            }
        }
        if (ph + 1 < P.ph_hi) { if (ph == 0) { grid.sync(); if (threadIdx.x == 0) { (void)xb_add((unsigned*)ws + 1024 + XB_XCNT(xb_xcc_id()), 1u); if (blockIdx.x >= 128) (void)xb_add((unsigned*)ws + 8192 + 1024 + XB_XCNT(xb_xcc_id()), 1u); } } else xcd_barrier((unsigned*)ws + 1024, xst, gridDim.x); }
    }
}

extern "C" void kernel_launch(void* const* d_in, const int* in_sizes, int n_in, void* d_out, int out_size, void* d_ws, size_t ws_size, hipStream_t stream) {
    static int grid = 0;
    if (grid == 0) {
        int dev = 0, cus = 0, per_cu = 0;
        hipGetDevice(&dev); hipDeviceGetAttribute(&cus, hipDeviceAttributeMultiprocessorCount, dev);
        if (hipFuncSetAttribute((const void*)mk_fwd, hipFuncAttributeMaxDynamicSharedMemorySize, LDS_BYTES) != hipSuccess) { fprintf(stderr, "kernel_launch: hipFuncSetAttribute failed\n"); grid = -1; return; }
        if (hipOccupancyMaxActiveBlocksPerMultiprocessor(&per_cu, (const void*)mk_fwd, 512, LDS_BYTES) != hipSuccess || per_cu < 1) { fprintf(stderr, "kernel_launch: occupancy query says %d\n", per_cu); per_cu = 1; }
        (void)hipGetLastError();
        grid = cus;
        if (ws_size < WS_END) fprintf(stderr, "kernel_launch: workspace too small: %zu < %zu\n", ws_size, (size_t)WS_END);
    }
    if (grid < 0) return;
    Params p{};
    for (int i = 0; i < 27; ++i) p.in[i] = (const float*)d_in[i];
    p.out = (float*)d_out; p.ws = (unsigned char*)d_ws; p.ph_lo = 0; p.ph_hi = NPHASES;
    void* args[] = {&p};
    hipError_t e = hipLaunchCooperativeKernel((const void*)mk_fwd, dim3(grid), dim3(512), args, LDS_BYTES, stream);
    if (e != hipSuccess) fprintf(stderr, "cooperative launch failed: %s (grid %d)\n", hipGetErrorString(e), grid);
}
```

```cpp
#include <hip/hip_runtime.h>
#include <hip/hip_cooperative_groups.h>
#include <cstdio>
namespace cg = cooperative_groups;

#define LAS __attribute__((address_space(3)))
typedef unsigned short bf16_t;
typedef short bf16x8 __attribute__((ext_vector_type(8)));
typedef float f32x4 __attribute__((ext_vector_type(4)));
typedef unsigned u32x4 __attribute__((ext_vector_type(4)));
typedef unsigned u32x2 __attribute__((ext_vector_type(2)));

constexpr int DM = 2048, NB = 8, LP = 2112, PADF = 48, MP = NB * LP;
constexpr int DIN = 4128, DINP = 4352, DFF = 5632, DEPTH = 4;
constexpr int NCH = LP / 16;
constexpr int S5ROWS = NB * NCH;
constexpr int S5ROWP = 1280;
constexpr float EPSN = 1e-6f;
constexpr int LDH = 2112, LDF = 5696, LDG = 1088, LDU = 576, LDWS = 320, LDTO = 576;
constexpr int CV_SPLIT1 = 7075, CV_SPLIT2 = 14150;
constexpr int NPH_L = 6, NPHASES = 2 + DEPTH * NPH_L;

constexpr size_t MiB = 1u << 20;
constexpr size_t WO_WIN = 0 * MiB, WO_WGLU = 18 * MiB, WO_WOUT = 21 * MiB, WO_WGU = 30 * MiB, WO_WDN = 76 * MiB;
constexpr size_t WS_WSET = 1 * MiB;
constexpr size_t WS_WST = 100 * MiB, WS_TO = 140 * MiB, WS_H = 212 * MiB, WS_HN = 344 * MiB + 8192, WS_G = 413 * MiB, WS_Y = 416 * MiB;
constexpr size_t WS_UA = 485 * MiB, WS_Z = 576 * MiB, WS_SLOC = 676 * MiB, WS_YGELU = 676 * MiB, WS_YGLU = 716 * MiB, WS_HFB = 756 * MiB;
constexpr size_t WS_GT = 486 * MiB, WS_ACT = 669 * MiB, WS_SS = 854 * MiB, WS_END = 856 * MiB;
constexpr int LDS_BYTES = 147456;

struct Params { const float* in[27]; float* out; unsigned char* ws; int ph_lo, ph_hi; };

#define LAUNDER_Z() int zz = 0; asm volatile("" : "+s"(zz))
#define PIN(i) (P.in[(i) + zz])
__device__ __forceinline__ int tid_l() { int w = __builtin_amdgcn_readfirstlane(threadIdx.x >> 6); asm volatile("" : "+s"(w)); int ln = __builtin_amdgcn_mbcnt_hi(~0u, __builtin_amdgcn_mbcnt_lo(~0u, 0u)); asm volatile("" : "+v"(ln)); return w * 64 + ln; }
__device__ __forceinline__ int bid_l() { int t = blockIdx.x; asm volatile("" : "+s"(t)); return t; }
__device__ __forceinline__ unsigned cvt_pk_bf16(float lo, float hi) { unsigned r; asm("v_cvt_pk_bf16_f32 %0, %1, %2" : "=v"(r) : "v"(lo), "v"(hi)); return r; }
__device__ __forceinline__ float bf_lo(unsigned w) { return __uint_as_float(w << 16); }
__device__ __forceinline__ float bf_hi(unsigned w) { return __uint_as_float(w & 0xffff0000u); }
__device__ __forceinline__ float bf2f(bf16_t b) { return __uint_as_float((unsigned)b << 16); }
__device__ __forceinline__ bf16_t f2bf(float f) { return (bf16_t)(cvt_pk_bf16(f, 0.f) & 0xffffu); }
__device__ __forceinline__ float sigmoidf_(float x) { return __builtin_amdgcn_rcpf(1.0f + __expf(-x)); }
__device__ __forceinline__ float siluf_(float x) { return x * sigmoidf_(x); }
__device__ __forceinline__ float gelu_tanh(float x) { const float u = 0.7978845608028654f * (x + 0.044715f * x * x * x); return x * __builtin_amdgcn_rcpf(1.0f + __expf(-2.0f * u)); }
__device__ __forceinline__ float shx(float v, int o, int lane) { return __int_as_float(__builtin_amdgcn_ds_bpermute((lane ^ o) << 2, __float_as_int(v))); }
__device__ __forceinline__ float shi(float v, int idx) { return __int_as_float(__builtin_amdgcn_ds_bpermute(idx << 2, __float_as_int(v))); }
__device__ __forceinline__ float wave_sum(float v, int lane) {
#pragma unroll
    for (int o = 1; o < 64; o <<= 1) v += shx(v, o, lane);
    return v;
}
__device__ __forceinline__ float wave_max(float v, int lane) {
#pragma unroll
    for (int o = 1; o < 64; o <<= 1) v = fmaxf(v, shx(v, o, lane));
    return v;
}

__device__ __forceinline__ float dpp_shr(float v, float ident, const int n) {
    switch (n) {
    case 1: return __int_as_float(__builtin_amdgcn_update_dpp(__float_as_int(ident), __float_as_int(v), 0x111, 0xf, 0xf, false));
    case 2: return __int_as_float(__builtin_amdgcn_update_dpp(__float_as_int(ident), __float_as_int(v), 0x112, 0xf, 0xf, false));
    case 4: return __int_as_float(__builtin_amdgcn_update_dpp(__float_as_int(ident), __float_as_int(v), 0x114, 0xf, 0xf, false));
    default: return __int_as_float(__builtin_amdgcn_update_dpp(__float_as_int(ident), __float_as_int(v), 0x118, 0xf, 0xf, false));
    }
}
__device__ __forceinline__ float rdlane(float v, const int l) { return __int_as_float(__builtin_amdgcn_readlane(__float_as_int(v), l)); }
__device__ __forceinline__ float wave_incl_sum(float v, int lane) {
    v += dpp_shr(v, 0.f, 1); v += dpp_shr(v, 0.f, 2); v += dpp_shr(v, 0.f, 4); v += dpp_shr(v, 0.f, 8);
    const float s0 = rdlane(v, 15), s1 = rdlane(v, 31), s2 = rdlane(v, 47); const int q = lane >> 4;
    return v + (q == 0 ? 0.f : (q == 1 ? s0 : (q == 2 ? s0 + s1 : (s0 + s1) + s2)));
}
__device__ __forceinline__ float wave_incl_max(float v, int lane) {
    const float NI = -3.0e38f;
    v = fmaxf(v, dpp_shr(v, NI, 1)); v = fmaxf(v, dpp_shr(v, NI, 2)); v = fmaxf(v, dpp_shr(v, NI, 4)); v = fmaxf(v, dpp_shr(v, NI, 8));
    const float m0 = rdlane(v, 15), m1 = fmaxf(m0, rdlane(v, 31)), m2 = fmaxf(m1, rdlane(v, 47)); const int q = lane >> 4;
    return fmaxf(v, q == 0 ? NI : (q == 1 ? m0 : (q == 2 ? m1 : m2)));
}
constexpr int BM = 256, BK = 64, HALF = 128, HTB = HALF * BK * 2;
__device__ __forceinline__ int lds_byte(int r, int c) { const int st = (r >> 4) * 2 + (c >> 5), rr = r & 15, cc = c & 31, ob = rr * 64 + cc * 2; return st * 1024 + (ob ^ (((ob >> 9) & 1) << 5)); }
__device__ __forceinline__ void stage_rc(int b, int& R, int& C) { const int st = b / 1024, sb = b % 1024, swz = sb ^ (((sb >> 9) & 1) << 5); R = (st >> 1) * 16 + swz / 64; C = (st & 1) * 32 + (swz % 64) / 2; }

struct Unit { int pm, pn, b, piece, tu, k0, nt; };
struct GemmDesc { const bf16_t* A; const bf16_t* Bt; int lda, ldb, K, nM, nN, nB; size_t sA, sB; int epi, layer, ssi, amode, gG, gc, split, ubase, umax, perm; };
enum { EPI_WIN = 0, EPI_S5A = 1, EPI_S5C = 2, EPI_GLU = 3, EPI_RES = 4, EPI_FFN = 5 };

__device__ __forceinline__ bool next_unit(const GemmDesc& d, int i, int G, int c, Unit& u) {
    const int per = d.nM * d.nN; long L = (long)d.ubase + (long)i * G + c; const int ntf = d.K / BK;
    if (L >= d.umax) return false;
    u.piece = -1; u.tu = 0; u.k0 = 0; u.nt = ntf;
    if (d.split > 0) { const int nfull = (per / G) * G;
        if (L >= nfull) { const long q = L - nfull; if (q >= (long)(per - nfull) * d.split) return false;
            u.tu = (int)(q / d.split); u.piece = (int)(q % d.split); u.nt = ntf / d.split; u.k0 = u.piece * u.nt; L = nfull + u.tu; } }
    if (L >= (long)per * d.nB) return false;
    u.b = (int)(L / per); int wgid = (int)(L % per);
    { const int q = per / 8, r = per % 8, xcd = wgid % 8, off = wgid / 8; wgid = (xcd < r ? xcd * (q + 1) : r * (q + 1) + (xcd - r) * q) + off; }
    const int nig = 8 * d.nN, gid = wgid / nig, fm = gid * 8, gsz = (d.nM - fm) < 8 ? (d.nM - fm) : 8;
    u.pm = fm + ((wgid % nig) % gsz); u.pn = (wgid % nig) / gsz; return true;
}

__device__ __forceinline__ void store_bf4(bf16_t* p, f32x4 v) { u32x2 w; w.x = cvt_pk_bf16(v[0], v[1]); w.y = cvt_pk_bf16(v[2], v[3]); *(u32x2*)p = w; }
__device__ __forceinline__ f32x4 load_bf4(const bf16_t* p) { const u32x2 w = *(const u32x2*)p; return (f32x4){bf_lo(w.x), bf_hi(w.x), bf_lo(w.y), bf_hi(w.y)}; }

typedef unsigned long long u64;
constexpr float SSCALE = 16777216.0f;
__device__ __forceinline__ float row_rs(const u64* ss, int r) { return __builtin_amdgcn_rsqf((float)ss[r] * (1.0f / (SSCALE * DM)) + EPSN); }
__device__ __forceinline__ void gemm_epilogue(const Params& P, const GemmDesc& d, const f32x4 (&acc)[2][2][4][2], const Unit& u, int wr, int wc, int fr, int fq) {
    LAUNDER_Z(); unsigned char* ws = P.ws + zz; const int l = d.layer;
    int lane;
    { const int t2 = tid_l(); const int w2 = __builtin_amdgcn_readfirstlane(t2 >> 6); wr = w2 >> 2; wc = w2 & 3; lane = t2 & 63; fr = lane & 15; fq = lane >> 4; }
    const int rbase = u.pm * BM + wr * 64 + fr, cbase = u.pn * BM + wc * 32 + 4 * fq;
    if (d.epi == EPI_RES) {
        const int cb8 = u.pn * BM + wc * 32 + 8 * fq;
        float* hb = (float*)(ws + WS_H) + (size_t)rbase * DM + cb8; bf16_t* nb = (bf16_t*)(ws + WS_HN) + (size_t)rbase * LDH + cb8;
        u64* ssp = (u64*)(ws + WS_SS) + (size_t)d.ssi * MP + rbase;
#pragma unroll
        for (int ai = 0; ai < 2; ++ai)
#pragma unroll
        for (int mh = 0; mh < 2; ++mh) {
            f32x4 t[2][2][2];
            float* hp = hb + (size_t)(ai * HALF + mh * 32) * DM; asm volatile("" : "+v"(hp));
#pragma unroll
            for (int m = 0; m < 2; ++m)
#pragma unroll
                for (int bj = 0; bj < 2; ++bj)
#pragma unroll
                    for (int n = 0; n < 2; ++n) t[m][bj][n] = *(const f32x4*)(hp + (size_t)(m * 16) * DM + bj * HALF + n * 4);
            float sq[2] = {0.f, 0.f};
#pragma unroll
            for (int m = 0; m < 2; ++m)
#pragma unroll
                for (int bj = 0; bj < 2; ++bj)
#pragma unroll
                    for (int n = 0; n < 2; ++n) { const f32x4 hv = t[m][bj][n] + acc[ai][bj][mh * 2 + m][n]; t[m][bj][n] = hv;
                        __builtin_nontemporal_store(hv, (f32x4*)(hp + (size_t)(m * 16) * DM + bj * HALF + n * 4));
                        sq[m] += (hv[0] * hv[0] + hv[1] * hv[1]) + (hv[2] * hv[2] + hv[3] * hv[3]); }
            bf16_t* np = nb + (size_t)(ai * HALF + mh * 32) * LDH; asm volatile("" : "+v"(np));
#pragma unroll
            for (int m = 0; m < 2; ++m) {
#pragma unroll
                for (int bj = 0; bj < 2; ++bj) { u32x4 o; o.x = cvt_pk_bf16(t[m][bj][0][0], t[m][bj][0][1]); o.y = cvt_pk_bf16(t[m][bj][0][2], t[m][bj][0][3]); o.z = cvt_pk_bf16(t[m][bj][1][0], t[m][bj][1][1]); o.w = cvt_pk_bf16(t[m][bj][1][2], t[m][bj][1][3]);
                    *(u32x4*)(np + (size_t)(m * 16) * LDH + bj * HALF) = o; }
                float q = sq[m]; q += shx(q, 16, lane); q += shx(q, 32, lane);
                if (fq == 0) atomicAdd(ssp + ai * HALF + mh * 32 + m * 16, (u64)(q * SSCALE));
            }
        }
        return;
    }
    if (d.epi == EPI_FFN) {
        const int ccol = u.pn * 128 + wc * 32 + 8 * fq;
        const float* cwb = PIN(23) + (size_t)l * 3 * DFF + ccol; const float* cbb = PIN(24) + (size_t)l * DFF + ccol;
        const u64* ssb = (const u64*)(ws + WS_SS) + (size_t)d.ssi * MP;
#pragma unroll
        for (int ai = 0; ai < 2; ++ai) {
            const int row0 = u.pm * 248 + (ai * 2 + wr) * 62 - 1 + fr;
            float rsv[4];
#pragma unroll
            for (int m = 0; m < 4; ++m) { int rc = row0 + m * 16; rc = rc < 0 ? 0 : (rc > MP - 1 ? MP - 1 : rc); rsv[m] = row_rs(ssb, rc); }
            bf16_t* ab = (bf16_t*)(ws + WS_ACT) + (size_t)row0 * LDF + ccol;
            u32x2 keep[4];
#pragma unroll
            for (int n = 0; n < 2; ++n) {
                const f32x4 w0 = *(const f32x4*)(cwb + n * 4), w1 = *(const f32x4*)(cwb + DFF + n * 4), w2 = *(const f32x4*)(cwb + 2 * DFF + n * 4), cb = *(const f32x4*)(cbb + n * 4);
                f32x4 X[4], RR[4], RL[4];
#pragma unroll
                for (int m = 0; m < 4; ++m) { X[m] = acc[ai][0][m][n] * rsv[m];
#pragma unroll
                    for (int j = 0; j < 4; ++j) { RR[m][j] = __int_as_float(__builtin_amdgcn_update_dpp(0, __float_as_int(X[m][j]), 0x121, 0xf, 0xf, false));
                                                  RL[m][j] = __int_as_float(__builtin_amdgcn_update_dpp(0, __float_as_int(X[m][j]), 0x12f, 0xf, 0xf, false)); } }
#pragma unroll
                for (int m = 0; m < 4; ++m) {
                    const f32x4 prev = (fr > 0) ? RR[m] : RR[m > 0 ? m - 1 : 0];
                    const f32x4 next = (fr < 15) ? RL[m] : RL[m < 3 ? m + 1 : 3];
                    const f32x4 gt = cb + w0 * prev + w1 * X[m] + w2 * next; const f32x4 v = acc[ai][1][m][n] * rsv[m];
                    const int lr = m * 16 + fr, row = row0 + m * 16;
                    u32x2 pk; pk.x = cvt_pk_bf16(siluf_(gt[0]) * v[0], siluf_(gt[1]) * v[1]); pk.y = cvt_pk_bf16(siluf_(gt[2]) * v[2], siluf_(gt[3]) * v[3]);
                    if (n == 0) keep[m] = pk;
                    else if (lr >= 1 && lr <= 62 && row < MP) { u32x4 o; o.x = keep[m].x; o.y = keep[m].y; o.z = pk.x; o.w = pk.y; __builtin_nontemporal_store(o, (u32x4*)(ab + (size_t)(m * 16) * LDF)); } }
            }
        }
        return;
    }
    if (d.epi == EPI_GLU) {
        const int c8 = u.pn * BM + wc * 32 + 8 * fq;
        const bf16_t* yb = (const bf16_t*)(ws + WS_YGELU) + (size_t)rbase * LDG + c8; bf16_t* ob = (bf16_t*)(ws + WS_YGLU) + (size_t)rbase * 1024 + c8;
        const float* bb = PIN(13) + (size_t)l * 1024 + c8;
#pragma unroll
        for (int bj = 0; bj < 2; ++bj) {
            f32x4 bg[2];
#pragma unroll
            for (int n = 0; n < 2; ++n) bg[n] = *(const f32x4*)(bb + bj * HALF + n * 4);
#pragma unroll
            for (int ai = 0; ai < 2; ++ai) {
                u32x4 y[4];
                const bf16_t* yq = yb + (size_t)(ai * HALF) * LDG + bj * HALF; asm volatile("" : "+v"(yq));
#pragma unroll
                for (int m = 0; m < 4; ++m) y[m] = *(const u32x4*)(yq + (size_t)(m * 16) * LDG);
#pragma unroll
                for (int m = 0; m < 4; ++m) { const f32x4 v0 = acc[ai][bj][m][0] + bg[0], v1 = acc[ai][bj][m][1] + bg[1]; const u32x4 yy = y[m]; u32x4 o;
                    o.x = cvt_pk_bf16(bf_lo(yy.x) * sigmoidf_(v0[0]), bf_hi(yy.x) * sigmoidf_(v0[1])); o.y = cvt_pk_bf16(bf_lo(yy.y) * sigmoidf_(v0[2]), bf_hi(yy.y) * sigmoidf_(v0[3]));
                    o.z = cvt_pk_bf16(bf_lo(yy.z) * sigmoidf_(v1[0]), bf_hi(yy.z) * sigmoidf_(v1[1])); o.w = cvt_pk_bf16(bf_lo(yy.w) * sigmoidf_(v1[2]), bf_hi(yy.w) * sigmoidf_(v1[3]));
                    *(u32x4*)(ob + (size_t)(ai * HALF + m * 16) * 1024 + bj * HALF) = o; }
            }
        }
        return;
    }
    if (d.epi == EPI_S5C) {
#pragma unroll
        for (int ai = 0; ai < 2; ++ai)
#pragma unroll
        for (int m = 0; m < 4; ++m) {
            const int r = rbase + ai * HALF + m * 16;
            if (r < S5ROWS) { const int b = r / NCH, nn = r - b * NCH;
#pragma unroll
                for (int bj = 0; bj < 2; ++bj) { const int c8 = bj * HALF + wc * 32 + 8 * fq, tl = c8 >> 4, ch = c8 & 15; const size_t row = (size_t)b * LP + nn * 16 + tl;
                    const f32x4 v0 = acc[ai][bj][m][0], v1 = acc[ai][bj][m][1]; u32x4 o;
                    o.x = cvt_pk_bf16(gelu_tanh(v0[0]), gelu_tanh(v0[1])); o.y = cvt_pk_bf16(gelu_tanh(v0[2]), gelu_tanh(v0[3])); o.z = cvt_pk_bf16(gelu_tanh(v1[0]), gelu_tanh(v1[1])); o.w = cvt_pk_bf16(gelu_tanh(v1[2]), gelu_tanh(v1[3]));
                    *(u32x4*)((bf16_t*)(ws + WS_YGELU) + row * LDG + u.b * 16 + ch) = o; } }
        }
        return;
    }
    if (d.epi == EPI_WIN) {
        const u64* ssb = (const u64*)(ws + WS_SS) + (size_t)d.ssi * MP;
#pragma unroll
        for (int ai = 0; ai < 2; ++ai)
#pragma unroll
        for (int m = 0; m < 4; ++m) {
            const int r = rbase + ai * HALF + m * 16; const float rsc = row_rs(ssb, r);
#pragma unroll
            for (int bj = 0; bj < 2; ++bj) {
                const int c8 = u.pn * BM + bj * HALF + wc * 32 + 8 * fq;
                const f32x4 v0 = acc[ai][bj][m][0] * rsc, v1 = acc[ai][bj][m][1] * rsc;
                if (u.pn < 16) { u32x4 o; o.x = cvt_pk_bf16(v0[0], v0[1]); o.y = cvt_pk_bf16(v0[2], v0[3]); o.z = cvt_pk_bf16(v1[0], v1[1]); o.w = cvt_pk_bf16(v1[2], v1[3]);
                    if (u.pn < 4) { const int g = c8 >> 4, ch = c8 & 15, b = r / LP, pos = r - b * LP, cr = b * NCH + (pos >> 4), tl = pos & 15;
                        *(u32x4*)((bf16_t*)(ws + WS_UA) + ((size_t)g * S5ROWP + cr) * LDU + tl * 16 + ch) = o; }
                    else *(u32x4*)((bf16_t*)(ws + WS_Z) + (size_t)r * 3072 + (c8 - 1024)) = o; }
                else if (c8 - 4096 < 32) { float* gp = (float*)(ws + WS_G) + (size_t)r * 32 + (c8 - 4096); *(f32x4*)gp = v0; *(f32x4*)(gp + 4) = v1; }
            }
        }
        return;
    }
#pragma unroll
    for (int ai = 0; ai < 2; ++ai)
#pragma unroll
    for (int m = 0; m < 4; ++m) {
        const int r = rbase + ai * HALF + m * 16;
        const float rsc = (d.epi == EPI_WIN) ? row_rs((const u64*)(ws + WS_SS) + (size_t)d.ssi * MP, r) : 1.0f;
#pragma unroll
        for (int bj = 0; bj < 2; ++bj)
#pragma unroll
        for (int n = 0; n < 2; ++n) {
            const int c0 = cbase + bj * HALF + n * 16;
            const f32x4 v = acc[ai][bj][m][n] * rsc;
            switch (d.epi) {
            case EPI_WIN: {
                if (u.pn < 4) { const int g = c0 >> 4, ch = c0 & 15, b = r / LP, pos = r - b * LP, cr = b * NCH + (pos >> 4), tl = pos & 15;
                    store_bf4((bf16_t*)(ws + WS_UA) + ((size_t)g * S5ROWP + cr) * LDU + tl * 16 + ch, v); }
                else if (u.pn < 16) store_bf4((bf16_t*)(ws + WS_Z) + (size_t)r * 3072 + (c0 - 1024), v);
                else if (c0 - 4096 < 32) *(f32x4*)((float*)(ws + WS_G) + (size_t)r * 32 + (c0 - 4096)) = v;
            } break;
            case EPI_S5A: *(f32x4*)((float*)(ws + WS_SLOC) + ((size_t)u.b * S5ROWP + r) * 256 + c0) = v; break;
            case EPI_S5C: {
                if (r < S5ROWS) { const int b = r / NCH, nn = r - b * NCH, tl = c0 >> 4, ch = c0 & 15; const size_t row = (size_t)b * LP + nn * 16 + tl;
                    store_bf4((bf16_t*)(ws + WS_YGELU) + row * LDG + u.b * 16 + ch, (f32x4){gelu_tanh(v[0]), gelu_tanh(v[1]), gelu_tanh(v[2]), gelu_tanh(v[3])}); }
            } break;
            default: break;
            }
        }
    }
}

__device__ __forceinline__ void gemm_phase(const Params& P, LAS unsigned char* lds, const GemmDesc d) {
    const int tid = tid_l(), wid = __builtin_amdgcn_readfirstlane(tid >> 6), lane = tid & 63, wr = wid >> 2, wc = wid & 3, fr = lane & 15, fq = lane >> 4;
    const int K = d.K, nt = K / BK; const int G = d.gG, cblk = d.gc;
    unsigned voffA[2], voffB[2];
#pragma unroll
    for (int i = 0; i < 2; ++i) { int R, C; stage_rc(tid * 16 + i * 8192, R, C); const int Ra = (d.amode && R >= 64) ? R - 2 : R; voffA[i] = (unsigned)(Ra * d.lda + C) * 2u; const int Rb = d.perm ? ((R & ~31) + 8 * ((R & 15) >> 2) + 4 * ((R & 31) >> 4) + (R & 3)) : R; voffB[i] = (unsigned)(Rb * d.ldb + C) * 2u; }
    const size_t kstep = (size_t)(BK * 2);
    const size_t hstepA = (size_t)(d.amode ? 124 : HALF) * d.lda * 2, hstepB = (size_t)HALF * d.ldb * 2;
    const unsigned ldsw = (unsigned)wid * 1024u;
    const int aoff = lds_byte(wr * 64 + fr, fq * 8), boff = lds_byte(wc * 32 + fr, fq * 8);
#define PG8_SA(b, h) (((b) * 2 + (h)) * HTB)
#define PG8_SB(b, h) ((4 + (b) * 2 + (h)) * HTB)
#define PG8_STAGE(bufoff, gbase, voff) do { _Pragma("unroll") for (int _i = 0; _i < 2; ++_i) \
        __builtin_amdgcn_global_load_lds((const unsigned*)((const char*)(gbase) + (voff)[_i]), (LAS unsigned*)(lds + (bufoff) + ldsw + _i * 8192), 16, 0, 0); } while (0)
#define PG8_LDA(dst, b, h) do { _Pragma("unroll") for (int m = 0; m < 4; ++m) _Pragma("unroll") for (int k = 0; k < 2; ++k) dst[m][k] = *(const LAS bf16x8*)(lds + PG8_SA(b, h) + aoff + m * 2048 + k * 1024); } while (0)
#define PG8_LDB(dst, b, h) do { _Pragma("unroll") for (int n = 0; n < 2; ++n) _Pragma("unroll") for (int k = 0; k < 2; ++k) dst[n][k] = *(const LAS bf16x8*)(lds + PG8_SB(b, h) + boff + n * 2048 + k * 1024); } while (0)
#define PG8_MMA(ai, bj, At, Bt) do { __builtin_amdgcn_s_setprio(1); _Pragma("unroll") for (int m = 0; m < 4; ++m) _Pragma("unroll") for (int n = 0; n < 2; ++n) _Pragma("unroll") for (int k = 0; k < 2; ++k) \
        acc[ai][bj][m][n] = __builtin_amdgcn_mfma_f32_16x16x32_bf16(Bt[n][k], At[m][k], acc[ai][bj][m][n], 0, 0, 0); __builtin_amdgcn_s_setprio(0); } while (0)
#define PG8_WAIT_V(n) asm volatile("s_waitcnt vmcnt(" #n ")" ::: "memory")
#define PG8_WAIT_L(n) asm volatile("s_waitcnt lgkmcnt(" #n ")" ::: "memory")
#define PG8_BAR __builtin_amdgcn_s_barrier()
#define PG8_SCHED __builtin_amdgcn_sched_barrier(0)
    Unit cur, nxt; int ui = 0;
    if (!next_unit(d, 0, G, cblk, cur)) return;
    f32x4 acc[2][2][4][2];
#pragma unroll
    for (int a = 0; a < 2; ++a)
#pragma unroll
        for (int b = 0; b < 2; ++b)
#pragma unroll
            for (int m = 0; m < 4; ++m)
#pragma unroll
                for (int n = 0; n < 2; ++n) acc[a][b][m][n] = (f32x4){0.f, 0.f, 0.f, 0.f};
    bf16x8 At[4][2], B0[2][2], B1[2][2];
    const char* cA = (const char*)d.A + ((size_t)cur.b * d.sA) * 2 + (size_t)cur.pm * 2 * hstepA + (size_t)cur.k0 * kstep;
    const char* cB = (const char*)d.Bt + ((size_t)cur.b * d.sB) * 2 + (size_t)cur.pn * 2 * hstepB + (size_t)cur.k0 * kstep;
    PG8_STAGE(PG8_SB(0, 0), cB, voffB); PG8_STAGE(PG8_SA(0, 0), cA, voffA); PG8_STAGE(PG8_SB(0, 1), cB + hstepB, voffB); PG8_STAGE(PG8_SA(0, 1), cA + hstepA, voffA);
    if (wr == 1) PG8_BAR;
    PG8_WAIT_V(4); PG8_BAR;
    PG8_STAGE(PG8_SB(1, 0), cB + kstep, voffB); PG8_STAGE(PG8_SA(1, 0), cA + kstep, voffA); PG8_STAGE(PG8_SB(1, 1), cB + hstepB + kstep, voffB);
    PG8_WAIT_V(6); PG8_BAR;
    for (;;) {
        const bool has_next = next_unit(d, ui + 1, G, cblk, nxt);
        const char* nA = has_next ? (const char*)d.A + ((size_t)nxt.b * d.sA) * 2 + (size_t)nxt.pm * 2 * hstepA + (size_t)nxt.k0 * kstep : cA;
        const char* nB = has_next ? (const char*)d.Bt + ((size_t)nxt.b * d.sB) * 2 + (size_t)nxt.pn * 2 * hstepB + (size_t)nxt.k0 * kstep : cB;
        const int ntu = cur.nt;
        for (int t = 0; t < ntu; t += 2) {
            const bool last = (t == ntu - 2);
            const char* a1 = cA + (size_t)(t + 1) * kstep;
            const char* a2 = last ? nA : cA + (size_t)(t + 2) * kstep; const char* b2 = last ? nB : cB + (size_t)(t + 2) * kstep;
            const char* a3 = a2 + kstep; const char* b3 = b2 + kstep;
            PG8_LDB(B0, 0, 0); PG8_SCHED; PG8_LDA(At, 0, 0); PG8_STAGE(PG8_SA(1, 1), a1 + hstepA, voffA);
            PG8_WAIT_L(8); PG8_BAR; PG8_WAIT_L(0); PG8_MMA(0, 0, At, B0); PG8_BAR; PG8_SCHED;
            PG8_LDB(B1, 0, 1); PG8_STAGE(PG8_SB(0, 0), b2, voffB);
            PG8_BAR; PG8_WAIT_L(0); PG8_MMA(0, 1, At, B1); PG8_BAR;
            PG8_LDA(At, 0, 1); PG8_STAGE(PG8_SA(0, 0), a2, voffA);
            PG8_BAR; PG8_WAIT_L(0); PG8_MMA(1, 0, At, B0); PG8_BAR; PG8_SCHED;
            PG8_STAGE(PG8_SB(0, 1), b2 + hstepB, voffB);
            PG8_WAIT_V(6); PG8_BAR; PG8_MMA(1, 1, At, B1); PG8_BAR;
            PG8_LDB(B0, 1, 0); PG8_SCHED; PG8_LDA(At, 1, 0); PG8_STAGE(PG8_SA(0, 1), a2 + hstepA, voffA);
            PG8_WAIT_L(8); PG8_BAR; PG8_WAIT_L(0); PG8_MMA(0, 0, At, B0); PG8_BAR; PG8_SCHED;
            PG8_LDB(B1, 1, 1); PG8_STAGE(PG8_SB(1, 0), b3, voffB);
            PG8_BAR; PG8_WAIT_L(0); PG8_MMA(0, 1, At, B1); PG8_BAR;
            PG8_LDA(At, 1, 1); PG8_STAGE(PG8_SA(1, 0), a3, voffA);
            PG8_BAR; PG8_WAIT_L(0); PG8_MMA(1, 0, At, B0); PG8_BAR; PG8_SCHED;
            PG8_STAGE(PG8_SB(1, 1), b3 + hstepB, voffB);
            PG8_WAIT_V(6); PG8_BAR; PG8_MMA(1, 1, At, B1); PG8_BAR;
        }
        bool do_epi = true;
        if (cur.piece >= 0) {
            LAUNDER_Z();
            const int t3 = tid_l(); const int w3 = __builtin_amdgcn_readfirstlane(t3 >> 6), l3 = t3 & 63;
            const size_t pstride = (size_t)8 * 32 * 64;
            f32x4* slab = (f32x4*)(P.ws + zz + WS_UA) + ((size_t)(cur.tu * d.split) * 8 + w3) * 32 * 64 + l3;
            {   f32x4* mine = slab + (size_t)cur.piece * pstride;
#pragma unroll
                for (int idx = 0; idx < 32; ++idx) { asm volatile("global_store_dwordx4 %0, %1, off sc1\n\ts_nop 1" :: "v"(mine), "v"(acc[idx >> 4][(idx >> 3) & 1][(idx >> 1) & 3][idx & 1]) : "memory"); mine += 64; } }
            asm volatile("s_waitcnt vmcnt(0)" ::: "memory");
            unsigned old = 0u;
            if (l3 == 0) old = __hip_atomic_fetch_add((unsigned*)(P.ws + zz) + 8192 + cur.tu * 8 + w3, 1u, __ATOMIC_RELAXED, __HIP_MEMORY_SCOPE_AGENT);
            old = (unsigned)__builtin_amdgcn_readfirstlane((int)old);
            do_epi = ((old % (unsigned)d.split) == (unsigned)d.split - 1u);
            if (do_epi) {
                __builtin_amdgcn_fence(__ATOMIC_ACQUIRE, "agent");
                asm volatile("s_waitcnt vmcnt(0)" ::: "memory");
                const f32x4* p = slab;
#pragma unroll
                for (int i4 = 0; i4 < 8; ++i4) { f32x4 t4[4][4];
#pragma unroll
                    for (int j = 0; j < 4; ++j) { asm volatile("" : "+v"(p));
#pragma unroll
                        for (int q = 0; q < 4; ++q) t4[j][q] = p[(size_t)q * pstride];
                        p += 64; }
#pragma unroll
                    for (int j = 0; j < 4; ++j) { const int idx = i4 * 4 + j; acc[idx >> 4][(idx >> 3) & 1][(idx >> 1) & 3][idx & 1] = ((t4[j][0] + t4[j][1]) + t4[j][2]) + t4[j][3]; } }
            }
        }
        if (do_epi) gemm_epilogue(P, d, acc, cur, wr, wc, fr, fq);
        if (!has_next) break;
#pragma unroll
        for (int a = 0; a < 2; ++a)
#pragma unroll
            for (int b = 0; b < 2; ++b)
#pragma unroll
                for (int m = 0; m < 4; ++m)
#pragma unroll
                    for (int n = 0; n < 2; ++n) acc[a][b][m][n] = (f32x4){0.f, 0.f, 0.f, 0.f};
        cur = nxt; cA = nA; cB = nB; ++ui;
    }
    PG8_WAIT_V(0);
    if (wr == 0) PG8_BAR;
    PG8_BAR;
#undef PG8_SA
#undef PG8_SB
#undef PG8_STAGE
#undef PG8_LDA
#undef PG8_LDB
#undef PG8_MMA
#undef PG8_WAIT_V
#undef PG8_WAIT_L
#undef PG8_BAR
#undef PG8_SCHED
}

__device__ __forceinline__ void transpose_item(const float* W, int K, int N, bf16_t* WT, int ldw, LAS float* scr, int item, int lane, const float* gsc, int rowmap = 0) {
    const int nblk = N / 32, kb = item / nblk, nb = item % nblk, k0 = 64 * kb, n0 = 32 * nb;
    float wv[32];
#pragma unroll
    for (int i = 0; i < 32; ++i) { const int kk = 2 * i + (lane >> 5); wv[i] = W[(size_t)(k0 + kk) * N + n0 + (lane & 31)]; }
#pragma unroll
    for (int i = 0; i < 32; ++i) { const int kk = 2 * i + (lane >> 5); const float gg = gsc ? gsc[k0 + kk] : 1.0f; scr[kk * 33 + (lane & 31)] = wv[i] * gg; }
    asm volatile("s_waitcnt lgkmcnt(0)" ::: "memory");
    const int c = lane & 7;
#pragma unroll
    for (int j = 0; j < 4; ++j) { const int n = (lane >> 3) + 8 * j; const LAS float* s = scr + (8 * c) * 33 + n;
        u32x4 o; o.x = cvt_pk_bf16(s[0 * 33], s[1 * 33]); o.y = cvt_pk_bf16(s[2 * 33], s[3 * 33]); o.z = cvt_pk_bf16(s[4 * 33], s[5 * 33]); o.w = cvt_pk_bf16(s[6 * 33], s[7 * 33]);
        const int nr = n0 + n; const int dr = rowmap ? ((nr >> 7) * 256 + (nr & 127) + (rowmap == 2 ? 128 : 0)) : nr;
        *(u32x4*)(WT + (size_t)dr * ldw + k0 + 8 * c) = o; }
    asm volatile("s_waitcnt lgkmcnt(0)" ::: "memory");
}

__device__ __forceinline__ void norm_row_bf16(const float* hrow, const float* g, bf16_t* orow, int lane, bool pad) {
    u32x2* o8 = (u32x2*)orow + lane;
    if (pad) {
#pragma unroll
        for (int j = 0; j < 8; ++j) o8[64 * j] = (u32x2){0u, 0u};
        return; }
    const f32x4* xr = (const f32x4*)hrow + lane; const f32x4* gr = (const f32x4*)g + lane;
    f32x4 v[8]; float s = 0.f;
#pragma unroll
    for (int j = 0; j < 8; ++j) { v[j] = xr[64 * j]; s += (v[j][0] * v[j][0] + v[j][1] * v[j][1]) + (v[j][2] * v[j][2] + v[j][3] * v[j][3]); }
    const float rs = __builtin_amdgcn_rsqf(wave_sum(s, lane) * (1.0f / DM) + EPSN);
#pragma unroll
    for (int j = 0; j < 8; ++j) { const f32x4 gg = gr[64 * j]; u32x2 w; w.x = cvt_pk_bf16(v[j][0] * rs * gg[0], v[j][1] * rs * gg[1]); w.y = cvt_pk_bf16(v[j][2] * rs * gg[2], v[j][3] * rs * gg[3]); o8[64 * j] = w; }
}

__device__ __forceinline__ void zero_rows16(void* p, int n16, int gt, int NGT) { unsigned z0 = 0u; asm volatile("" : "+v"(z0)); u32x4* z = (u32x4*)p; for (int i = gt; i < n16; i += NGT) z[i] = (u32x4){z0, z0, z0, z0}; }
__device__ __forceinline__ void phase_init_rows(const Params& P) {
    LAUNDER_Z();
    const int lane = tid_l() & 63, gw = bid_l() * 8 + (tid_l() >> 6), NGW = gridDim.x * 8;
    float* H = (float*)(P.ws + zz + WS_H); bf16_t* HN = (bf16_t*)(P.ws + zz + WS_HN); u64* SS = (u64*)(P.ws + zz + WS_SS);
    float zf = 0.f; asm volatile("" : "+v"(zf));
    for (int r = gw; r < MP; r += NGW) {
        const int b = r / LP, pos = r - b * LP; f32x4* o = (f32x4*)(H + (size_t)r * DM) + lane; u32x2* o8 = (u32x2*)(HN + (size_t)r * LDH) + lane;
        if (pos < PADF) {
#pragma unroll
            for (int j = 0; j < 8; ++j) { o[64 * j] = (f32x4){zf, zf, zf, zf}; o8[64 * j] = (u32x2){__float_as_uint(zf), __float_as_uint(zf)}; }
            if (lane == 0) SS[r] = (u64)__float_as_uint(zf);
        } else {
            const float* src = pos < 64 ? PIN(1) + (size_t)(pos - PADF) * DM : PIN(0) + ((size_t)b * 2048 + (pos - 64)) * DM;
            const f32x4* s4 = (const f32x4*)src + lane; float sq = 0.f;
#pragma unroll
            for (int j = 0; j < 8; ++j) { const f32x4 v = s4[64 * j]; o[64 * j] = v; u32x2 w; w.x = cvt_pk_bf16(v[0], v[1]); w.y = cvt_pk_bf16(v[2], v[3]); o8[64 * j] = w; sq += (v[0] * v[0] + v[1] * v[1]) + (v[2] * v[2] + v[3] * v[3]); }
            sq = wave_sum(sq, lane); if (lane == 0) SS[r] = (u64)(sq * SSCALE);
        }
    }
    const int gt = bid_l() * 512 + tid_l(), NGT = gridDim.x * 512;
    for (int i = gt; i < 8 * MP; i += NGT) SS[MP + i] = (u64)__float_as_uint(zf);
    zero_rows16((bf16_t*)(P.ws + zz + WS_HN) - LDH, LDH / 8, gt, NGT); zero_rows16((bf16_t*)(P.ws + zz + WS_HN) + (size_t)MP * LDH, 256 * LDH / 8, gt, NGT);
    zero_rows16((bf16_t*)(P.ws + zz + WS_WSET + WO_WIN) + (size_t)DIN * LDH, (DINP - DIN) * LDH / 8, gt, NGT);
    zero_rows16((bf16_t*)((unsigned char*)P.out + zz + WO_WIN) + (size_t)DIN * LDH, (DINP - DIN) * LDH / 8, gt, NGT);
}

__device__ __forceinline__ void s5_precompute(const Params& P, LAS unsigned char* lds, int l, int g) {
    LAS float* lpr = (LAS float*)lds;
    LAS float* lpi = lpr + 2 * 17 * 64;
    LAS float* bbr = lpi + 2 * 17 * 64;
    LAS float* bbi = bbr + 2048;
    LAS float* ccr = bbi + 2048;
    LAS float* cci = ccr + 2048;
    LAS float* zr = cci + 2048;
    LAS float* zi = zr + 128;
    LAS float* kd = zi + 128;
    LAUNDER_Z();
    const int tid = tid_l();
    if (tid < 128) {
        const int dir = tid >> 6, p = tid & 63; const size_t o = ((size_t)(l * 2 + dir) * 64 + g) * 64 + p;
        const float are = fminf(PIN(4)[o], -1e-4f), aim = PIN(5)[o], dt = expf(PIN(6)[(size_t)(l * 2 + dir) * 64 + g]);
        const float mag = expf(are * dt); float sn, cs; sincosf(aim * dt, &sn, &cs); const float lr = mag * cs, li = mag * sn;
        { float pr = 1.0f, pi = 0.0f;
          for (int dd = 0; dd <= 16; ++dd) { lpr[(dir * 17 + dd) * 64 + p] = pr; lpi[(dir * 17 + dd) * 64 + p] = pi; const float nr = pr * lr - pi * li, ni = pr * li + pi * lr; pr = nr; pi = ni; } }
        const float den = are * are + aim * aim, pp = lr - 1.0f;
        zr[dir * 64 + p] = (pp * are + li * aim) / den; zi[dir * 64 + p] = (li * are - pp * aim) / den;
    }
    __syncthreads();
    for (int e = tid; e < 2048; e += 512) { const int dir = e >> 10, p = (e >> 4) & 63, h = e & 15; const size_t o = (((size_t)(l * 2 + dir) * 64 + g) * 64 + p) * 16 + h;
        const float br = PIN(7)[o], bi = PIN(8)[o], z_r = zr[dir * 64 + p], z_i = zi[dir * 64 + p];
        bbr[e] = z_r * br - z_i * bi; bbi[e] = z_r * bi + z_i * br; }
    for (int e = tid; e < 2048; e += 512) { const int dir = e >> 10, h = (e >> 6) & 15, p = e & 63; const size_t o = (((size_t)(l * 2 + dir) * 64 + g) * 16 + h) * 64 + p;
        ccr[e] = PIN(9)[o]; cci[e] = PIN(10)[o]; }
    __syncthreads();
    for (int e = tid; e < 8192; e += 512) { const int dir = e >> 12, dd = (e >> 8) & 15, h = (e >> 4) & 15, h2 = e & 15; float s = 0.f;
        for (int p = 0; p < 64; ++p) { const float cr = ccr[(dir * 16 + h) * 64 + p], ci = cci[(dir * 16 + h) * 64 + p], lr = lpr[(dir * 17 + dd) * 64 + p], li = lpi[(dir * 17 + dd) * 64 + p];
            const float ur = cr * lr - ci * li, ui = cr * li + ci * lr; s += ur * bbr[(dir * 64 + p) * 16 + h2] - ui * bbi[(dir * 64 + p) * 16 + h2]; }
        kd[e] = s; }
    __syncthreads();
    bf16_t* WST = (bf16_t*)(P.ws + zz + WS_WST) + ((size_t)l * 64 + g) * (256 * LDWS);
    for (int e8 = tid; e8 < 8192; e8 += 512) { const int n = e8 >> 5, k0 = (e8 & 31) * 8; const int part = n >> 6, p = n & 63, dir = part >> 1; float v[8];
#pragma unroll
        for (int j = 0; j < 8; ++j) { const int k = k0 + j, s = k >> 4, h2 = k & 15, pw = dir == 0 ? 15 - s : s; const float lr = lpr[(dir * 17 + pw) * 64 + p], li = lpi[(dir * 17 + pw) * 64 + p], br = bbr[(dir * 64 + p) * 16 + h2], bi = bbi[(dir * 64 + p) * 16 + h2];
            v[j] = (part & 1) ? (lr * bi + li * br) : (lr * br - li * bi); }
        u32x4 o; o.x = cvt_pk_bf16(v[0], v[1]); o.y = cvt_pk_bf16(v[2], v[3]); o.z = cvt_pk_bf16(v[4], v[5]); o.w = cvt_pk_bf16(v[6], v[7]);
        *(u32x4*)(WST + (size_t)n * LDWS + k0) = o; }
    bf16_t* TO = (bf16_t*)(P.ws + zz + WS_TO) + ((size_t)l * 64 + g) * (256 * LDTO);
    const float* dsk = PIN(11) + ((size_t)l * 64 + g) * 16;
    for (int e8 = tid; e8 < 16384; e8 += 512) { const int n = e8 >> 6, k0 = (e8 & 63) * 8; const int t = n >> 4, h = n & 15; float v[8];
#pragma unroll
        for (int j = 0; j < 8; ++j) { const int k = k0 + j;
            if (k < 256) { const int s = k >> 4, h2 = k & 15;
                if (t > s) v[j] = kd[((0 * 16 + (t - s)) * 16 + h) * 16 + h2];
                else if (t < s) v[j] = kd[((1 * 16 + (s - t)) * 16 + h) * 16 + h2];
                else v[j] = kd[((0 * 16 + 0) * 16 + h) * 16 + h2] + kd[((1 * 16 + 0) * 16 + h) * 16 + h2] + (h == h2 ? dsk[h] : 0.f);
            } else { const int kk = k - 256, part = kk >> 6, p = kk & 63, dir = part >> 1, pw = dir == 0 ? t + 1 : 16 - t;
                const float cr = ccr[(dir * 16 + h) * 64 + p], ci = cci[(dir * 16 + h) * 64 + p], lr = lpr[(dir * 17 + pw) * 64 + p], li = lpi[(dir * 17 + pw) * 64 + p];
                v[j] = (part & 1) ? -(cr * li + ci * lr) : (cr * lr - ci * li); } }
        u32x4 o; o.x = cvt_pk_bf16(v[0], v[1]); o.y = cvt_pk_bf16(v[2], v[3]); o.z = cvt_pk_bf16(v[4], v[5]); o.w = cvt_pk_bf16(v[6], v[7]);
        *(u32x4*)(TO + (size_t)n * LDTO + k0) = o; }
    __syncthreads();
}

__device__ __forceinline__ unsigned char* wset_base(const Params& P, int l, int zz) { return (l & 1) ? (unsigned char*)P.out + zz : P.ws + zz + WS_WSET; }
__device__ __forceinline__ void convert_weights(const Params& P, LAS unsigned char* lds, int l, int gw, int NGW, int wave, int lane, int it_lo = 0, int it_hi = 1 << 30) {
    LAUNDER_Z();
    unsigned char* wb = wset_base(P, l, zz);
    LAS float* scr = (LAS float*)(lds + wave * 16384);
    constexpr int I_IN = 32 * 129, I_GLU = 16 * 32, I_OUT = 32 * 64, I_G = 32 * 176, I_DN = 88 * 64, NIT = I_IN + I_GLU + I_OUT + 2 * I_G + I_DN;
    const int ihi = it_hi < NIT ? it_hi : NIT;
    for (int it = it_lo + gw; it < ihi; it += NGW) { int r = it;
        if (r < I_IN) { transpose_item(PIN(3) + (size_t)l * DM * DIN, DM, DIN, (bf16_t*)(wb + WO_WIN), LDH, scr, r, lane, PIN(2) + (size_t)l * DM); continue; } r -= I_IN;
        if (r < I_GLU) { transpose_item(PIN(12) + (size_t)l * 1024 * 1024, 1024, 1024, (bf16_t*)(wb + WO_WGLU), LDG, scr, r, lane, nullptr); continue; } r -= I_GLU;
        if (r < I_OUT) { transpose_item(PIN(19) + (size_t)l * DM * DM, DM, DM, (bf16_t*)(wb + WO_WOUT), LDH, scr, r, lane, nullptr); continue; } r -= I_OUT;
        if (r < I_G) { transpose_item(PIN(21) + (size_t)l * DM * DFF, DM, DFF, (bf16_t*)(wb + WO_WGU), LDH, scr, r, lane, PIN(20) + (size_t)l * DM, 1); continue; } r -= I_G;
        if (r < I_G) { transpose_item(PIN(22) + (size_t)l * DM * DFF, DM, DFF, (bf16_t*)(wb + WO_WGU), LDH, scr, r, lane, PIN(20) + (size_t)l * DM, 2); continue; } r -= I_G;
        transpose_item(PIN(25) + (size_t)l * DFF * DM, DFF, DM, (bf16_t*)(wb + WO_WDN), LDF, scr, r, lane, nullptr);
    }
}

__device__ __forceinline__ void phase_s5_scan(const Params& P, int l, int bofs) {
    LAUNDER_Z();
    const int t = tid_l(); if (t >= 128) return;
    const int idx = (bid_l() - bofs) * 128 + t; if (idx >= 16384 || idx < 0) return;
    const int p4 = idx & 15, dir = (idx >> 4) & 1, b = (idx >> 5) & 7, g = idx >> 8;
    const size_t o = ((size_t)(l * 2 + dir) * 64 + g) * 64 + 4 * p4;
    const float dt = expf(PIN(6)[(size_t)(l * 2 + dir) * 64 + g]);
    f32x4 Lr, Li;
#pragma unroll
    for (int j = 0; j < 4; ++j) { const float are = fminf(PIN(4)[o + j], -1e-4f), aim = PIN(5)[o + j]; const float mag = expf(are * dt * 16.0f); float sn, cs; sincosf(aim * dt * 16.0f, &sn, &cs); Lr[j] = mag * cs; Li[j] = mag * sn; }
    const f32x4* sl = (const f32x4*)((const float*)(P.ws + zz + WS_SLOC) + ((size_t)g * S5ROWP + b * NCH) * 256 + dir * 128 + 4 * p4);
    bf16_t* so = (bf16_t*)(P.ws + zz + WS_UA) + ((size_t)g * S5ROWP + b * NCH) * LDU + 256 + dir * 128 + 4 * p4;
    f32x4 sr = (f32x4){0.f, 0.f, 0.f, 0.f}, si = (f32x4){0.f, 0.f, 0.f, 0.f};
    for (int blk = 0; blk < 11; ++blk) {
        f32x4 xr[12], xi[12];
#pragma unroll
        for (int j = 0; j < 12; ++j) { const int i = blk * 12 + j, n = dir == 0 ? i : NCH - 1 - i; xr[j] = sl[(size_t)n * 64]; xi[j] = sl[(size_t)n * 64 + 16]; }
#pragma unroll
        for (int j = 0; j < 12; ++j) { const int i = blk * 12 + j, n = dir == 0 ? i : NCH - 1 - i;
            u32x2 wr_, wi_; wr_.x = cvt_pk_bf16(sr[0], sr[1]); wr_.y = cvt_pk_bf16(sr[2], sr[3]); wi_.x = cvt_pk_bf16(si[0], si[1]); wi_.y = cvt_pk_bf16(si[2], si[3]);
            *(u32x2*)(so + (size_t)n * LDU) = wr_; *(u32x2*)(so + (size_t)n * LDU + 64) = wi_;
            const f32x4 nr = Lr * sr - Li * si + xr[j], ni = Lr * si + Li * sr + xi[j]; sr = nr; si = ni; }
    }
}

constexpr int MLS = 72;
__device__ __forceinline__ f32x4 mma_tile(const LAS bf16_t* A, const LAS bf16_t* Bt, int fr, int fq, f32x4 acc) {
#pragma unroll
    for (int kk = 0; kk < 2; ++kk) { const bf16x8 a = *(const LAS bf16x8*)(A + fr * MLS + kk * 32 + fq * 8); const bf16x8 b = *(const LAS bf16x8*)(Bt + fr * MLS + kk * 32 + fq * 8);
        acc = __builtin_amdgcn_mfma_f32_16x16x32_bf16(a, b, acc, 0, 0, 0); }
    return acc;
}
__device__ __forceinline__ void phase_mlstm(const Params& P, LAS unsigned char* lds, int l) {
    LAUNDER_Z();
    const int tid = tid_l(), lane = tid & 63, w = tid >> 6, fr = lane & 15, fq = lane >> 4; unsigned char* ws = P.ws + zz;
    LAS bf16_t* Qs = (LAS bf16_t*)lds;
    LAS bf16_t* Ks = Qs + 64 * MLS;
    LAS bf16_t* Kw = Ks + 64 * MLS;
    LAS bf16_t* Ss = Kw + 64 * MLS;
    LAS bf16_t* Vt = Ss + 64 * MLS;
    LAS bf16_t* Ct = Vt + 160 * MLS;
    LAS float* den = (LAS float*)(Ct + 160 * MLS);
    LAS float* CW = den + 64;
    const bf16_t* Z = (const bf16_t*)(ws + WS_Z); const float* Gt = (const float*)(ws + WS_G);
    const int nmb = gridDim.x >= 256 ? 128 : gridDim.x;
    if (bid_l() >= nmb) return;
    for (int item = bid_l(); item < 128; item += nmb) {
        const int dir = item & 1, hd = (item >> 1) & 7, b = item >> 4;
        __syncthreads();
        for (int e = tid; e < 160 * MLS; e += 512) Ct[e] = 0;
        for (int e = tid; e < 32 * MLS; e += 512) Vt[128 * MLS + e] = (e < 64) ? (bf16_t)0x3F80 : (bf16_t)0;
        f32x4 Cst[5];
#pragma unroll
        for (int j = 0; j < 5; ++j) Cst[j] = (f32x4){0.f, 0.f, 0.f, 0.f};
        float m_prev = -1e30f;
        const float gb_i = PIN(17)[l * 32 + (2 * dir) * 8 + hd], gb_f = PIN(17)[l * 32 + (2 * dir + 1) * 8 + hd];
        bf16_t* Hout = (bf16_t*)(ws + WS_HFB) + (size_t)dir * MP * 1024;
        for (int e = tid; e < 512; e += 512) { const int rr = e >> 7, c = e & 127; const int colz = (c < 64 ? hd * 64 + c : 512 + hd * 64 + (c - 64));
            CW[e] = rr < 3 ? PIN(15)[(size_t)l * 3 * 1024 + rr * 1024 + colz] : PIN(16)[(size_t)l * 1024 + colz]; }
        const int wu = __builtin_amdgcn_readfirstlane(w);
        const int colz = (wu < 4 ? hd * 64 + wu * 16 : 512 + hd * 64 + (wu - 4) * 16);
        const int myoff = dir == 0 ? lane : 63 - lane;
        const int gcol_i = (2 * dir) * 8 + hd, gcol_f = (2 * dir + 1) * 8 + hd;
        u32x4 pz[8]; float pg_i, pg_f;
#define ML_PREFETCH(cx) do { const int n_ = dir == 0 ? (cx) : 32 - (cx); const size_t r_ = (size_t)(b * LP + n_ * 64 + myoff); \
            const bf16_t* zp_ = Z + r_ * 3072 + colz; const bf16_t* vp_ = Z + r_ * 3072 + 1024 + hd * 128 + wu * 16; \
            pz[0] = *(const u32x4*)(zp_ - 3072); pz[1] = *(const u32x4*)(zp_ - 3072 + 8); pz[2] = *(const u32x4*)(zp_); pz[3] = *(const u32x4*)(zp_ + 8); \
            pz[4] = *(const u32x4*)(zp_ + 3072); pz[5] = *(const u32x4*)(zp_ + 3072 + 8); pz[6] = *(const u32x4*)(vp_); pz[7] = *(const u32x4*)(vp_ + 8); \
            pg_i = Gt[r_ * 32 + gcol_i]; pg_f = Gt[r_ * 32 + gcol_f]; } while (0)
        ML_PREFETCH(0);
        __syncthreads();
        for (int cix = 0; cix < 33; ++cix) {
            const int n = dir == 0 ? cix : 32 - cix;
            const int rowbase = b * LP + n * 64;
            u32x4 cz[8];
#pragma unroll
            for (int j = 0; j < 8; ++j) cz[j] = pz[j];
            const float cg_i = pg_i, cg_f = pg_f;
            if (cix + 1 < 33) ML_PREFETCH(cix + 1);
            const bool mypad = (n * 64 + myoff) < PADF;
            float li = cg_i + gb_i;
            const float xf = cg_f + gb_f;
            float lf = fminf(xf, 0.f) - __logf(1.0f + __expf(-fabsf(xf)));
            if (mypad) { li = -1e30f; lf = 0.f; }
            const float bc = wave_incl_sum(lf, lane);
            const float gsum = rdlane(bc, 63);
            const float m_loc = rdlane(wave_incl_max(gsum - bc + li, lane), 63);
            const float wloc = __expf(gsum - bc + li - m_loc);
            const float cv = li - bc;
            const float pm = wave_incl_max(cv, lane);
            const float Mt = fmaxf(m_prev, pm);
            const float sint = __expf(m_prev - Mt);
            const float einv = __expf(-(bc + Mt));
            const float m_new = fmaxf(gsum + m_prev, m_loc);
            const float s_old = __expf(gsum + m_prev - m_new), s_loc = __expf(m_loc - m_new);
            {
                const int i = lane; const bool pad = mypad;
                const unsigned um[8] = {cz[0].x, cz[0].y, cz[0].z, cz[0].w, cz[1].x, cz[1].y, cz[1].z, cz[1].w};
                const unsigned u0[8] = {cz[2].x, cz[2].y, cz[2].z, cz[2].w, cz[3].x, cz[3].y, cz[3].z, cz[3].w};
                const unsigned up[8] = {cz[4].x, cz[4].y, cz[4].z, cz[4].w, cz[5].x, cz[5].y, cz[5].z, cz[5].w};
                float qv[16];
#pragma unroll
                for (int j4 = 0; j4 < 4; ++j4) {
                    const f32x4 w0 = *(const LAS f32x4*)(CW + 0 * 128 + wu * 16 + j4 * 4), w1 = *(const LAS f32x4*)(CW + 1 * 128 + wu * 16 + j4 * 4), w2 = *(const LAS f32x4*)(CW + 2 * 128 + wu * 16 + j4 * 4), bb = *(const LAS f32x4*)(CW + 3 * 128 + wu * 16 + j4 * 4);
#pragma unroll
                    for (int jj = 0; jj < 2; ++jj) { const int j = j4 * 2 + jj;
                        const float x0 = bb[2 * jj] + w0[2 * jj] * bf_lo(um[j]) + w1[2 * jj] * bf_lo(u0[j]) + w2[2 * jj] * bf_lo(up[j]);
                        const float x1 = bb[2 * jj + 1] + w0[2 * jj + 1] * bf_hi(um[j]) + w1[2 * jj + 1] * bf_hi(u0[j]) + w2[2 * jj + 1] * bf_hi(up[j]);
                        qv[2 * j] = pad ? 0.f : siluf_(x0); qv[2 * j + 1] = pad ? 0.f : siluf_(x1); } }
                if (wu < 4) {
                    u32x4 o0, o1; o0.x = cvt_pk_bf16(qv[0] * 0.125f, qv[1] * 0.125f); o0.y = cvt_pk_bf16(qv[2] * 0.125f, qv[3] * 0.125f); o0.z = cvt_pk_bf16(qv[4] * 0.125f, qv[5] * 0.125f); o0.w = cvt_pk_bf16(qv[6] * 0.125f, qv[7] * 0.125f);
                    o1.x = cvt_pk_bf16(qv[8] * 0.125f, qv[9] * 0.125f); o1.y = cvt_pk_bf16(qv[10] * 0.125f, qv[11] * 0.125f); o1.z = cvt_pk_bf16(qv[12] * 0.125f, qv[13] * 0.125f); o1.w = cvt_pk_bf16(qv[14] * 0.125f, qv[15] * 0.125f);
                    *(LAS u32x4*)(Qs + i * MLS + wu * 16) = o0; *(LAS u32x4*)(Qs + i * MLS + wu * 16 + 8) = o1;
                } else {
                    const int d0 = (wu - 4) * 16;
                    u32x4 o0, o1; o0.x = cvt_pk_bf16(qv[0], qv[1]); o0.y = cvt_pk_bf16(qv[2], qv[3]); o0.z = cvt_pk_bf16(qv[4], qv[5]); o0.w = cvt_pk_bf16(qv[6], qv[7]);
                    o1.x = cvt_pk_bf16(qv[8], qv[9]); o1.y = cvt_pk_bf16(qv[10], qv[11]); o1.z = cvt_pk_bf16(qv[12], qv[13]); o1.w = cvt_pk_bf16(qv[14], qv[15]);
                    *(LAS u32x4*)(Ks + i * MLS + d0) = o0; *(LAS u32x4*)(Ks + i * MLS + d0 + 8) = o1;
#pragma unroll
                    for (int j = 0; j < 16; ++j) Kw[(d0 + j) * MLS + i] = f2bf(qv[j] * wloc);
                }
                const unsigned uv[8] = {cz[6].x, cz[6].y, cz[6].z, cz[6].w, cz[7].x, cz[7].y, cz[7].z, cz[7].w};
#pragma unroll
                for (int j = 0; j < 8; ++j) { Vt[(wu * 16 + 2 * j) * MLS + i] = pad ? (bf16_t)0 : (bf16_t)(uv[j] & 0xffffu); Vt[(wu * 16 + 2 * j + 1) * MLS + i] = pad ? (bf16_t)0 : (bf16_t)(uv[j] >> 16); }
            }
            __syncthreads();
            {
                const int st = w & 3;
#pragma unroll
                for (int jj = 0; jj < 2; ++jj) { const int tt = (w >> 2) * 2 + jj;
                    f32x4 a = (f32x4){0.f, 0.f, 0.f, 0.f};
                    a = mma_tile(Ks + st * 16 * MLS, Qs + tt * 16 * MLS, fr, fq, a);
                    const int t = tt * 16 + fr, s0 = st * 16 + 4 * fq; const float Mtt = shi(Mt, t);
                    f32x4 o;
#pragma unroll
                    for (int j = 0; j < 4; ++j) { const float cs = shi(cv, s0 + j); o[j] = (s0 + j <= t) ? a[j] * __expf(cs - Mtt) : 0.f; }
                    u32x2 pk; pk.x = cvt_pk_bf16(o[0], o[1]); pk.y = cvt_pk_bf16(o[2], o[3]);
                    *(LAS u32x2*)(Ss + t * MLS + s0) = pk; }
            }
            __syncthreads();
            f32x4 num[5];
            const int tt = w & 3, tC = tt * 16 + fr; const float sint_t = shi(sint, tC), einv_t = shi(einv, tC);
#pragma unroll
            for (int j = 0; j < 5; ++j) { const int dvt = (w >> 2) * 5 + j;
                f32x4 a1 = (f32x4){0.f, 0.f, 0.f, 0.f}, a2 = (f32x4){0.f, 0.f, 0.f, 0.f};
                a1 = mma_tile(Vt + dvt * 16 * MLS, Ss + tt * 16 * MLS, fr, fq, a1);
                a2 = mma_tile(Ct + dvt * 16 * MLS, Qs + tt * 16 * MLS, fr, fq, a2);
                num[j] = a1 + a2 * sint_t;
                if (dvt == 8 && fq == 0) den[tC] = num[j][0]; }
            __syncthreads();
            {
                const float dn = den[tC]; const float inv = __builtin_amdgcn_rcpf(fmaxf(fabsf(dn), einv_t));
                const int off = dir == 0 ? tC : 63 - tC; const size_t r = (size_t)rowbase + off;
#pragma unroll
                for (int j = 0; j < 5; ++j) { const int dvt = (w >> 2) * 5 + j;
                    if (dvt < 8) store_bf4(Hout + r * 1024 + hd * 128 + dvt * 16 + 4 * fq, num[j] * inv); }
            }
            {
                const int dkt = w & 3;
#pragma unroll
                for (int j = 0; j < 5; ++j) { const int dvt = (w >> 2) * 5 + j;
                    f32x4 a = (f32x4){0.f, 0.f, 0.f, 0.f};
                    a = mma_tile(Kw + dkt * 16 * MLS, Vt + dvt * 16 * MLS, fr, fq, a);
                    Cst[j] = Cst[j] * s_old + a * s_loc;
                    u32x2 pk; pk.x = cvt_pk_bf16(Cst[j][0], Cst[j][1]); pk.y = cvt_pk_bf16(Cst[j][2], Cst[j][3]);
                    *(LAS u32x2*)(Ct + (dvt * 16 + fr) * MLS + dkt * 16 + 4 * fq) = pk; }
            }
            m_prev = m_new;
            __syncthreads();
        }
    }
}

__device__ __forceinline__ void phase_finalize(const Params& P, int l) {
    LAUNDER_Z();
    const int tid = tid_l(), lane = tid & 63, gw = bid_l() * 8 + (tid >> 6), NGW = gridDim.x * 8; unsigned char* ws = P.ws + zz;
    const bf16_t* YG = (const bf16_t*)(ws + WS_YGLU); const bf16_t* HF = (const bf16_t*)(ws + WS_HFB); const bf16_t* HB = HF + (size_t)MP * 1024;
    const bf16_t* Z = (const bf16_t*)(ws + WS_Z); bf16_t* Y = (bf16_t*)(ws + WS_Y);
    float g1[16], g2[16];
    { const f32x4* p1 = (const f32x4*)(PIN(14) + (size_t)l * 1024 + lane * 16); const f32x4* p2 = (const f32x4*)(PIN(18) + (size_t)l * 1024 + lane * 16);
#pragma unroll
      for (int j = 0; j < 4; ++j) { const f32x4 a = p1[j], b = p2[j]; g1[4 * j] = a[0]; g1[4 * j + 1] = a[1]; g1[4 * j + 2] = a[2]; g1[4 * j + 3] = a[3]; g2[4 * j] = b[0]; g2[4 * j + 1] = b[1]; g2[4 * j + 2] = b[2]; g2[4 * j + 3] = b[3]; } }
    for (int r = gw; r < MP; r += NGW) {
        u32x4* yo = (u32x4*)(Y + (size_t)r * LDH);
        if ((r % LP) < PADF) { unsigned z0 = 0u; asm volatile("" : "+v"(z0)); for (int j = 0; j < 4; ++j) yo[lane + 64 * j] = (u32x4){z0, z0, z0, z0}; continue; }
        const size_t o = (size_t)r * 1024 + lane * 16;
        const u32x4 f0 = *(const u32x4*)(HF + o), f1 = *(const u32x4*)(HF + o + 8), b0 = *(const u32x4*)(HB + o), b1 = *(const u32x4*)(HB + o + 8);
        const u32x4 q0 = *(const u32x4*)(Z + (size_t)r * 3072 + 2048 + lane * 16), q1 = *(const u32x4*)(Z + (size_t)r * 3072 + 2048 + lane * 16 + 8);
        {
            const u32x4 a0 = *(const u32x4*)(YG + (size_t)r * 1024 + lane * 16), a1 = *(const u32x4*)(YG + (size_t)r * 1024 + lane * 16 + 8);
            const unsigned uu[8] = {a0.x, a0.y, a0.z, a0.w, a1.x, a1.y, a1.z, a1.w}; float v[16]; float s = 0.f;
#pragma unroll
            for (int j = 0; j < 8; ++j) { v[2 * j] = bf_lo(uu[j]); v[2 * j + 1] = bf_hi(uu[j]); s += v[2 * j] * v[2 * j] + v[2 * j + 1] * v[2 * j + 1]; }
            const float rs = __builtin_amdgcn_rsqf(wave_sum(s, lane) * (1.0f / 1024.0f) + EPSN);
            const float* g = g1;
            u32x4 o0, o1; o0.x = cvt_pk_bf16(v[0] * rs * g[0], v[1] * rs * g[1]); o0.y = cvt_pk_bf16(v[2] * rs * g[2], v[3] * rs * g[3]); o0.z = cvt_pk_bf16(v[4] * rs * g[4], v[5] * rs * g[5]); o0.w = cvt_pk_bf16(v[6] * rs * g[6], v[7] * rs * g[7]);
            o1.x = cvt_pk_bf16(v[8] * rs * g[8], v[9] * rs * g[9]); o1.y = cvt_pk_bf16(v[10] * rs * g[10], v[11] * rs * g[11]); o1.z = cvt_pk_bf16(v[12] * rs * g[12], v[13] * rs * g[13]); o1.w = cvt_pk_bf16(v[14] * rs * g[14], v[15] * rs * g[15]);
            yo[lane * 2] = o0; yo[lane * 2 + 1] = o1;
        }
        {
            const unsigned uf[8] = {f0.x, f0.y, f0.z, f0.w, f1.x, f1.y, f1.z, f1.w}, ub[8] = {b0.x, b0.y, b0.z, b0.w, b1.x, b1.y, b1.z, b1.w}, uo[8] = {q0.x, q0.y, q0.z, q0.w, q1.x, q1.y, q1.z, q1.w};
            float v[16]; float s = 0.f;
#pragma unroll
            for (int j = 0; j < 8; ++j) { v[2 * j] = bf_lo(uf[j]) + bf_lo(ub[j]); v[2 * j + 1] = bf_hi(uf[j]) + bf_hi(ub[j]); s += v[2 * j] * v[2 * j] + v[2 * j + 1] * v[2 * j + 1]; }
            s += shx(s, 1, lane); s += shx(s, 2, lane); s += shx(s, 4, lane);
            const float rs = __builtin_amdgcn_rsqf(s * (1.0f / 128.0f) + EPSN);
            const float* g = g2;
            float ov[16];
#pragma unroll
            for (int j = 0; j < 8; ++j) { ov[2 * j] = sigmoidf_(bf_lo(uo[j])) * v[2 * j] * rs * g[2 * j]; ov[2 * j + 1] = sigmoidf_(bf_hi(uo[j])) * v[2 * j + 1] * rs * g[2 * j + 1]; }
            u32x4 o0, o1; o0.x = cvt_pk_bf16(ov[0], ov[1]); o0.y = cvt_pk_bf16(ov[2], ov[3]); o0.z = cvt_pk_bf16(ov[4], ov[5]); o0.w = cvt_pk_bf16(ov[6], ov[7]);
            o1.x = cvt_pk_bf16(ov[8], ov[9]); o1.y = cvt_pk_bf16(ov[10], ov[11]); o1.z = cvt_pk_bf16(ov[12], ov[13]); o1.w = cvt_pk_bf16(ov[14], ov[15]);
            yo[128 + lane * 2] = o0; yo[128 + lane * 2 + 1] = o1;
        }
    }
}

__device__ __forceinline__ void phase_final(const Params& P) {
    LAUNDER_Z();
    const int lane = tid_l() & 63, gw = bid_l() * 8 + (tid_l() >> 6), NGW = gridDim.x * 8;
    const float* H = (const float*)(P.ws + zz + WS_H);
    for (int q = gw; q < NB * 2048; q += NGW) {
        const int b = q >> 11, t = q & 2047; const size_t r = (size_t)b * LP + 64 + t;
        const f32x4* xr = (const f32x4*)(H + r * DM) + lane; const f32x4* gr = (const f32x4*)PIN(26) + lane; f32x4* o = (f32x4*)(P.out + zz + (size_t)q * DM) + lane;
        f32x4 v[8]; float s = 0.f;
#pragma unroll
        for (int j = 0; j < 8; ++j) { v[j] = xr[64 * j]; s += (v[j][0] * v[j][0] + v[j][1] * v[j][1]) + (v[j][2] * v[j][2] + v[j][3] * v[j][3]); }
        const float rs = __builtin_amdgcn_rsqf(wave_sum(s, lane) * (1.0f / DM) + EPSN);
#pragma unroll
        for (int j = 0; j < 8; ++j) o[64 * j] = v[j] * rs * gr[64 * j];
    }
}

#define XB_TMO      128
#define XB_XCNT(j)  (256  + 64 * (j))
#define XB_XSUB(j)  (1280 + 64 * (j))
#define XB_XGEN(j)  (2304 + 64 * (j))
#define XB_TOP      3328
#define XB_TOPGEN   3392
#define XCD_BAR_WORDS 3456
#define XB_SPIN_CAP (1u << 22)
__device__ __forceinline__ unsigned xb_ld(unsigned* p)              { return __hip_atomic_load(p, __ATOMIC_RELAXED, __HIP_MEMORY_SCOPE_AGENT); }
__device__ __forceinline__ unsigned xb_add(unsigned* p, unsigned v) { return __hip_atomic_fetch_add(p, v, __ATOMIC_RELAXED, __HIP_MEMORY_SCOPE_AGENT); }
__device__ __forceinline__ unsigned xb_xcc_id() { return (unsigned)__builtin_amdgcn_s_getreg((3 << 11) | 20) & 0xFu; }
#define XB_SPIN(cond, bar) do { unsigned _sp = 0; while (cond) { __builtin_amdgcn_s_sleep(1); \
    if ((++_sp & 255u) == 0u) { if (xb_ld(&(bar)[XB_TMO])) break; if (_sp > XB_SPIN_CAP) { atomicAdd(&(bar)[XB_TMO], 1u); break; } } } } while (0)
__device__ __forceinline__ void xcd_barrier(unsigned* bar, volatile LAS unsigned* st, unsigned G) {
    asm volatile("s_waitcnt vmcnt(0)" ::: "memory");
    __syncthreads();
    if (tid_l() == 0) {
        __builtin_amdgcn_s_waitcnt(0);
        const unsigned x = xb_xcc_id();
        unsigned nloc = st[0], nx = st[1];
        if (nloc == 0u) {
            unsigned sum, cnt, mine, sp = 0u;
            for (;;) {
                sum = 0u; cnt = 0u; mine = 0u;
#pragma unroll
                for (unsigned j = 0; j < 16; ++j) { const unsigned c = xb_ld(&bar[XB_XCNT(j)]); sum += c; cnt += (c > 0u) ? 1u : 0u; mine = (j == x) ? c : mine; }
                if (sum == G) break;
                __builtin_amdgcn_s_sleep(1);
                if ((++sp & 255u) == 0u) { if (xb_ld(&bar[XB_TMO])) break; if (sp > XB_SPIN_CAP) { atomicAdd(&bar[XB_TMO], 1u); break; } }
            }
            nloc = mine > 0u ? mine : 1u; nx = cnt > 0u ? cnt : 1u; st[0] = nloc; st[1] = nx;
        }
        const unsigned old = xb_add(&bar[XB_XSUB(x)], 1u);
        const unsigned gen = old / nloc;
        if (old + 1u == (gen + 1u) * nloc) {
            __builtin_amdgcn_fence(__ATOMIC_RELEASE, "agent");
            asm volatile("s_waitcnt vmcnt(0)" ::: "memory");
            const unsigned og = xb_add(&bar[XB_TOP], 1u);
            const unsigned tg = og / nx;
            if (og + 1u == (tg + 1u) * nx) xb_add(&bar[XB_TOPGEN], 1u);
            else XB_SPIN(xb_ld(&bar[XB_TOPGEN]) == tg, bar);
            __builtin_amdgcn_fence(__ATOMIC_ACQUIRE, "agent");
            xb_add(&bar[XB_XGEN(x)], 1u);
            asm volatile("s_waitcnt vmcnt(0)" ::: "memory");
        } else {
            XB_SPIN(xb_ld(&bar[XB_XGEN(x)]) == gen, bar);
            __builtin_amdgcn_fence(__ATOMIC_ACQUIRE, "agent");
            asm volatile("s_waitcnt vmcnt(0)" ::: "memory");
        }
    }
    __syncthreads();
}

__global__ void __launch_bounds__(512, 2) mk_fwd(Params P) {
    extern __shared__ __attribute__((aligned(16))) unsigned char lds_raw[];
    LAS unsigned char* lds = (LAS unsigned char*)lds_raw;
    cg::grid_group grid = cg::this_grid();
    volatile LAS unsigned* xst = (volatile LAS unsigned*)(lds + 131072);
    if (threadIdx.x < 4) xst[threadIdx.x] = 0u;
    __syncthreads();
    unsigned char* ws = P.ws;
    for (int ph = P.ph_lo; ph < P.ph_hi; ++ph) {
        if (ph == 0) {
            if (bid_l() == 0) { for (int i = tid_l(); i < 8192 + 1024 + XCD_BAR_WORDS; i += 512) ((unsigned*)ws)[i] = 0u; }
            phase_init_rows(P);
            for (int pr = bid_l(); pr < DEPTH * 64; pr += gridDim.x) s5_precompute(P, lds, pr >> 6, pr & 63);
            __syncthreads();
            convert_weights(P, lds, 0, bid_l() * 8 + (tid_l() >> 6), gridDim.x * 8, tid_l() >> 6, tid_l() & 63);
        }
        else if (ph == NPHASES - 1) phase_final(P);
        else {
            const int l = (ph - 1) / NPH_L, k = (ph - 1) % NPH_L;
            GemmDesc d; d.layer = l; d.nB = 1; d.sA = 0; d.sB = 0; d.A = nullptr; d.Bt = nullptr; d.lda = d.ldb = d.K = 256; d.nM = d.nN = 1; d.epi = 0; d.ssi = 0; d.amode = 0; d.split = 0; d.perm = 0; d.ubase = 0; d.umax = 0x7fffffff; d.gG = gridDim.x; d.gc = bid_l(); bool isg = false;
            const unsigned char* wb = (l & 1) ? (const unsigned char*)P.out : ws + WS_WSET;
            switch (k) {
            case 0: { const int gt = bid_l() * 512 + tid_l(), NGT = gridDim.x * 512; zero_rows16((bf16_t*)(ws + WS_Z) - 3072, 384, gt, NGT); zero_rows16((bf16_t*)(ws + WS_Z) + (size_t)MP * 3072, 384, gt, NGT); }
                d.A = (const bf16_t*)(ws + WS_HN); d.Bt = (const bf16_t*)(wb + WO_WIN); d.lda = LDH; d.ldb = LDH; d.K = DM; d.nM = MP / 256; d.nN = DINP / 256; d.epi = EPI_WIN; d.ssi = 2 * l; d.perm = 1; isg = true; break;
            case 1:
                if (bid_l() < 128) phase_mlstm(P, lds, l);
                else {
                    d.gG = gridDim.x - 128; d.gc = bid_l() - 128;
                    d.A = (const bf16_t*)(ws + WS_UA); d.Bt = (const bf16_t*)(ws + WS_WST) + (size_t)l * 64 * (256 * LDWS); d.lda = LDU; d.ldb = LDWS; d.K = 256; d.nM = S5ROWP / 256; d.nN = 1; d.nB = 64; d.sA = (size_t)S5ROWP * LDU; d.sB = 256 * LDWS; d.epi = EPI_S5A;
                    gemm_phase(P, lds, d);
                    xcd_barrier((unsigned*)ws + 8192 + 1024, xst + 2, gridDim.x - 128);
                    phase_s5_scan(P, l, 128);
                    xcd_barrier((unsigned*)ws + 8192 + 1024, xst + 2, gridDim.x - 128);
                    d.Bt = (const bf16_t*)(ws + WS_TO) + (size_t)l * 64 * (256 * LDTO); d.ldb = LDTO; d.K = 512; d.sB = 256 * LDTO; d.epi = EPI_S5C; d.perm = 1;
                    gemm_phase(P, lds, d);
                    xcd_barrier((unsigned*)ws + 8192 + 1024, xst + 2, gridDim.x - 128);
                    d.A = (const bf16_t*)(ws + WS_YGELU); d.Bt = (const bf16_t*)(wb + WO_WGLU); d.lda = LDG; d.ldb = LDG; d.K = 1024; d.nM = MP / 256; d.nN = 4; d.nB = 1; d.sA = 0; d.sB = 0; d.epi = EPI_GLU; d.perm = 1; d.umax = 2 * (gridDim.x - 128); isg = true;
                    if (bid_l() == 128 && tid_l() == 0) __hip_atomic_store((unsigned*)ws + 128, (unsigned)(l + 1), __ATOMIC_RELAXED, __HIP_MEMORY_SCOPE_AGENT);
                }
                break;
            case 2: phase_finalize(P, l); break;
            case 3: d.A = (const bf16_t*)(ws + WS_Y); d.Bt = (const bf16_t*)(wb + WO_WOUT); d.lda = LDH; d.ldb = LDH; d.K = DM; d.nM = MP / 256; d.nN = 8; d.epi = EPI_RES; d.ssi = 2 * l + 1; d.split = 4; d.perm = 1; isg = true; break;
            case 4: d.A = (const bf16_t*)(ws + WS_HN) - LDH; d.Bt = (const bf16_t*)(wb + WO_WGU); d.lda = LDH; d.ldb = LDH; d.K = DM; d.nM = 69; d.nN = 44; d.epi = EPI_FFN; d.ssi = 2 * l + 1; d.amode = 1; d.perm = 1; isg = true; break;
            case 5: d.A = (const bf16_t*)(ws + WS_ACT); d.Bt = (const bf16_t*)(wb + WO_WDN); d.lda = LDF; d.ldb = LDF; d.K = DFF; d.nM = MP / 256; d.nN = 8; d.epi = EPI_RES; d.ssi = 2 * l + 2; d.split = 4; d.perm = 1; isg = true; break;
            }
            if (isg) gemm_phase(P, lds, d);
            if (k == 0 && l + 1 < DEPTH) {
                const int nun = (MP / 256) * (DINP / 256), nbusy = nun - (nun / (int)gridDim.x) * (int)gridDim.x; const int t_ = tid_l(); __syncthreads();
                if (bid_l() >= nbusy) convert_weights(P, lds, l + 1, (bid_l() - nbusy) * 8 + (t_ >> 6), (gridDim.x - nbusy) * 8, t_ >> 6, t_ & 63, 0, CV_SPLIT1);
            }
            if (k == 1 && l + 1 < DEPTH && bid_l() < 128) {
                const int t_ = tid_l(); __syncthreads();
                convert_weights(P, lds, l + 1, bid_l() * 8 + (t_ >> 6), 128 * 8, t_ >> 6, t_ & 63, CV_SPLIT1, CV_SPLIT2);
            }
            if (k == 1 && bid_l() < 128) {
                const int ntail = (MP / 256) * 4 - 2 * ((int)gridDim.x - 128);
                if ((int)bid_l() < ntail) {
                    __syncthreads();
                    if (tid_l() == 0) { unsigned sp = 0; while (__hip_atomic_load((unsigned*)ws + 128, __ATOMIC_RELAXED, __HIP_MEMORY_SCOPE_AGENT) < (unsigned)(l + 1)) { __builtin_amdgcn_s_sleep(4); if (++sp > (1u << 24)) break; }
                        __builtin_amdgcn_fence(__ATOMIC_ACQUIRE, "agent"); asm volatile("s_waitcnt vmcnt(0)" ::: "memory"); }
                    __syncthreads();
                    d.A = (const bf16_t*)(ws + WS_YGELU); d.Bt = (const bf16_t*)(wb + WO_WGLU); d.lda = LDG; d.ldb = LDG; d.K = 1024; d.nM = MP / 256; d.nN = 4; d.nB = 1; d.sA = 0; d.sB = 0; d.epi = EPI_GLU; d.perm = 1;
                    d.ubase = 2 * ((int)gridDim.x - 128); d.umax = 0x7fffffff; d.gG = ntail; d.gc = bid_l();
                    gemm_phase(P, lds, d);
                }
            }
            if (k == 5 && l + 1 < DEPTH) {
                const int nun = (MP / 256) * 8, nfull = (nun / (int)gridDim.x) * (int)gridDim.x, nbusy = (nun - nfull) * 4;
                const int t_ = tid_l(); __syncthreads();
                if (nbusy == 0 || nbusy >= (int)gridDim.x) convert_weights(P, lds, l + 1, bid_l() * 8 + (t_ >> 6), gridDim.x * 8, t_ >> 6, t_ & 63, CV_SPLIT2);
                else if (bid_l() >= nbusy) convert_weights(P, lds, l + 1, (bid_l() - nbusy) * 8 + (t_ >> 6), (gridDim.x - nbusy) * 8, t_ >> 6, t_ & 63, CV_SPLIT2);
            }
        }
        if (ph + 1 < P.ph_hi) { if (ph == 0) { grid.sync(); if (threadIdx.x == 0) { (void)xb_add((unsigned*)ws + 1024 + XB_XCNT(xb_xcc_id()), 1u); if (blockIdx.x >= 128) (void)xb_add((unsigned*)ws + 8192 + 1024 + XB_XCNT(xb_xcc_id()), 1u); } } else xcd_barrier((unsigned*)ws + 1024, xst, gridDim.x); }
    }
}

extern "C" void kernel_launch(void* const* d_in, const int* in_sizes, int n_in, void* d_out, int out_size, void* d_ws, size_t ws_size, hipStream_t stream) {
    static int grid = 0;
    if (grid == 0) {
        int dev = 0, cus = 0, per_cu = 0;
        hipGetDevice(&dev); hipDeviceGetAttribute(&cus, hipDeviceAttributeMultiprocessorCount, dev);
        if (hipFuncSetAttribute((const void*)mk_fwd, hipFuncAttributeMaxDynamicSharedMemorySize, LDS_BYTES) != hipSuccess) { fprintf(stderr, "kernel_launch: hipFuncSetAttribute failed\n"); grid = -1; return; }
        if (hipOccupancyMaxActiveBlocksPerMultiprocessor(&per_cu, (const void*)mk_fwd, 512, LDS_BYTES) != hipSuccess || per_cu < 1) { fprintf(stderr, "kernel_launch: occupancy query says %d\n", per_cu); per_cu = 1; }
        (void)hipGetLastError();
        grid = cus;
        if (ws_size < WS_END) fprintf(stderr, "kernel_launch: workspace too small: %zu < %zu\n", ws_size, (size_t)WS_END);
    }
    if (grid < 0) return;
    Params p{};
    for (int i = 0; i < 27; ++i) p.in[i] = (const float*)d_in[i];
    p.out = (float*)d_out; p.ws = (unsigned char*)d_ws; p.ph_lo = 0; p.ph_hi = NPHASES;
    void* args[] = {&p};
    hipError_t e = hipLaunchCooperativeKernel((const void*)mk_fwd, dim3(grid), dim3(512), args, LDS_BYTES, stream);
    if (e != hipSuccess) fprintf(stderr, "cooperative launch failed: %s (grid %d)\n", hipGetErrorString(e), grid);
}
```

```cpp
#include <hip/hip_runtime.h>
#include <hip/hip_cooperative_groups.h>
#include <cstdio>
namespace cg = cooperative_groups;

#define LAS __attribute__((address_space(3)))
typedef unsigned short bf16_t;
typedef short bf16x8 __attribute__((ext_vector_type(8)));
typedef float f32x4 __attribute__((ext_vector_type(4)));
typedef unsigned u32x4 __attribute__((ext_vector_type(4)));
typedef unsigned u32x2 __attribute__((ext_vector_type(2)));

constexpr int DM = 2048, NB = 8, LP = 2112, PADF = 48, MP = NB * LP;
constexpr int DIN = 4128, DINP = 4352, DFF = 5632, DEPTH = 4;
constexpr int NCH = LP / 16;
constexpr int S5ROWS = NB * NCH;
constexpr int S5ROWP = 1280;
constexpr float EPSN = 1e-6f;
constexpr int LDH = 2112, LDF = 5696, LDG = 1088, LDU = 576, LDWS = 320, LDTO = 576;
constexpr int CV_SPLIT1 = 7075, CV_SPLIT2 = 14150;
constexpr int NPH_L = 6, NPHASES = 2 + DEPTH * NPH_L;

constexpr size_t MiB = 1u << 20;
constexpr size_t WO_WIN = 0 * MiB, WO_WGLU = 18 * MiB, WO_WOUT = 21 * MiB, WO_WGU = 30 * MiB, WO_WDN = 76 * MiB;
constexpr size_t WS_WSET = 1 * MiB;
constexpr size_t WS_WST = 100 * MiB, WS_TO = 140 * MiB, WS_H = 212 * MiB, WS_HN = 344 * MiB + 8192, WS_G = 413 * MiB, WS_Y = 416 * MiB;
constexpr size_t WS_UA = 485 * MiB, WS_Z = 576 * MiB, WS_SLOC = 676 * MiB, WS_YGELU = 676 * MiB, WS_YGLU = 716 * MiB, WS_HFB = 756 * MiB;
constexpr size_t WS_GT = 486 * MiB, WS_ACT = 669 * MiB, WS_SS = 854 * MiB, WS_END = 856 * MiB;
constexpr int LDS_BYTES = 147456;

struct Params { const float* in[27]; float* out; unsigned char* ws; int ph_lo, ph_hi; };

#define LAUNDER_Z() int zz = 0; asm volatile("" : "+s"(zz))
#define PIN(i) (P.in[(i) + zz])
__device__ __forceinline__ int tid_l() { int w = __builtin_amdgcn_readfirstlane(threadIdx.x >> 6); asm volatile("" : "+s"(w)); int ln = __builtin_amdgcn_mbcnt_hi(~0u, __builtin_amdgcn_mbcnt_lo(~0u, 0u)); asm volatile("" : "+v"(ln)); return w * 64 + ln; }
__device__ __forceinline__ int bid_l() { int t = blockIdx.x; asm volatile("" : "+s"(t)); return t; }
__device__ __forceinline__ unsigned cvt_pk_bf16(float lo, float hi) { unsigned r; asm("v_cvt_pk_bf16_f32 %0, %1, %2" : "=v"(r) : "v"(lo), "v"(hi)); return r; }
__device__ __forceinline__ float bf_lo(unsigned w) { return __uint_as_float(w << 16); }
__device__ __forceinline__ float bf_hi(unsigned w) { return __uint_as_float(w & 0xffff0000u); }
__device__ __forceinline__ float bf2f(bf16_t b) { return __uint_as_float((unsigned)b << 16); }
__device__ __forceinline__ bf16_t f2bf(float f) { return (bf16_t)(cvt_pk_bf16(f, 0.f) & 0xffffu); }
__device__ __forceinline__ float sigmoidf_(float x) { return __builtin_amdgcn_rcpf(1.0f + __expf(-x)); }
__device__ __forceinline__ float siluf_(float x) { return x * sigmoidf_(x); }
__device__ __forceinline__ float gelu_tanh(float x) { const float u = 0.7978845608028654f * (x + 0.044715f * x * x * x); return x * __builtin_amdgcn_rcpf(1.0f + __expf(-2.0f * u)); }
__device__ __forceinline__ float shx(float v, int o, int lane) { return __int_as_float(__builtin_amdgcn_ds_bpermute((lane ^ o) << 2, __float_as_int(v))); }
__device__ __forceinline__ float shi(float v, int idx) { return __int_as_float(__builtin_amdgcn_ds_bpermute(idx << 2, __float_as_int(v))); }
__device__ __forceinline__ float wave_sum(float v, int lane) {
#pragma unroll
    for (int o = 1; o < 64; o <<= 1) v += shx(v, o, lane);
    return v;
}
__device__ __forceinline__ float wave_max(float v, int lane) {
#pragma unroll
    for (int o = 1; o < 64; o <<= 1) v = fmaxf(v, shx(v, o, lane));
    return v;
}

__device__ __forceinline__ float dpp_shr(float v, float ident, const int n) {
    switch (n) {
    case 1: return __int_as_float(__builtin_amdgcn_update_dpp(__float_as_int(ident), __float_as_int(v), 0x111, 0xf, 0xf, false));
    case 2: return __int_as_float(__builtin_amdgcn_update_dpp(__float_as_int(ident), __float_as_int(v), 0x112, 0xf, 0xf, false));
    case 4: return __int_as_float(__builtin_amdgcn_update_dpp(__float_as_int(ident), __float_as_int(v), 0x114, 0xf, 0xf, false));
    default: return __int_as_float(__builtin_amdgcn_update_dpp(__float_as_int(ident), __float_as_int(v), 0x118, 0xf, 0xf, false));
    }
}
__device__ __forceinline__ float rdlane(float v, const int l) { return __int_as_float(__builtin_amdgcn_readlane(__float_as_int(v), l)); }
__device__ __forceinline__ float wave_incl_sum(float v, int lane) {
    v += dpp_shr(v, 0.f, 1); v += dpp_shr(v, 0.f, 2); v += dpp_shr(v, 0.f, 4); v += dpp_shr(v, 0.f, 8);
    const float s0 = rdlane(v, 15), s1 = rdlane(v, 31), s2 = rdlane(v, 47); const int q = lane >> 4;
    return v + (q == 0 ? 0.f : (q == 1 ? s0 : (q == 2 ? s0 + s1 : (s0 + s1) + s2)));
}
__device__ __forceinline__ float wave_incl_max(float v, int lane) {
    const float NI = -3.0e38f;
    v = fmaxf(v, dpp_shr(v, NI, 1)); v = fmaxf(v, dpp_shr(v, NI, 2)); v = fmaxf(v, dpp_shr(v, NI, 4)); v = fmaxf(v, dpp_shr(v, NI, 8));
    const float m0 = rdlane(v, 15), m1 = fmaxf(m0, rdlane(v, 31)), m2 = fmaxf(m1, rdlane(v, 47)); const int q = lane >> 4;
    return fmaxf(v, q == 0 ? NI : (q == 1 ? m0 : (q == 2 ? m1 : m2)));
}
constexpr int BM = 256, BK = 64, HALF = 128, HTB = HALF * BK * 2;
__device__ __forceinline__ int lds_byte(int r, int c) { const int st = (r >> 4) * 2 + (c >> 5), rr = r & 15, cc = c & 31, ob = rr * 64 + cc * 2; return st * 1024 + (ob ^ (((ob >> 9) & 1) << 5)); }
__device__ __forceinline__ void stage_rc(int b, int& R, int& C) { const int st = b / 1024, sb = b % 1024, swz = sb ^ (((sb >> 9) & 1) << 5); R = (st >> 1) * 16 + swz / 64; C = (st & 1) * 32 + (swz % 64) / 2; }

struct Unit { int pm, pn, b, piece, tu, k0, nt; };
struct GemmDesc { const bf16_t* A; const bf16_t* Bt; int lda, ldb, K, nM, nN, nB; size_t sA, sB; int epi, layer, ssi, amode, gG, gc, split, ubase, umax, perm; };
enum { EPI_WIN = 0, EPI_S5A = 1, EPI_S5C = 2, EPI_GLU = 3, EPI_RES = 4, EPI_FFN = 5 };

__device__ __forceinline__ bool next_unit(const GemmDesc& d, int i, int G, int c, Unit& u) {
    const int per = d.nM * d.nN; long L = (long)d.ubase + (long)i * G + c; const int ntf = d.K / BK;
    if (L >= d.umax) return false;
    u.piece = -1; u.tu = 0; u.k0 = 0; u.nt = ntf;
    if (d.split > 0) { const int nfull = (per / G) * G;
        if (L >= nfull) { const long q = L - nfull; if (q >= (long)(per - nfull) * d.split) return false;
            u.tu = (int)(q / d.split); u.piece = (int)(q % d.split); u.nt = ntf / d.split; u.k0 = u.piece * u.nt; L = nfull + u.tu; } }
    if (L >= (long)per * d.nB) return false;
    u.b = (int)(L / per); int wgid = (int)(L % per);
    { const int q = per / 8, r = per % 8, xcd = wgid % 8, off = wgid / 8; wgid = (xcd < r ? xcd * (q + 1) : r * (q + 1) + (xcd - r) * q) + off; }
    const int nig = 8 * d.nN, gid = wgid / nig, fm = gid * 8, gsz = (d.nM - fm) < 8 ? (d.nM - fm) : 8;
    u.pm = fm + ((wgid % nig) % gsz); u.pn = (wgid % nig) / gsz; return true;
}

__device__ __forceinline__ void store_bf4(bf16_t* p, f32x4 v) { u32x2 w; w.x = cvt_pk_bf16(v[0], v[1]); w.y = cvt_pk_bf16(v[2], v[3]); *(u32x2*)p = w; }
__device__ __forceinline__ f32x4 load_bf4(const bf16_t* p) { const u32x2 w = *(const u32x2*)p; return (f32x4){bf_lo(w.x), bf_hi(w.x), bf_lo(w.y), bf_hi(w.y)}; }

typedef unsigned long long u64;
constexpr float SSCALE = 16777216.0f;
__device__ __forceinline__ float row_rs(const u64* ss, int r) { return __builtin_amdgcn_rsqf((float)ss[r] * (1.0f / (SSCALE * DM)) + EPSN); }
__device__ __forceinline__ void gemm_epilogue(const Params& P, const GemmDesc& d, const f32x4 (&acc)[2][2][4][2], const Unit& u, int wr, int wc, int fr, int fq) {
    LAUNDER_Z(); unsigned char* ws = P.ws + zz; const int l = d.layer;
    int lane;
    { const int t2 = tid_l(); const int w2 = __builtin_amdgcn_readfirstlane(t2 >> 6); wr = w2 >> 2; wc = w2 & 3; lane = t2 & 63; fr = lane & 15; fq = lane >> 4; }
    const int rbase = u.pm * BM + wr * 64 + fr, cbase = u.pn * BM + wc * 32 + 4 * fq;
    if (d.epi == EPI_RES) {
        const int cb8 = u.pn * BM + wc * 32 + 8 * fq;
        float* hb = (float*)(ws + WS_H) + (size_t)rbase * DM + cb8; bf16_t* nb = (bf16_t*)(ws + WS_HN) + (size_t)rbase * LDH + cb8;
        u64* ssp = (u64*)(ws + WS_SS) + (size_t)d.ssi * MP + rbase;
#pragma unroll
        for (int ai = 0; ai < 2; ++ai)
#pragma unroll
        for (int mh = 0; mh < 2; ++mh) {
            f32x4 t[2][2][2];
            float* hp = hb + (size_t)(ai * HALF + mh * 32) * DM; asm volatile("" : "+v"(hp));
#pragma unroll
            for (int m = 0; m < 2; ++m)
#pragma unroll
                for (int bj = 0; bj < 2; ++bj)
#pragma unroll
                    for (int n = 0; n < 2; ++n) t[m][bj][n] = *(const f32x4*)(hp + (size_t)(m * 16) * DM + bj * HALF + n * 4);
            float sq[2] = {0.f, 0.f};
#pragma unroll
            for (int m = 0; m < 2; ++m)
#pragma unroll
                for (int bj = 0; bj < 2; ++bj)
#pragma unroll
                    for (int n = 0; n < 2; ++n) { const f32x4 hv = t[m][bj][n] + acc[ai][bj][mh * 2 + m][n]; t[m][bj][n] = hv;
                        __builtin_nontemporal_store(hv, (f32x4*)(hp + (size_t)(m * 16) * DM + bj * HALF + n * 4));
                        sq[m] += (hv[0] * hv[0] + hv[1] * hv[1]) + (hv[2] * hv[2] + hv[3] * hv[3]); }
            bf16_t* np = nb + (size_t)(ai * HALF + mh * 32) * LDH; asm volatile("" : "+v"(np));
#pragma unroll
            for (int m = 0; m < 2; ++m) {
#pragma unroll
                for (int bj = 0; bj < 2; ++bj) { u32x4 o; o.x = cvt_pk_bf16(t[m][bj][0][0], t[m][bj][0][1]); o.y = cvt_pk_bf16(t[m][bj][0][2], t[m][bj][0][3]); o.z = cvt_pk_bf16(t[m][bj][1][0], t[m][bj][1][1]); o.w = cvt_pk_bf16(t[m][bj][1][2], t[m][bj][1][3]);
                    *(u32x4*)(np + (size_t)(m * 16) * LDH + bj * HALF) = o; }
                float q = sq[m]; q += shx(q, 16, lane); q += shx(q, 32, lane);
                if (fq == 0) atomicAdd(ssp + ai * HALF + mh * 32 + m * 16, (u64)(q * SSCALE));
            }
        }
        return;
    }
    if (d.epi == EPI_FFN) {
        const int ccol = u.pn * 128 + wc * 32 + 8 * fq;
        const float* cwb = PIN(23) + (size_t)l * 3 * DFF + ccol; const float* cbb = PIN(24) + (size_t)l * DFF + ccol;
        const u64* ssb = (const u64*)(ws + WS_SS) + (size_t)d.ssi * MP;
#pragma unroll
        for (int ai = 0; ai < 2; ++ai) {
            const int row0 = u.pm * 248 + (ai * 2 + wr) * 62 - 1 + fr;
            float rsv[4];
#pragma unroll
            for (int m = 0; m < 4; ++m) { int rc = row0 + m * 16; rc = rc < 0 ? 0 : (rc > MP - 1 ? MP - 1 : rc); rsv[m] = row_rs(ssb, rc); }
            bf16_t* ab = (bf16_t*)(ws + WS_ACT) + (size_t)row0 * LDF + ccol;
            u32x2 keep[4];
#pragma unroll
            for (int n = 0; n < 2; ++n) {
                const f32x4 w0 = *(const f32x4*)(cwb + n * 4), w1 = *(const f32x4*)(cwb + DFF + n * 4), w2 = *(const f32x4*)(cwb + 2 * DFF + n * 4), cb = *(const f32x4*)(cbb + n * 4);
                f32x4 X[4], RR[4], RL[4];
#pragma unroll
                for (int m = 0; m < 4; ++m) { X[m] = acc[ai][0][m][n] * rsv[m];
#pragma unroll
                    for (int j = 0; j < 4; ++j) { RR[m][j] = __int_as_float(__builtin_amdgcn_update_dpp(0, __float_as_int(X[m][j]), 0x121, 0xf, 0xf, false));
                                                  RL[m][j] = __int_as_float(__builtin_amdgcn_update_dpp(0, __float_as_int(X[m][j]), 0x12f, 0xf, 0xf, false)); } }
#pragma unroll
                for (int m = 0; m < 4; ++m) {
                    const f32x4 prev = (fr > 0) ? RR[m] : RR[m > 0 ? m - 1 : 0];
                    const f32x4 next = (fr < 15) ? RL[m] : RL[m < 3 ? m + 1 : 3];
                    const f32x4 gt = cb + w0 * prev + w1 * X[m] + w2 * next; const f32x4 v = acc[ai][1][m][n] * rsv[m];
                    const int lr = m * 16 + fr, row = row0 + m * 16;
                    u32x2 pk; pk.x = cvt_pk_bf16(siluf_(gt[0]) * v[0], siluf_(gt[1]) * v[1]); pk.y = cvt_pk_bf16(siluf_(gt[2]) * v[2], siluf_(gt[3]) * v[3]);
                    if (n == 0) keep[m] = pk;
                    else if (lr >= 1 && lr <= 62 && row < MP) { u32x4 o; o.x = keep[m].x; o.y = keep[m].y; o.z = pk.x; o.w = pk.y; __builtin_nontemporal_store(o, (u32x4*)(ab + (size_t)(m * 16) * LDF)); } }
            }
        }
        return;
    }
    if (d.epi == EPI_GLU) {
        const int c8 = u.pn * BM + wc * 32 + 8 * fq;
        const bf16_t* yb = (const bf16_t*)(ws + WS_YGELU) + (size_t)rbase * LDG + c8; bf16_t* ob = (bf16_t*)(ws + WS_YGLU) + (size_t)rbase * 1024 + c8;
        const float* bb = PIN(13) + (size_t)l * 1024 + c8;
#pragma unroll
        for (int bj = 0; bj < 2; ++bj) {
            f32x4 bg[2];
#pragma unroll
            for (int n = 0; n < 2; ++n) bg[n] = *(const f32x4*)(bb + bj * HALF + n * 4);
#pragma unroll
            for (int ai = 0; ai < 2; ++ai) {
                u32x4 y[4];
                const bf16_t* yq = yb + (size_t)(ai * HALF) * LDG + bj * HALF; asm volatile("" : "+v"(yq));
#pragma unroll
                for (int m = 0; m < 4; ++m) y[m] = *(const u32x4*)(yq + (size_t)(m * 16) * LDG);
#pragma unroll
                for (int m = 0; m < 4; ++m) { const f32x4 v0 = acc[ai][bj][m][0] + bg[0], v1 = acc[ai][bj][m][1] + bg[1]; const u32x4 yy = y[m]; u32x4 o;
                    o.x = cvt_pk_bf16(bf_lo(yy.x) * sigmoidf_(v0[0]), bf_hi(yy.x) * sigmoidf_(v0[1])); o.y = cvt_pk_bf16(bf_lo(yy.y) * sigmoidf_(v0[2]), bf_hi(yy.y) * sigmoidf_(v0[3]));
                    o.z = cvt_pk_bf16(bf_lo(yy.z) * sigmoidf_(v1[0]), bf_hi(yy.z) * sigmoidf_(v1[1])); o.w = cvt_pk_bf16(bf_lo(yy.w) * sigmoidf_(v1[2]), bf_hi(yy.w) * sigmoidf_(v1[3]));
                    *(u32x4*)(ob + (size_t)(ai * HALF + m * 16) * 1024 + bj * HALF) = o; }
            }
        }
        return;
    }
    if (d.epi == EPI_S5C) {
#pragma unroll
        for (int ai = 0; ai < 2; ++ai)
#pragma unroll
        for (int m = 0; m < 4; ++m) {
            const int r = rbase + ai * HALF + m * 16;
            if (r < S5ROWS) { const int b = r / NCH, nn = r - b * NCH;
#pragma unroll
                for (int bj = 0; bj < 2; ++bj) { const int c8 = bj * HALF + wc * 32 + 8 * fq, tl = c8 >> 4, ch = c8 & 15; const size_t row = (size_t)b * LP + nn * 16 + tl;
                    const f32x4 v0 = acc[ai][bj][m][0], v1 = acc[ai][bj][m][1]; u32x4 o;
                    o.x = cvt_pk_bf16(gelu_tanh(v0[0]), gelu_tanh(v0[1])); o.y = cvt_pk_bf16(gelu_tanh(v0[2]), gelu_tanh(v0[3])); o.z = cvt_pk_bf16(gelu_tanh(v1[0]), gelu_tanh(v1[1])); o.w = cvt_pk_bf16(gelu_tanh(v1[2]), gelu_tanh(v1[3]));
                    *(u32x4*)((bf16_t*)(ws + WS_YGELU) + row * LDG + u.b * 16 + ch) = o; } }
        }
        return;
    }
    if (d.epi == EPI_WIN) {
        const u64* ssb = (const u64*)(ws + WS_SS) + (size_t)d.ssi * MP;
#pragma unroll
        for (int ai = 0; ai < 2; ++ai)
#pragma unroll
        for (int m = 0; m < 4; ++m) {
            const int r = rbase + ai * HALF + m * 16; const float rsc = row_rs(ssb, r);
#pragma unroll
            for (int bj = 0; bj < 2; ++bj) {
                const int c8 = u.pn * BM + bj * HALF + wc * 32 + 8 * fq;
                const f32x4 v0 = acc[ai][bj][m][0] * rsc, v1 = acc[ai][bj][m][1] * rsc;
                if (u.pn < 16) { u32x4 o; o.x = cvt_pk_bf16(v0[0], v0[1]); o.y = cvt_pk_bf16(v0[2], v0[3]); o.z = cvt_pk_bf16(v1[0], v1[1]); o.w = cvt_pk_bf16(v1[2], v1[3]);
                    if (u.pn < 4) { const int g = c8 >> 4, ch = c8 & 15, b = r / LP, pos = r - b * LP, cr = b * NCH + (pos >> 4), tl = pos & 15;
                        *(u32x4*)((bf16_t*)(ws + WS_UA) + ((size_t)g * S5ROWP + cr) * LDU + tl * 16 + ch) = o; }
                    else *(u32x4*)((bf16_t*)(ws + WS_Z) + (size_t)r * 3072 + (c8 - 1024)) = o; }
                else if (c8 - 4096 < 32) { float* gp = (float*)(ws + WS_G) + (size_t)r * 32 + (c8 - 4096); *(f32x4*)gp = v0; *(f32x4*)(gp + 4) = v1; }
            }
        }
        return;
    }
#pragma unroll
    for (int ai = 0; ai < 2; ++ai)
#pragma unroll
    for (int m = 0; m < 4; ++m) {
        const int r = rbase + ai * HALF + m * 16;
        const float rsc = (d.epi == EPI_WIN) ? row_rs((const u64*)(ws + WS_SS) + (size_t)d.ssi * MP, r) : 1.0f;
#pragma unroll
        for (int bj = 0; bj < 2; ++bj)
#pragma unroll
        for (int n = 0; n < 2; ++n) {
            const int c0 = cbase + bj * HALF + n * 16;
            const f32x4 v = acc[ai][bj][m][n] * rsc;
            switch (d.epi) {
            case EPI_WIN: {
                if (u.pn < 4) { const int g = c0 >> 4, ch = c0 & 15, b = r / LP, pos = r - b * LP, cr = b * NCH + (pos >> 4), tl = pos & 15;
                    store_bf4((bf16_t*)(ws + WS_UA) + ((size_t)g * S5ROWP + cr) * LDU + tl * 16 + ch, v); }
                else if (u.pn < 16) store_bf4((bf16_t*)(ws + WS_Z) + (size_t)r * 3072 + (c0 - 1024), v);
                else if (c0 - 4096 < 32) *(f32x4*)((float*)(ws + WS_G) + (size_t)r * 32 + (c0 - 4096)) = v;
            } break;
            case EPI_S5A: *(f32x4*)((float*)(ws + WS_SLOC) + ((size_t)u.b * S5ROWP + r) * 256 + c0) = v; break;
            case EPI_S5C: {
                if (r < S5ROWS) { const int b = r / NCH, nn = r - b * NCH, tl = c0 >> 4, ch = c0 & 15; const size_t row = (size_t)b * LP + nn * 16 + tl;
                    store_bf4((bf16_t*)(ws + WS_YGELU) + row * LDG + u.b * 16 + ch, (f32x4){gelu_tanh(v[0]), gelu_tanh(v[1]), gelu_tanh(v[2]), gelu_tanh(v[3])}); }
            } break;
            default: break;
            }
        }
    }
}

__device__ __forceinline__ void gemm_phase(const Params& P, LAS unsigned char* lds, const GemmDesc d) {
    const int tid = tid_l(), wid = __builtin_amdgcn_readfirstlane(tid >> 6), lane = tid & 63, wr = wid >> 2, wc = wid & 3, fr = lane & 15, fq = lane >> 4;
    const int K = d.K, nt = K / BK; const int G = d.gG, cblk = d.gc;
    unsigned voffA[2], voffB[2];
#pragma unroll
    for (int i = 0; i < 2; ++i) { int R, C; stage_rc(tid * 16 + i * 8192, R, C); const int Ra = (d.amode && R >= 64) ? R - 2 : R; voffA[i] = (unsigned)(Ra * d.lda + C) * 2u; const int Rb = d.perm ? ((R & ~31) + 8 * ((R & 15) >> 2) + 4 * ((R & 31) >> 4) + (R & 3)) : R; voffB[i] = (unsigned)(Rb * d.ldb + C) * 2u; }
    const size_t kstep = (size_t)(BK * 2);
    const size_t hstepA = (size_t)(d.amode ? 124 : HALF) * d.lda * 2, hstepB = (size_t)HALF * d.ldb * 2;
    const unsigned ldsw = (unsigned)wid * 1024u;
    const int aoff = lds_byte(wr * 64 + fr, fq * 8), boff = lds_byte(wc * 32 + fr, fq * 8);
#define PG8_SA(b, h) (((b) * 2 + (h)) * HTB)
#define PG8_SB(b, h) ((4 + (b) * 2 + (h)) * HTB)
#define PG8_STAGE(bufoff, gbase, voff) do { _Pragma("unroll") for (int _i = 0; _i < 2; ++_i) \
        __builtin_amdgcn_global_load_lds((const unsigned*)((const char*)(gbase) + (voff)[_i]), (LAS unsigned*)(lds + (bufoff) + ldsw + _i * 8192), 16, 0, 0); } while (0)
#define PG8_LDA(dst, b, h) do { _Pragma("unroll") for (int m = 0; m < 4; ++m) _Pragma("unroll") for (int k = 0; k < 2; ++k) dst[m][k] = *(const LAS bf16x8*)(lds + PG8_SA(b, h) + aoff + m * 2048 + k * 1024); } while (0)
#define PG8_LDB(dst, b, h) do { _Pragma("unroll") for (int n = 0; n < 2; ++n) _Pragma("unroll") for (int k = 0; k < 2; ++k) dst[n][k] = *(const LAS bf16x8*)(lds + PG8_SB(b, h) + boff + n * 2048 + k * 1024); } while (0)
#define PG8_MMA(ai, bj, At, Bt) do { __builtin_amdgcn_s_setprio(1); _Pragma("unroll") for (int m = 0; m < 4; ++m) _Pragma("unroll") for (int n = 0; n < 2; ++n) _Pragma("unroll") for (int k = 0; k < 2; ++k) \
        acc[ai][bj][m][n] = __builtin_amdgcn_mfma_f32_16x16x32_bf16(Bt[n][k], At[m][k], acc[ai][bj][m][n], 0, 0, 0); __builtin_amdgcn_s_setprio(0); } while (0)
#define PG8_WAIT_V(n) asm volatile("s_waitcnt vmcnt(" #n ")" ::: "memory")
#define PG8_WAIT_L(n) asm volatile("s_waitcnt lgkmcnt(" #n ")" ::: "memory")
#define PG8_BAR __builtin_amdgcn_s_barrier()
#define PG8_SCHED __builtin_amdgcn_sched_barrier(0)
    Unit cur, nxt; int ui = 0;
    if (!next_unit(d, 0, G, cblk, cur)) return;
    f32x4 acc[2][2][4][2];
#pragma unroll
    for (int a = 0; a < 2; ++a)
#pragma unroll
        for (int b = 0; b < 2; ++b)
#pragma unroll
            for (int m = 0; m < 4; ++m)
#pragma unroll
                for (int n = 0; n < 2; ++n) acc[a][b][m][n] = (f32x4){0.f, 0.f, 0.f, 0.f};
    bf16x8 At[4][2], B0[2][2], B1[2][2];
    const char* cA = (const char*)d.A + ((size_t)cur.b * d.sA) * 2 + (size_t)cur.pm * 2 * hstepA + (size_t)cur.k0 * kstep;
    const char* cB = (const char*)d.Bt + ((size_t)cur.b * d.sB) * 2 + (size_t)cur.pn * 2 * hstepB + (size_t)cur.k0 * kstep;
    PG8_STAGE(PG8_SB(0, 0), cB, voffB); PG8_STAGE(PG8_SA(0, 0), cA, voffA); PG8_STAGE(PG8_SB(0, 1), cB + hstepB, voffB); PG8_STAGE(PG8_SA(0, 1), cA + hstepA, voffA);
    if (wr == 1) PG8_BAR;
    PG8_WAIT_V(4); PG8_BAR;
    PG8_STAGE(PG8_SB(1, 0), cB + kstep, voffB); PG8_STAGE(PG8_SA(1, 0), cA + kstep, voffA); PG8_STAGE(PG8_SB(1, 1), cB + hstepB + kstep, voffB);
    PG8_WAIT_V(6); PG8_BAR;
    for (;;) {
        const bool has_next = next_unit(d, ui + 1, G, cblk, nxt);
        const char* nA = has_next ? (const char*)d.A + ((size_t)nxt.b * d.sA) * 2 + (size_t)nxt.pm * 2 * hstepA + (size_t)nxt.k0 * kstep : cA;
        const char* nB = has_next ? (const char*)d.Bt + ((size_t)nxt.b * d.sB) * 2 + (size_t)nxt.pn * 2 * hstepB + (size_t)nxt.k0 * kstep : cB;
        const int ntu = cur.nt;
        for (int t = 0; t < ntu; t += 2) {
            const bool last = (t == ntu - 2);
            const char* a1 = cA + (size_t)(t + 1) * kstep;
            const char* a2 = last ? nA : cA + (size_t)(t + 2) * kstep; const char* b2 = last ? nB : cB + (size_t)(t + 2) * kstep;
            const char* a3 = a2 + kstep; const char* b3 = b2 + kstep;
            PG8_LDB(B0, 0, 0); PG8_SCHED; PG8_LDA(At, 0, 0); PG8_STAGE(PG8_SA(1, 1), a1 + hstepA, voffA);
            PG8_WAIT_L(8); PG8_BAR; PG8_WAIT_L(0); PG8_MMA(0, 0, At, B0); PG8_BAR; PG8_SCHED;
            PG8_LDB(B1, 0, 1); PG8_STAGE(PG8_SB(0, 0), b2, voffB);
            PG8_BAR; PG8_WAIT_L(0); PG8_MMA(0, 1, At, B1); PG8_BAR;
            PG8_LDA(At, 0, 1); PG8_STAGE(PG8_SA(0, 0), a2, voffA);
            PG8_BAR; PG8_WAIT_L(0); PG8_MMA(1, 0, At, B0); PG8_BAR; PG8_SCHED;
            PG8_STAGE(PG8_SB(0, 1), b2 + hstepB, voffB);
            PG8_WAIT_V(6); PG8_BAR; PG8_MMA(1, 1, At, B1); PG8_BAR;
            PG8_LDB(B0, 1, 0); PG8_SCHED; PG8_LDA(At, 1, 0); PG8_STAGE(PG8_SA(0, 1), a2 + hstepA, voffA);
            PG8_WAIT_L(8); PG8_BAR; PG8_WAIT_L(0); PG8_MMA(0, 0, At, B0); PG8_BAR; PG8_SCHED;
            PG8_LDB(B1, 1, 1); PG8_STAGE(PG8_SB(1, 0), b3, voffB);
            PG8_BAR; PG8_WAIT_L(0); PG8_MMA(0, 1, At, B1); PG8_BAR;
            PG8_LDA(At, 1, 1); PG8_STAGE(PG8_SA(1, 0), a3, voffA);
            PG8_BAR; PG8_WAIT_L(0); PG8_MMA(1, 0, At, B0); PG8_BAR; PG8_SCHED;
            PG8_STAGE(PG8_SB(1, 1), b3 + hstepB, voffB);
            PG8_WAIT_V(6); PG8_BAR; PG8_MMA(1, 1, At, B1); PG8_BAR;
        }
        bool do_epi = true;
        if (cur.piece >= 0) {
            LAUNDER_Z();
            const int t3 = tid_l(); const int w3 = __builtin_amdgcn_readfirstlane(t3 >> 6), l3 = t3 & 63;
            const size_t pstride = (size_t)8 * 32 * 64;
            f32x4* slab = (f32x4*)(P.ws + zz + WS_UA) + ((size_t)(cur.tu * d.split) * 8 + w3) * 32 * 64 + l3;
            {   f32x4* mine = slab + (size_t)cur.piece * pstride;
#pragma unroll
                for (int idx = 0; idx < 32; ++idx) { asm volatile("global_store_dwordx4 %0, %1, off sc1\n\ts_nop 1" :: "v"(mine), "v"(acc[idx >> 4][(idx >> 3) & 1][(idx >> 1) & 3][idx & 1]) : "memory"); mine += 64; } }
            asm volatile("s_waitcnt vmcnt(0)" ::: "memory");
            unsigned old = 0u;
            if (l3 == 0) old = __hip_atomic_fetch_add((unsigned*)(P.ws + zz) + 8192 + cur.tu * 8 + w3, 1u, __ATOMIC_RELAXED, __HIP_MEMORY_SCOPE_AGENT);
            old = (unsigned)__builtin_amdgcn_readfirstlane((int)old);
            do_epi = ((old % (unsigned)d.split) == (unsigned)d.split - 1u);
            if (do_epi) {
                __builtin_amdgcn_fence(__ATOMIC_ACQUIRE, "agent");
                asm volatile("s_waitcnt vmcnt(0)" ::: "memory");
                const f32x4* p = slab;
#pragma unroll
                for (int i4 = 0; i4 < 8; ++i4) { f32x4 t4[4][4];
#pragma unroll
                    for (int j = 0; j < 4; ++j) { asm volatile("" : "+v"(p));
#pragma unroll
                        for (int q = 0; q < 4; ++q) t4[j][q] = p[(size_t)q * pstride];
                        p += 64; }
#pragma unroll
                    for (int j = 0; j < 4; ++j) { const int idx = i4 * 4 + j; acc[idx >> 4][(idx >> 3) & 1][(idx >> 1) & 3][idx & 1] = ((t4[j][0] + t4[j][1]) + t4[j][2]) + t4[j][3]; } }
            }
        }
        if (do_epi) gemm_epilogue(P, d, acc, cur, wr, wc, fr, fq);
        if (!has_next) break;
#pragma unroll
        for (int a = 0; a < 2; ++a)
#pragma unroll
            for (int b = 0; b < 2; ++b)
#pragma unroll
                for (int m = 0; m < 4; ++m)
#pragma unroll
                    for (int n = 0; n < 2; ++n) acc[a][b][m][n] = (f32x4){0.f, 0.f, 0.f, 0.f};
        cur = nxt; cA = nA; cB = nB; ++ui;
    }
    PG8_WAIT_V(0);
    if (wr == 0) PG8_BAR;
    PG8_BAR;
#undef PG8_SA
#undef PG8_SB
#undef PG8_STAGE
#undef PG8_LDA
#undef PG8_LDB
#undef PG8_MMA
#undef PG8_WAIT_V
#undef PG8_WAIT_L
#undef PG8_BAR
#undef PG8_SCHED
}

__device__ __forceinline__ void transpose_item(const float* W, int K, int N, bf16_t* WT, int ldw, LAS float* scr, int item, int lane, const float* gsc, int rowmap = 0) {
    const int nblk = N / 32, kb = item / nblk, nb = item % nblk, k0 = 64 * kb, n0 = 32 * nb;
    float wv[32];
#pragma unroll
    for (int i = 0; i < 32; ++i) { const int kk = 2 * i + (lane >> 5); wv[i] = W[(size_t)(k0 + kk) * N + n0 + (lane & 31)]; }
#pragma unroll
    for (int i = 0; i < 32; ++i) { const int kk = 2 * i + (lane >> 5); const float gg = gsc ? gsc[k0 + kk] : 1.0f; scr[kk * 33 + (lane & 31)] = wv[i] * gg; }
    asm volatile("s_waitcnt lgkmcnt(0)" ::: "memory");
    const int c = lane & 7;
#pragma unroll
    for (int j = 0; j < 4; ++j) { const int n = (lane >> 3) + 8 * j; const LAS float* s = scr + (8 * c) * 33 + n;
        u32x4 o; o.x = cvt_pk_bf16(s[0 * 33], s[1 * 33]); o.y = cvt_pk_bf16(s[2 * 33], s[3 * 33]); o.z = cvt_pk_bf16(s[4 * 33], s[5 * 33]); o.w = cvt_pk_bf16(s[6 * 33], s[7 * 33]);
        const int nr = n0 + n; const int dr = rowmap ? ((nr >> 7) * 256 + (nr & 127) + (rowmap == 2 ? 128 : 0)) : nr;
        *(u32x4*)(WT + (size_t)dr * ldw + k0 + 8 * c) = o; }
    asm volatile("s_waitcnt lgkmcnt(0)" ::: "memory");
}

__device__ __forceinline__ void norm_row_bf16(const float* hrow, const float* g, bf16_t* orow, int lane, bool pad) {
    u32x2* o8 = (u32x2*)orow + lane;
    if (pad) {
#pragma unroll
        for (int j = 0; j < 8; ++j) o8[64 * j] = (u32x2){0u, 0u};
        return; }
    const f32x4* xr = (const f32x4*)hrow + lane; const f32x4* gr = (const f32x4*)g + lane;
    f32x4 v[8]; float s = 0.f;
#pragma unroll
    for (int j = 0; j < 8; ++j) { v[j] = xr[64 * j]; s += (v[j][0] * v[j][0] + v[j][1] * v[j][1]) + (v[j][2] * v[j][2] + v[j][3] * v[j][3]); }
    const float rs = __builtin_amdgcn_rsqf(wave_sum(s, lane) * (1.0f / DM) + EPSN);
#pragma unroll
    for (int j = 0; j < 8; ++j) { const f32x4 gg = gr[64 * j]; u32x2 w; w.x = cvt_pk_bf16(v[j][0] * rs * gg[0], v[j][1] * rs * gg[1]); w.y = cvt_pk_bf16(v[j][2] * rs * gg[2], v[j][3] * rs * gg[3]); o8[64 * j] = w; }
}

__device__ __forceinline__ void zero_rows16(void* p, int n16, int gt, int NGT) { unsigned z0 = 0u; asm volatile("" : "+v"(z0)); u32x4* z = (u32x4*)p; for (int i = gt; i < n16; i += NGT) z[i] = (u32x4){z0, z0, z0, z0}; }
__device__ __forceinline__ void phase_init_rows(const Params& P) {
    LAUNDER_Z();
    const int lane = tid_l() & 63, gw = bid_l() * 8 + (tid_l() >> 6), NGW = gridDim.x * 8;
    float* H = (float*)(P.ws + zz + WS_H); bf16_t* HN = (bf16_t*)(P.ws + zz + WS_HN); u64* SS = (u64*)(P.ws + zz + WS_SS);
    float zf = 0.f; asm volatile("" : "+v"(zf));
    for (int r = gw; r < MP; r += NGW) {
        const int b = r / LP, pos = r - b * LP; f32x4* o = (f32x4*)(H + (size_t)r * DM) + lane; u32x2* o8 = (u32x2*)(HN + (size_t)r * LDH) + lane;
        if (pos < PADF) {
#pragma unroll
            for (int j = 0; j < 8; ++j) { o[64 * j] = (f32x4){zf, zf, zf, zf}; o8[64 * j] = (u32x2){__float_as_uint(zf), __float_as_uint(zf)}; }
            if (lane == 0) SS[r] = (u64)__float_as_uint(zf);
        } else {
            const float* src = pos < 64 ? PIN(1) + (size_t)(pos - PADF) * DM : PIN(0) + ((size_t)b * 2048 + (pos - 64)) * DM;
            const f32x4* s4 = (const f32x4*)src + lane; float sq = 0.f;
#pragma unroll
            for (int j = 0; j < 8; ++j) { const f32x4 v = s4[64 * j]; o[64 * j] = v; u32x2 w; w.x = cvt_pk_bf16(v[0], v[1]); w.y = cvt_pk_bf16(v[2], v[3]); o8[64 * j] = w; sq += (v[0] * v[0] + v[1] * v[1]) + (v[2] * v[2] + v[3] * v[3]); }
            sq = wave_sum(sq, lane); if (lane == 0) SS[r] = (u64)(sq * SSCALE);
        }
    }
    const int gt = bid_l() * 512 + tid_l(), NGT = gridDim.x * 512;
    for (int i = gt; i < 8 * MP; i += NGT) SS[MP + i] = (u64)__float_as_uint(zf);
    zero_rows16((bf16_t*)(P.ws + zz + WS_HN) - LDH, LDH / 8, gt, NGT); zero_rows16((bf16_t*)(P.ws + zz + WS_HN) + (size_t)MP * LDH, 256 * LDH / 8, gt, NGT);
    zero_rows16((bf16_t*)(P.ws + zz + WS_WSET + WO_WIN) + (size_t)DIN * LDH, (DINP - DIN) * LDH / 8, gt, NGT);
    zero_rows16((bf16_t*)((unsigned char*)P.out + zz + WO_WIN) + (size_t)DIN * LDH, (DINP - DIN) * LDH / 8, gt, NGT);
}

__device__ __forceinline__ void s5_precompute(const Params& P, LAS unsigned char* lds, int l, int g) {
    LAS float* lpr = (LAS float*)lds;
    LAS float* lpi = lpr + 2 * 17 * 64;
    LAS float* bbr = lpi + 2 * 17 * 64;
    LAS float* bbi = bbr + 2048;
    LAS float* ccr = bbi + 2048;
    LAS float* cci = ccr + 2048;
    LAS float* zr = cci + 2048;
    LAS float* zi = zr + 128;
    LAS float* kd = zi + 128;
    LAUNDER_Z();
    const int tid = tid_l();
    if (tid < 128) {
        const int dir = tid >> 6, p = tid & 63; const size_t o = ((size_t)(l * 2 + dir) * 64 + g) * 64 + p;
        const float are = fminf(PIN(4)[o], -1e-4f), aim = PIN(5)[o], dt = expf(PIN(6)[(size_t)(l * 2 + dir) * 64 + g]);
        const float mag = expf(are * dt); float sn, cs; sincosf(aim * dt, &sn, &cs); const float lr = mag * cs, li = mag * sn;
        { float pr = 1.0f, pi = 0.0f;
          for (int dd = 0; dd <= 16; ++dd) { lpr[(dir * 17 + dd) * 64 + p] = pr; lpi[(dir * 17 + dd) * 64 + p] = pi; const float nr = pr * lr - pi * li, ni = pr * li + pi * lr; pr = nr; pi = ni; } }
        { float* t16 = (float*)(P.ws + zz + 524288) + (((size_t)l * 64 + g) * 2 + dir) * 128; t16[p] = lpr[(dir * 17 + 16) * 64 + p]; t16[64 + p] = lpi[(dir * 17 + 16) * 64 + p]; }
        const float den = are * are + aim * aim, pp = lr - 1.0f;
        zr[dir * 64 + p] = (pp * are + li * aim) / den; zi[dir * 64 + p] = (li * are - pp * aim) / den;
    }
    __syncthreads();
    for (int e = tid; e < 2048; e += 512) { const int dir = e >> 10, p = (e >> 4) & 63, h = e & 15; const size_t o = (((size_t)(l * 2 + dir) * 64 + g) * 64 + p) * 16 + h;
        const float br = PIN(7)[o], bi = PIN(8)[o], z_r = zr[dir * 64 + p], z_i = zi[dir * 64 + p];
        bbr[e] = z_r * br - z_i * bi; bbi[e] = z_r * bi + z_i * br; }
    for (int e = tid; e < 2048; e += 512) { const int dir = e >> 10, h = (e >> 6) & 15, p = e & 63; const size_t o = (((size_t)(l * 2 + dir) * 64 + g) * 16 + h) * 64 + p;
        ccr[e] = PIN(9)[o]; cci[e] = PIN(10)[o]; }
    __syncthreads();
    for (int e = tid; e < 8192; e += 512) { const int dir = e >> 12, dd = (e >> 8) & 15, h = (e >> 4) & 15, h2 = e & 15; float s = 0.f;
        for (int p = 0; p < 64; ++p) { const float cr = ccr[(dir * 16 + h) * 64 + p], ci = cci[(dir * 16 + h) * 64 + p], lr = lpr[(dir * 17 + dd) * 64 + p], li = lpi[(dir * 17 + dd) * 64 + p];
            const float ur = cr * lr - ci * li, ui = cr * li + ci * lr; s += ur * bbr[(dir * 64 + p) * 16 + h2] - ui * bbi[(dir * 64 + p) * 16 + h2]; }
        kd[e] = s; }
    __syncthreads();
    bf16_t* WST = (bf16_t*)(P.ws + zz + WS_WST) + ((size_t)l * 64 + g) * (256 * LDWS);
    for (int e8 = tid; e8 < 8192; e8 += 512) { const int n = e8 >> 5, k0 = (e8 & 31) * 8; const int part = n >> 6, p = n & 63, dir = part >> 1; float v[8];
#pragma unroll
        for (int j = 0; j < 8; ++j) { const int k = k0 + j, s = k >> 4, h2 = k & 15, pw = dir == 0 ? 15 - s : s; const float lr = lpr[(dir * 17 + pw) * 64 + p], li = lpi[(dir * 17 + pw) * 64 + p], br = bbr[(dir * 64 + p) * 16 + h2], bi = bbi[(dir * 64 + p) * 16 + h2];
            v[j] = (part & 1) ? (lr * bi + li * br) : (lr * br - li * bi); }
        u32x4 o; o.x = cvt_pk_bf16(v[0], v[1]); o.y = cvt_pk_bf16(v[2], v[3]); o.z = cvt_pk_bf16(v[4], v[5]); o.w = cvt_pk_bf16(v[6], v[7]);
        *(u32x4*)(WST + (size_t)n * LDWS + k0) = o; }
    bf16_t* TO = (bf16_t*)(P.ws + zz + WS_TO) + ((size_t)l * 64 + g) * (256 * LDTO);
    const float* dsk = PIN(11) + ((size_t)l * 64 + g) * 16;
    for (int e8 = tid; e8 < 16384; e8 += 512) { const int n = e8 >> 6, k0 = (e8 & 63) * 8; const int t = n >> 4, h = n & 15; float v[8];
#pragma unroll
        for (int j = 0; j < 8; ++j) { const int k = k0 + j;
            if (k < 256) { const int s = k >> 4, h2 = k & 15;
                if (t > s) v[j] = kd[((0 * 16 + (t - s)) * 16 + h) * 16 + h2];
                else if (t < s) v[j] = kd[((1 * 16 + (s - t)) * 16 + h) * 16 + h2];
                else v[j] = kd[((0 * 16 + 0) * 16 + h) * 16 + h2] + kd[((1 * 16 + 0) * 16 + h) * 16 + h2] + (h == h2 ? dsk[h] : 0.f);
            } else { const int kk = k - 256, part = kk >> 6, p = kk & 63, dir = part >> 1, pw = dir == 0 ? t + 1 : 16 - t;
                const float cr = ccr[(dir * 16 + h) * 64 + p], ci = cci[(dir * 16 + h) * 64 + p], lr = lpr[(dir * 17 + pw) * 64 + p], li = lpi[(dir * 17 + pw) * 64 + p];
                v[j] = (part & 1) ? -(cr * li + ci * lr) : (cr * lr - ci * li); } }
        u32x4 o; o.x = cvt_pk_bf16(v[0], v[1]); o.y = cvt_pk_bf16(v[2], v[3]); o.z = cvt_pk_bf16(v[4], v[5]); o.w = cvt_pk_bf16(v[6], v[7]);
        *(u32x4*)(TO + (size_t)n * LDTO + k0) = o; }
    __syncthreads();
}

__device__ __forceinline__ unsigned char* wset_base(const Params& P, int l, int zz) { return (l & 1) ? (unsigned char*)P.out + zz : P.ws + zz + WS_WSET; }
__device__ __forceinline__ void convert_weights(const Params& P, LAS unsigned char* lds, int l, int gw, int NGW, int wave, int lane, int it_lo = 0, int it_hi = 1 << 30) {
    LAUNDER_Z();
    unsigned char* wb = wset_base(P, l, zz);
    LAS float* scr = (LAS float*)(lds + wave * 16384);
    constexpr int I_IN = 32 * 129, I_GLU = 16 * 32, I_OUT = 32 * 64, I_G = 32 * 176, I_DN = 88 * 64, NIT = I_IN + I_GLU + I_OUT + 2 * I_G + I_DN;
    const int ihi = it_hi < NIT ? it_hi : NIT;
    for (int it = it_lo + gw; it < ihi; it += NGW) { int r = it;
        if (r < I_IN) { transpose_item(PIN(3) + (size_t)l * DM * DIN, DM, DIN, (bf16_t*)(wb + WO_WIN), LDH, scr, r, lane, PIN(2) + (size_t)l * DM); continue; } r -= I_IN;
        if (r < I_GLU) { transpose_item(PIN(12) + (size_t)l * 1024 * 1024, 1024, 1024, (bf16_t*)(wb + WO_WGLU), LDG, scr, r, lane, nullptr); continue; } r -= I_GLU;
        if (r < I_OUT) { transpose_item(PIN(19) + (size_t)l * DM * DM, DM, DM, (bf16_t*)(wb + WO_WOUT), LDH, scr, r, lane, nullptr); continue; } r -= I_OUT;
        if (r < I_G) { transpose_item(PIN(21) + (size_t)l * DM * DFF, DM, DFF, (bf16_t*)(wb + WO_WGU), LDH, scr, r, lane, PIN(20) + (size_t)l * DM, 1); continue; } r -= I_G;
        if (r < I_G) { transpose_item(PIN(22) + (size_t)l * DM * DFF, DM, DFF, (bf16_t*)(wb + WO_WGU), LDH, scr, r, lane, PIN(20) + (size_t)l * DM, 2); continue; } r -= I_G;
        transpose_item(PIN(25) + (size_t)l * DFF * DM, DFF, DM, (bf16_t*)(wb + WO_WDN), LDF, scr, r, lane, nullptr);
    }
}

__device__ __forceinline__ void phase_s5_scan(const Params& P, int l, int bofs) {
    LAUNDER_Z();
    const int t = tid_l(); if (t >= 128) return;
    const int idx = (bid_l() - bofs) * 128 + t; if (idx >= 16384 || idx < 0) return;
    const int p4 = idx & 15, dir = (idx >> 4) & 1, b = (idx >> 5) & 7, g = idx >> 8;
    const float* t16 = (const float*)(P.ws + zz + 524288) + (((size_t)l * 64 + g) * 2 + dir) * 128 + 4 * p4;
    const f32x4 Lr = *(const f32x4*)t16, Li = *(const f32x4*)(t16 + 64);
    const f32x4* sl = (const f32x4*)((const float*)(P.ws + zz + WS_SLOC) + ((size_t)g * S5ROWP + b * NCH) * 256 + dir * 128 + 4 * p4);
    bf16_t* so = (bf16_t*)(P.ws + zz + WS_UA) + ((size_t)g * S5ROWP + b * NCH) * LDU + 256 + dir * 128 + 4 * p4;
    f32x4 sr = (f32x4){0.f, 0.f, 0.f, 0.f}, si = (f32x4){0.f, 0.f, 0.f, 0.f};
    for (int blk = 0; blk < 11; ++blk) {
        f32x4 xr[12], xi[12];
#pragma unroll
        for (int j = 0; j < 12; ++j) { const int i = blk * 12 + j, n = dir == 0 ? i : NCH - 1 - i; xr[j] = sl[(size_t)n * 64]; xi[j] = sl[(size_t)n * 64 + 16]; }
#pragma unroll
        for (int j = 0; j < 12; ++j) { const int i = blk * 12 + j, n = dir == 0 ? i : NCH - 1 - i;
            u32x2 wr_, wi_; wr_.x = cvt_pk_bf16(sr[0], sr[1]); wr_.y = cvt_pk_bf16(sr[2], sr[3]); wi_.x = cvt_pk_bf16(si[0], si[1]); wi_.y = cvt_pk_bf16(si[2], si[3]);
            *(u32x2*)(so + (size_t)n * LDU) = wr_; *(u32x2*)(so + (size_t)n * LDU + 64) = wi_;
            const f32x4 nr = Lr * sr - Li * si + xr[j], ni = Lr * si + Li * sr + xi[j]; sr = nr; si = ni; }
    }
}

constexpr int MLS = 72;
__device__ __forceinline__ f32x4 mma_tile(const LAS bf16_t* A, const LAS bf16_t* Bt, int fr, int fq, f32x4 acc) {
#pragma unroll
    for (int kk = 0; kk < 2; ++kk) { const bf16x8 a = *(const LAS bf16x8*)(A + fr * MLS + kk * 32 + fq * 8); const bf16x8 b = *(const LAS bf16x8*)(Bt + fr * MLS + kk * 32 + fq * 8);
        acc = __builtin_amdgcn_mfma_f32_16x16x32_bf16(a, b, acc, 0, 0, 0); }
    return acc;
}
__device__ __forceinline__ void phase_mlstm(const Params& P, LAS unsigned char* lds, int l) {
    LAUNDER_Z();
    const int tid = tid_l(), lane = tid & 63, w = tid >> 6, fr = lane & 15, fq = lane >> 4; unsigned char* ws = P.ws + zz;
    LAS bf16_t* Qs = (LAS bf16_t*)lds;
    LAS bf16_t* Ks = Qs + 64 * MLS;
    LAS bf16_t* Kw = Ks + 64 * MLS;
    LAS bf16_t* Ss = Kw + 64 * MLS;
    LAS bf16_t* Vt = Ss + 64 * MLS;
    LAS bf16_t* Ct = Vt + 160 * MLS;
    LAS float* den = (LAS float*)(Ct + 160 * MLS);
    LAS float* CW = den + 64;
    const bf16_t* Z = (const bf16_t*)(ws + WS_Z); const float* Gt = (const float*)(ws + WS_G);
    const int nmb = gridDim.x >= 256 ? 128 : gridDim.x;
    if (bid_l() >= nmb) return;
    for (int item = bid_l(); item < 128; item += nmb) {
        const int dir = item & 1, hd = (item >> 1) & 7, b = item >> 4;
        __syncthreads();
        for (int e = tid; e < 160 * MLS; e += 512) Ct[e] = 0;
        for (int e = tid; e < 32 * MLS; e += 512) Vt[128 * MLS + e] = (e < 64) ? (bf16_t)0x3F80 : (bf16_t)0;
        f32x4 Cst[5];
#pragma unroll
        for (int j = 0; j < 5; ++j) Cst[j] = (f32x4){0.f, 0.f, 0.f, 0.f};
        float m_prev = -1e30f;
        const float gb_i = PIN(17)[l * 32 + (2 * dir) * 8 + hd], gb_f = PIN(17)[l * 32 + (2 * dir + 1) * 8 + hd];
        bf16_t* Hout = (bf16_t*)(ws + WS_HFB) + (size_t)dir * MP * 1024;
        for (int e = tid; e < 512; e += 512) { const int rr = e >> 7, c = e & 127; const int colz = (c < 64 ? hd * 64 + c : 512 + hd * 64 + (c - 64));
            CW[e] = rr < 3 ? PIN(15)[(size_t)l * 3 * 1024 + rr * 1024 + colz] : PIN(16)[(size_t)l * 1024 + colz]; }
        const int wu = __builtin_amdgcn_readfirstlane(w);
        const int colz = (wu < 4 ? hd * 64 + wu * 16 : 512 + hd * 64 + (wu - 4) * 16);
        const int myoff = dir == 0 ? lane : 63 - lane;
        const int gcol_i = (2 * dir) * 8 + hd, gcol_f = (2 * dir + 1) * 8 + hd;
        u32x4 pz[8]; float pg_i, pg_f;
#define ML_PREFETCH(cx) do { const int n_ = dir == 0 ? (cx) : 32 - (cx); const size_t r_ = (size_t)(b * LP + n_ * 64 + myoff); \
            const bf16_t* zp_ = Z + r_ * 3072 + colz; const bf16_t* vp_ = Z + r_ * 3072 + 1024 + hd * 128 + wu * 16; \
            pz[0] = *(const u32x4*)(zp_ - 3072); pz[1] = *(const u32x4*)(zp_ - 3072 + 8); pz[2] = *(const u32x4*)(zp_); pz[3] = *(const u32x4*)(zp_ + 8); \
            pz[4] = *(const u32x4*)(zp_ + 3072); pz[5] = *(const u32x4*)(zp_ + 3072 + 8); pz[6] = *(const u32x4*)(vp_); pz[7] = *(const u32x4*)(vp_ + 8); \
            pg_i = Gt[r_ * 32 + gcol_i]; pg_f = Gt[r_ * 32 + gcol_f]; } while (0)
        ML_PREFETCH(0);
        __syncthreads();
        for (int cix = 0; cix < 33; ++cix) {
            const int n = dir == 0 ? cix : 32 - cix;
            const int rowbase = b * LP + n * 64;
            u32x4 cz[8];
#pragma unroll
            for (int j = 0; j < 8; ++j) cz[j] = pz[j];
            const float cg_i = pg_i, cg_f = pg_f;
            if (cix + 1 < 33) ML_PREFETCH(cix + 1);
            const bool mypad = (n * 64 + myoff) < PADF;
            float li = cg_i + gb_i;
            const float xf = cg_f + gb_f;
            float lf = fminf(xf, 0.f) - __logf(1.0f + __expf(-fabsf(xf)));
            if (mypad) { li = -1e30f; lf = 0.f; }
            const float bc = wave_incl_sum(lf, lane);
            const float gsum = rdlane(bc, 63);
            const float m_loc = rdlane(wave_incl_max(gsum - bc + li, lane), 63);
            const float wloc = __expf(gsum - bc + li - m_loc);
            const float cv = li - bc;
            const float pm = wave_incl_max(cv, lane);
            const float Mt = fmaxf(m_prev, pm);
            const float sint = __expf(m_prev - Mt);
            const float einv = __expf(-(bc + Mt));
            const float m_new = fmaxf(gsum + m_prev, m_loc);
            const float s_old = __expf(gsum + m_prev - m_new), s_loc = __expf(m_loc - m_new);
            {
                const int i = lane; const bool pad = mypad;
                const unsigned um[8] = {cz[0].x, cz[0].y, cz[0].z, cz[0].w, cz[1].x, cz[1].y, cz[1].z, cz[1].w};
                const unsigned u0[8] = {cz[2].x, cz[2].y, cz[2].z, cz[2].w, cz[3].x, cz[3].y, cz[3].z, cz[3].w};
                const unsigned up[8] = {cz[4].x, cz[4].y, cz[4].z, cz[4].w, cz[5].x, cz[5].y, cz[5].z, cz[5].w};
                float qv[16];
#pragma unroll
                for (int j4 = 0; j4 < 4; ++j4) {
                    const f32x4 w0 = *(const LAS f32x4*)(CW + 0 * 128 + wu * 16 + j4 * 4), w1 = *(const LAS f32x4*)(CW + 1 * 128 + wu * 16 + j4 * 4), w2 = *(const LAS f32x4*)(CW + 2 * 128 + wu * 16 + j4 * 4), bb = *(const LAS f32x4*)(CW + 3 * 128 + wu * 16 + j4 * 4);
#pragma unroll
                    for (int jj = 0; jj < 2; ++jj) { const int j = j4 * 2 + jj;
                        const float x0 = bb[2 * jj] + w0[2 * jj] * bf_lo(um[j]) + w1[2 * jj] * bf_lo(u0[j]) + w2[2 * jj] * bf_lo(up[j]);
                        const float x1 = bb[2 * jj + 1] + w0[2 * jj + 1] * bf_hi(um[j]) + w1[2 * jj + 1] * bf_hi(u0[j]) + w2[2 * jj + 1] * bf_hi(up[j]);
                        qv[2 * j] = pad ? 0.f : siluf_(x0); qv[2 * j + 1] = pad ? 0.f : siluf_(x1); } }
                if (wu < 4) {
                    u32x4 o0, o1; o0.x = cvt_pk_bf16(qv[0] * 0.125f, qv[1] * 0.125f); o0.y = cvt_pk_bf16(qv[2] * 0.125f, qv[3] * 0.125f); o0.z = cvt_pk_bf16(qv[4] * 0.125f, qv[5] * 0.125f); o0.w = cvt_pk_bf16(qv[6] * 0.125f, qv[7] * 0.125f);
                    o1.x = cvt_pk_bf16(qv[8] * 0.125f, qv[9] * 0.125f); o1.y = cvt_pk_bf16(qv[10] * 0.125f, qv[11] * 0.125f); o1.z = cvt_pk_bf16(qv[12] * 0.125f, qv[13] * 0.125f); o1.w = cvt_pk_bf16(qv[14] * 0.125f, qv[15] * 0.125f);
                    *(LAS u32x4*)(Qs + i * MLS + wu * 16) = o0; *(LAS u32x4*)(Qs + i * MLS + wu * 16 + 8) = o1;
                } else {
                    const int d0 = (wu - 4) * 16;
                    u32x4 o0, o1; o0.x = cvt_pk_bf16(qv[0], qv[1]); o0.y = cvt_pk_bf16(qv[2], qv[3]); o0.z = cvt_pk_bf16(qv[4], qv[5]); o0.w = cvt_pk_bf16(qv[6], qv[7]);
                    o1.x = cvt_pk_bf16(qv[8], qv[9]); o1.y = cvt_pk_bf16(qv[10], qv[11]); o1.z = cvt_pk_bf16(qv[12], qv[13]); o1.w = cvt_pk_bf16(qv[14], qv[15]);
                    *(LAS u32x4*)(Ks + i * MLS + d0) = o0; *(LAS u32x4*)(Ks + i * MLS + d0 + 8) = o1;
#pragma unroll
                    for (int j = 0; j < 16; ++j) Kw[(d0 + j) * MLS + i] = f2bf(qv[j] * wloc);
                }
                const unsigned uv[8] = {cz[6].x, cz[6].y, cz[6].z, cz[6].w, cz[7].x, cz[7].y, cz[7].z, cz[7].w};
#pragma unroll
                for (int j = 0; j < 8; ++j) { Vt[(wu * 16 + 2 * j) * MLS + i] = pad ? (bf16_t)0 : (bf16_t)(uv[j] & 0xffffu); Vt[(wu * 16 + 2 * j + 1) * MLS + i] = pad ? (bf16_t)0 : (bf16_t)(uv[j] >> 16); }
            }
            __syncthreads();
            {
                const int st = w & 3;
#pragma unroll
                for (int jj = 0; jj < 2; ++jj) { const int tt = (w >> 2) * 2 + jj;
                    f32x4 a = (f32x4){0.f, 0.f, 0.f, 0.f};
                    a = mma_tile(Ks + st * 16 * MLS, Qs + tt * 16 * MLS, fr, fq, a);
                    const int t = tt * 16 + fr, s0 = st * 16 + 4 * fq; const float Mtt = shi(Mt, t);
                    f32x4 o;
#pragma unroll
                    for (int j = 0; j < 4; ++j) { const float cs = shi(cv, s0 + j); o[j] = (s0 + j <= t) ? a[j] * __expf(cs - Mtt) : 0.f; }
                    u32x2 pk; pk.x = cvt_pk_bf16(o[0], o[1]); pk.y = cvt_pk_bf16(o[2], o[3]);
                    *(LAS u32x2*)(Ss + t * MLS + s0) = pk; }
            }
            __syncthreads();
            f32x4 num[5];
            const int tt = w & 3, tC = tt * 16 + fr; const float sint_t = shi(sint, tC), einv_t = shi(einv, tC);
#pragma unroll
            for (int j = 0; j < 5; ++j) { const int dvt = (w >> 2) * 5 + j;
                f32x4 a1 = (f32x4){0.f, 0.f, 0.f, 0.f}, a2 = (f32x4){0.f, 0.f, 0.f, 0.f};
                a1 = mma_tile(Vt + dvt * 16 * MLS, Ss + tt * 16 * MLS, fr, fq, a1);
                a2 = mma_tile(Ct + dvt * 16 * MLS, Qs + tt * 16 * MLS, fr, fq, a2);
                num[j] = a1 + a2 * sint_t;
                if (dvt == 8 && fq == 0) den[tC] = num[j][0]; }
            __syncthreads();
            {
                const float dn = den[tC]; const float inv = __builtin_amdgcn_rcpf(fmaxf(fabsf(dn), einv_t));
                const int off = dir == 0 ? tC : 63 - tC; const size_t r = (size_t)rowbase + off;
#pragma unroll
                for (int j = 0; j < 5; ++j) { const int dvt = (w >> 2) * 5 + j;
                    if (dvt < 8) store_bf4(Hout + r * 1024 + hd * 128 + dvt * 16 + 4 * fq, num[j] * inv); }
            }
            {
                const int dkt = w & 3;
#pragma unroll
                for (int j = 0; j < 5; ++j) { const int dvt = (w >> 2) * 5 + j;
                    f32x4 a = (f32x4){0.f, 0.f, 0.f, 0.f};
                    a = mma_tile(Kw + dkt * 16 * MLS, Vt + dvt * 16 * MLS, fr, fq, a);
                    Cst[j] = Cst[j] * s_old + a * s_loc;
                    u32x2 pk; pk.x = cvt_pk_bf16(Cst[j][0], Cst[j][1]); pk.y = cvt_pk_bf16(Cst[j][2], Cst[j][3]);
                    *(LAS u32x2*)(Ct + (dvt * 16 + fr) * MLS + dkt * 16 + 4 * fq) = pk; }
            }
            m_prev = m_new;
            __syncthreads();
        }
    }
}

__device__ __forceinline__ void phase_finalize(const Params& P, int l) {
    LAUNDER_Z();
    const int tid = tid_l(), lane = tid & 63, gw = bid_l() * 8 + (tid >> 6), NGW = gridDim.x * 8; unsigned char* ws = P.ws + zz;
    const bf16_t* YG = (const bf16_t*)(ws + WS_YGLU); const bf16_t* HF = (const bf16_t*)(ws + WS_HFB); const bf16_t* HB = HF + (size_t)MP * 1024;
    const bf16_t* Z = (const bf16_t*)(ws + WS_Z); bf16_t* Y = (bf16_t*)(ws + WS_Y);
    float g1[16], g2[16];
    { const f32x4* p1 = (const f32x4*)(PIN(14) + (size_t)l * 1024 + lane * 16); const f32x4* p2 = (const f32x4*)(PIN(18) + (size_t)l * 1024 + lane * 16);
#pragma unroll
      for (int j = 0; j < 4; ++j) { const f32x4 a = p1[j], b = p2[j]; g1[4 * j] = a[0]; g1[4 * j + 1] = a[1]; g1[4 * j + 2] = a[2]; g1[4 * j + 3] = a[3]; g2[4 * j] = b[0]; g2[4 * j + 1] = b[1]; g2[4 * j + 2] = b[2]; g2[4 * j + 3] = b[3]; } }
    for (int r = gw; r < MP; r += NGW) {
        u32x4* yo = (u32x4*)(Y + (size_t)r * LDH);
        if ((r % LP) < PADF) { unsigned z0 = 0u; asm volatile("" : "+v"(z0)); for (int j = 0; j < 4; ++j) yo[lane + 64 * j] = (u32x4){z0, z0, z0, z0}; continue; }
        const size_t o = (size_t)r * 1024 + lane * 16;
        const u32x4 f0 = *(const u32x4*)(HF + o), f1 = *(const u32x4*)(HF + o + 8), b0 = *(const u32x4*)(HB + o), b1 = *(const u32x4*)(HB + o + 8);
        const u32x4 q0 = *(const u32x4*)(Z + (size_t)r * 3072 + 2048 + lane * 16), q1 = *(const u32x4*)(Z + (size_t)r * 3072 + 2048 + lane * 16 + 8);
        {
            const u32x4 a0 = *(const u32x4*)(YG + (size_t)r * 1024 + lane * 16), a1 = *(const u32x4*)(YG + (size_t)r * 1024 + lane * 16 + 8);
            const unsigned uu[8] = {a0.x, a0.y, a0.z, a0.w, a1.x, a1.y, a1.z, a1.w}; float v[16]; float s = 0.f;
#pragma unroll
            for (int j = 0; j < 8; ++j) { v[2 * j] = bf_lo(uu[j]); v[2 * j + 1] = bf_hi(uu[j]); s += v[2 * j] * v[2 * j] + v[2 * j + 1] * v[2 * j + 1]; }
            const float rs = __builtin_amdgcn_rsqf(wave_sum(s, lane) * (1.0f / 1024.0f) + EPSN);
            const float* g = g1;
            u32x4 o0, o1; o0.x = cvt_pk_bf16(v[0] * rs * g[0], v[1] * rs * g[1]); o0.y = cvt_pk_bf16(v[2] * rs * g[2], v[3] * rs * g[3]); o0.z = cvt_pk_bf16(v[4] * rs * g[4], v[5] * rs * g[5]); o0.w = cvt_pk_bf16(v[6] * rs * g[6], v[7] * rs * g[7]);
            o1.x = cvt_pk_bf16(v[8] * rs * g[8], v[9] * rs * g[9]); o1.y = cvt_pk_bf16(v[10] * rs * g[10], v[11] * rs * g[11]); o1.z = cvt_pk_bf16(v[12] * rs * g[12], v[13] * rs * g[13]); o1.w = cvt_pk_bf16(v[14] * rs * g[14], v[15] * rs * g[15]);
            yo[lane * 2] = o0; yo[lane * 2 + 1] = o1;
        }
        {
            const unsigned uf[8] = {f0.x, f0.y, f0.z, f0.w, f1.x, f1.y, f1.z, f1.w}, ub[8] = {b0.x, b0.y, b0.z, b0.w, b1.x, b1.y, b1.z, b1.w}, uo[8] = {q0.x, q0.y, q0.z, q0.w, q1.x, q1.y, q1.z, q1.w};
            float v[16]; float s = 0.f;
#pragma unroll
            for (int j = 0; j < 8; ++j) { v[2 * j] = bf_lo(uf[j]) + bf_lo(ub[j]); v[2 * j + 1] = bf_hi(uf[j]) + bf_hi(ub[j]); s += v[2 * j] * v[2 * j] + v[2 * j + 1] * v[2 * j + 1]; }
            s += shx(s, 1, lane); s += shx(s, 2, lane); s += shx(s, 4, lane);
            const float rs = __builtin_amdgcn_rsqf(s * (1.0f / 128.0f) + EPSN);
            const float* g = g2;
            float ov[16];
#pragma unroll
            for (int j = 0; j < 8; ++j) { ov[2 * j] = sigmoidf_(bf_lo(uo[j])) * v[2 * j] * rs * g[2 * j]; ov[2 * j + 1] = sigmoidf_(bf_hi(uo[j])) * v[2 * j + 1] * rs * g[2 * j + 1]; }
            u32x4 o0, o1; o0.x = cvt_pk_bf16(ov[0], ov[1]); o0.y = cvt_pk_bf16(ov[2], ov[3]); o0.z = cvt_pk_bf16(ov[4], ov[5]); o0.w = cvt_pk_bf16(ov[6], ov[7]);
            o1.x = cvt_pk_bf16(ov[8], ov[9]); o1.y = cvt_pk_bf16(ov[10], ov[11]); o1.z = cvt_pk_bf16(ov[12], ov[13]); o1.w = cvt_pk_bf16(ov[14], ov[15]);
            yo[128 + lane * 2] = o0; yo[128 + lane * 2 + 1] = o1;
        }
    }
}

__device__ __forceinline__ void phase_final(const Params& P) {
    LAUNDER_Z();
    const int lane = tid_l() & 63, gw = bid_l() * 8 + (tid_l() >> 6), NGW = gridDim.x * 8;
    const float* H = (const float*)(P.ws + zz + WS_H);
    for (int q = gw; q < NB * 2048; q += NGW) {
        const int b = q >> 11, t = q & 2047; const size_t r = (size_t)b * LP + 64 + t;
        const f32x4* xr = (const f32x4*)(H + r * DM) + lane; const f32x4* gr = (const f32x4*)PIN(26) + lane; f32x4* o = (f32x4*)(P.out + zz + (size_t)q * DM) + lane;
        f32x4 v[8]; float s = 0.f;
#pragma unroll
        for (int j = 0; j < 8; ++j) { v[j] = xr[64 * j]; s += (v[j][0] * v[j][0] + v[j][1] * v[j][1]) + (v[j][2] * v[j][2] + v[j][3] * v[j][3]); }
        const float rs = __builtin_amdgcn_rsqf(wave_sum(s, lane) * (1.0f / DM) + EPSN);
#pragma unroll
        for (int j = 0; j < 8; ++j) o[64 * j] = v[j] * rs * gr[64 * j];
    }
}

#define XB_TMO      128
#define XB_XCNT(j)  (256  + 64 * (j))
#define XB_XSUB(j)  (1280 + 64 * (j))
#define XB_XGEN(j)  (2304 + 64 * (j))
#define XB_TOP      3328
#define XB_TOPGEN   3392
#define XCD_BAR_WORDS 3456
#define XB_SPIN_CAP (1u << 22)
__device__ __forceinline__ unsigned xb_ld(unsigned* p)              { return __hip_atomic_load(p, __ATOMIC_RELAXED, __HIP_MEMORY_SCOPE_AGENT); }
__device__ __forceinline__ unsigned xb_add(unsigned* p, unsigned v) { return __hip_atomic_fetch_add(p, v, __ATOMIC_RELAXED, __HIP_MEMORY_SCOPE_AGENT); }
__device__ __forceinline__ unsigned xb_xcc_id() { return (unsigned)__builtin_amdgcn_s_getreg((3 << 11) | 20) & 0xFu; }
#define XB_SPIN(cond, bar) do { unsigned _sp = 0; while (cond) { __builtin_amdgcn_s_sleep(1); \
    if ((++_sp & 255u) == 0u) { if (xb_ld(&(bar)[XB_TMO])) break; if (_sp > XB_SPIN_CAP) { atomicAdd(&(bar)[XB_TMO], 1u); break; } } } } while (0)
__device__ __forceinline__ void xcd_barrier(unsigned* bar, volatile LAS unsigned* st, unsigned G) {
    asm volatile("s_waitcnt vmcnt(0)" ::: "memory");
    __syncthreads();
    if (tid_l() == 0) {
        __builtin_amdgcn_s_waitcnt(0);
        const unsigned x = xb_xcc_id();
        unsigned nloc = st[0], nx = st[1];
        if (nloc == 0u) {
            unsigned sum, cnt, mine, sp = 0u;
            for (;;) {
                sum = 0u; cnt = 0u; mine = 0u;
#pragma unroll
                for (unsigned j = 0; j < 16; ++j) { const unsigned c = xb_ld(&bar[XB_XCNT(j)]); sum += c; cnt += (c > 0u) ? 1u : 0u; mine = (j == x) ? c : mine; }
                if (sum == G) break;
                __builtin_amdgcn_s_sleep(1);
                if ((++sp & 255u) == 0u) { if (xb_ld(&bar[XB_TMO])) break; if (sp > XB_SPIN_CAP) { atomicAdd(&bar[XB_TMO], 1u); break; } }
            }
            nloc = mine > 0u ? mine : 1u; nx = cnt > 0u ? cnt : 1u; st[0] = nloc; st[1] = nx;
        }
        const unsigned old = xb_add(&bar[XB_XSUB(x)], 1u);
        const unsigned gen = old / nloc;
        if (old + 1u == (gen + 1u) * nloc) {
            __builtin_amdgcn_fence(__ATOMIC_RELEASE, "agent");
            asm volatile("s_waitcnt vmcnt(0)" ::: "memory");
            const unsigned og = xb_add(&bar[XB_TOP], 1u);
            const unsigned tg = og / nx;
            if (og + 1u == (tg + 1u) * nx) xb_add(&bar[XB_TOPGEN], 1u);
            else XB_SPIN(xb_ld(&bar[XB_TOPGEN]) == tg, bar);
            __builtin_amdgcn_fence(__ATOMIC_ACQUIRE, "agent");
            xb_add(&bar[XB_XGEN(x)], 1u);
            asm volatile("s_waitcnt vmcnt(0)" ::: "memory");
        } else {
            XB_SPIN(xb_ld(&bar[XB_XGEN(x)]) == gen, bar);
            __builtin_amdgcn_fence(__ATOMIC_ACQUIRE, "agent");
            asm volatile("s_waitcnt vmcnt(0)" ::: "memory");
        }
    }
    __syncthreads();
}

__global__ void __launch_bounds__(512, 2) mk_fwd(Params P) {
    extern __shared__ __attribute__((aligned(16))) unsigned char lds_raw[];
    LAS unsigned char* lds = (LAS unsigned char*)lds_raw;
    cg::grid_group grid = cg::this_grid();
    volatile LAS unsigned* xst = (volatile LAS unsigned*)(lds + 131072);
    if (threadIdx.x < 4) xst[threadIdx.x] = 0u;
    __syncthreads();
    unsigned char* ws = P.ws;
    for (int ph = P.ph_lo; ph < P.ph_hi; ++ph) {
        if (ph == 0) {
            if (bid_l() == 0) { for (int i = tid_l(); i < 8192 + 1024 + XCD_BAR_WORDS; i += 512) ((unsigned*)ws)[i] = 0u; }
            phase_init_rows(P);
            for (int pr = bid_l(); pr < DEPTH * 64; pr += gridDim.x) s5_precompute(P, lds, pr >> 6, pr & 63);
            __syncthreads();
            convert_weights(P, lds, 0, bid_l() * 8 + (tid_l() >> 6), gridDim.x * 8, tid_l() >> 6, tid_l() & 63);
        }
        else if (ph == NPHASES - 1) phase_final(P);
        else {
            const int l = (ph - 1) / NPH_L, k = (ph - 1) % NPH_L;
            GemmDesc d; d.layer = l; d.nB = 1; d.sA = 0; d.sB = 0; d.A = nullptr; d.Bt = nullptr; d.lda = d.ldb = d.K = 256; d.nM = d.nN = 1; d.epi = 0; d.ssi = 0; d.amode = 0; d.split = 0; d.perm = 0; d.ubase = 0; d.umax = 0x7fffffff; d.gG = gridDim.x; d.gc = bid_l(); bool isg = false;
            const unsigned char* wb = (l & 1) ? (const unsigned char*)P.out : ws + WS_WSET;
            switch (k) {
            case 0: { const int gt = bid_l() * 512 + tid_l(), NGT = gridDim.x * 512; zero_rows16((bf16_t*)(ws + WS_Z) - 3072, 384, gt, NGT); zero_rows16((bf16_t*)(ws + WS_Z) + (size_t)MP * 3072, 384, gt, NGT); }
                d.A = (const bf16_t*)(ws + WS_HN); d.Bt = (const bf16_t*)(wb + WO_WIN); d.lda = LDH; d.ldb = LDH; d.K = DM; d.nM = MP / 256; d.nN = DINP / 256; d.epi = EPI_WIN; d.ssi = 2 * l; d.perm = 1; isg = true; break;
            case 1:
                if (bid_l() < 128) phase_mlstm(P, lds, l);
                else {
                    d.gG = gridDim.x - 128; d.gc = bid_l() - 128;
                    d.A = (const bf16_t*)(ws + WS_UA); d.Bt = (const bf16_t*)(ws + WS_WST) + (size_t)l * 64 * (256 * LDWS); d.lda = LDU; d.ldb = LDWS; d.K = 256; d.nM = S5ROWP / 256; d.nN = 1; d.nB = 64; d.sA = (size_t)S5ROWP * LDU; d.sB = 256 * LDWS; d.epi = EPI_S5A;
                    gemm_phase(P, lds, d);
                    xcd_barrier((unsigned*)ws + 8192 + 1024, xst + 2, gridDim.x - 128);
                    phase_s5_scan(P, l, 128);
                    xcd_barrier((unsigned*)ws + 8192 + 1024, xst + 2, gridDim.x - 128);
                    d.Bt = (const bf16_t*)(ws + WS_TO) + (size_t)l * 64 * (256 * LDTO); d.ldb = LDTO; d.K = 512; d.sB = 256 * LDTO; d.epi = EPI_S5C; d.perm = 1;
                    gemm_phase(P, lds, d);
                    xcd_barrier((unsigned*)ws + 8192 + 1024, xst + 2, gridDim.x - 128);
                    d.A = (const bf16_t*)(ws + WS_YGELU); d.Bt = (const bf16_t*)(wb + WO_WGLU); d.lda = LDG; d.ldb = LDG; d.K = 1024; d.nM = MP / 256; d.nN = 4; d.nB = 1; d.sA = 0; d.sB = 0; d.epi = EPI_GLU; d.perm = 1; d.umax = 2 * (gridDim.x - 128); isg = true;
                    if (bid_l() == 128 && tid_l() == 0) __hip_atomic_store((unsigned*)ws + 128, (unsigned)(l + 1), __ATOMIC_RELAXED, __HIP_MEMORY_SCOPE_AGENT);
                }
                break;
            case 2: phase_finalize(P, l); break;
            case 3: d.A = (const bf16_t*)(ws + WS_Y); d.Bt = (const bf16_t*)(wb + WO_WOUT); d.lda = LDH; d.ldb = LDH; d.K = DM; d.nM = MP / 256; d.nN = 8; d.epi = EPI_RES; d.ssi = 2 * l + 1; d.split = 4; d.perm = 1; isg = true; break;
            case 4: d.A = (const bf16_t*)(ws + WS_HN) - LDH; d.Bt = (const bf16_t*)(wb + WO_WGU); d.lda = LDH; d.ldb = LDH; d.K = DM; d.nM = 69; d.nN = 44; d.epi = EPI_FFN; d.ssi = 2 * l + 1; d.amode = 1; d.perm = 1; isg = true; break;
            case 5: d.A = (const bf16_t*)(ws + WS_ACT); d.Bt = (const bf16_t*)(wb + WO_WDN); d.lda = LDF; d.ldb = LDF; d.K = DFF; d.nM = MP / 256; d.nN = 8; d.epi = EPI_RES; d.ssi = 2 * l + 2; d.split = 4; d.perm = 1; isg = true; break;
            }
            if (isg) gemm_phase(P, lds, d);
            if (k == 0 && l + 1 < DEPTH) {
                const int nun = (MP / 256) * (DINP / 256), nbusy = nun - (nun / (int)gridDim.x) * (int)gridDim.x; const int t_ = tid_l(); __syncthreads();
                if (bid_l() >= nbusy) convert_weights(P, lds, l + 1, (bid_l() - nbusy) * 8 + (t_ >> 6), (gridDim.x - nbusy) * 8, t_ >> 6, t_ & 63, 0, CV_SPLIT1);
            }
            if (k == 1 && l + 1 < DEPTH && bid_l() < 128) {
                const int t_ = tid_l(); __syncthreads();
                convert_weights(P, lds, l + 1, bid_l() * 8 + (t_ >> 6), 128 * 8, t_ >> 6, t_ & 63, CV_SPLIT1, CV_SPLIT2);
            }
            if (k == 1 && bid_l() < 128) {
                const int ntail = (MP / 256) * 4 - 2 * ((int)gridDim.x - 128);
                if ((int)bid_l() < ntail) {
                    __syncthreads();
                    if (tid_l() == 0) { unsigned sp = 0; while (__hip_atomic_load((unsigned*)ws + 128, __ATOMIC_RELAXED, __HIP_MEMORY_SCOPE_AGENT) < (unsigned)(l + 1)) { __builtin_amdgcn_s_sleep(4); if (++sp > (1u << 24)) break; }
                        __builtin_amdgcn_fence(__ATOMIC_ACQUIRE, "agent"); asm volatile("s_waitcnt vmcnt(0)" ::: "memory"); }
                    __syncthreads();
                    d.A = (const bf16_t*)(ws + WS_YGELU); d.Bt = (const bf16_t*)(wb + WO_WGLU); d.lda = LDG; d.ldb = LDG; d.K = 1024; d.nM = MP / 256; d.nN = 4; d.nB = 1; d.sA = 0; d.sB = 0; d.epi = EPI_GLU; d.perm = 1;
                    d.ubase = 2 * ((int)gridDim.x - 128); d.umax = 0x7fffffff; d.gG = ntail; d.gc = bid_l();
                    gemm_phase(P, lds, d);
                }
            }
            if (k == 5 && l + 1 < DEPTH) {
                const int nun = (MP / 256) * 8, nfull = (nun / (int)gridDim.x) * (int)gridDim.x, nbusy = (nun - nfull) * 4;
                const int t_ = tid_l(); __syncthreads();
                if (nbusy == 0 || nbusy >= (int)gridDim.x) convert_weights(P, lds, l + 1, bid_l() * 8 + (t_ >> 6), gridDim.x * 8, t_ >> 6, t_ & 63, CV_SPLIT2);
                else if (bid_l() >= nbusy) convert_weights(P, lds, l + 1, (bid_l() - nbusy) * 8 + (t_ >> 6), (gridDim.x - nbusy) * 8, t_ >> 6, t_ & 63, CV_SPLIT2);
            }
        }
        if (ph + 1 < P.ph_hi) { if (ph == 0) { grid.sync(); if (threadIdx.x == 0) { (void)xb_add((unsigned*)ws + 1024 + XB_XCNT(xb_xcc_id()), 1u); if (blockIdx.x >= 128) (void)xb_add((unsigned*)ws + 8192 + 1024 + XB_XCNT(xb_xcc_id()), 1u); } } else xcd_barrier((unsigned*)ws + 1024, xst, gridDim.x); }
    }
}

extern "C" void kernel_launch(void* const* d_in, const int* in_sizes, int n_in, void* d_out, int out_size, void* d_ws, size_t ws_size, hipStream_t stream) {
    static int grid = 0;
    if (grid == 0) {
        int dev = 0, cus = 0, per_cu = 0;
        hipGetDevice(&dev); hipDeviceGetAttribute(&cus, hipDeviceAttributeMultiprocessorCount, dev);
        if (hipFuncSetAttribute((const void*)mk_fwd, hipFuncAttributeMaxDynamicSharedMemorySize, LDS_BYTES) != hipSuccess) { fprintf(stderr, "kernel_launch: hipFuncSetAttribute failed\n"); grid = -1; return; }
        if (hipOccupancyMaxActiveBlocksPerMultiprocessor(&per_cu, (const void*)mk_fwd, 512, LDS_BYTES) != hipSuccess || per_cu < 1) { fprintf(stderr, "kernel_launch: occupancy query says %d\n", per_cu); per_cu = 1; }
        (void)hipGetLastError();
        grid = cus;
        if (ws_size < WS_END) fprintf(stderr, "kernel_launch: workspace too small: %zu < %zu\n", ws_size, (size_t)WS_END);
    }
    if (grid < 0) return;
    Params p{};
    for (int i = 0; i < 27; ++i) p.in[i] = (const float*)d_in[i];
    p.out = (float*)d_out; p.ws = (unsigned char*)d_ws; p.ph_lo = 0; p.ph_hi = NPHASES;
    void* args[] = {&p};
    hipError_t e = hipLaunchCooperativeKernel((const void*)mk_fwd, dim3(grid), dim3(512), args, LDS_BYTES, stream);
    if (e != hipSuccess) fprintf(stderr, "cooperative launch failed: %s (grid %d)\n", hipGetErrorString(e), grid);
}
```

```cpp
#include <hip/hip_runtime.h>
#include <hip/hip_cooperative_groups.h>
#include <cstdio>
namespace cg = cooperative_groups;

#define LAS __attribute__((address_space(3)))
typedef unsigned short bf16_t;
typedef short bf16x8 __attribute__((ext_vector_type(8)));
typedef float f32x4 __attribute__((ext_vector_type(4)));
typedef unsigned u32x4 __attribute__((ext_vector_type(4)));
typedef unsigned u32x2 __attribute__((ext_vector_type(2)));

constexpr int DM = 2048, NB = 8, LP = 2112, PADF = 48, MP = NB * LP;
constexpr int DIN = 4128, DINP = 4352, DFF = 5632, DEPTH = 4;
constexpr int NCH = LP / 16;
constexpr int S5ROWS = NB * NCH;
constexpr int S5ROWP = 1280;
constexpr float EPSN = 1e-6f;
constexpr int LDH = 2112, LDF = 5696, LDG = 1088, LDU = 576, LDWS = 320, LDTO = 576;
constexpr int CV_SPLIT1 = 7075, CV_SPLIT2 = 14150;
constexpr int NPH_L = 6, NPHASES = 2 + DEPTH * NPH_L;

constexpr size_t MiB = 1u << 20;
constexpr size_t WO_WIN = 0 * MiB, WO_WGLU = 18 * MiB, WO_WOUT = 21 * MiB, WO_WGU = 30 * MiB, WO_WDN = 76 * MiB;
constexpr size_t WS_WSET = 1 * MiB;
constexpr size_t WS_WST = 100 * MiB, WS_TO = 140 * MiB, WS_H = 212 * MiB, WS_HN = 344 * MiB + 8192, WS_G = 413 * MiB, WS_Y = 416 * MiB;
constexpr size_t WS_UA = 485 * MiB, WS_Z = 576 * MiB, WS_SLOC = 676 * MiB, WS_YGELU = 676 * MiB, WS_YGLU = 716 * MiB, WS_HFB = 756 * MiB;
constexpr size_t WS_GT = 486 * MiB, WS_ACT = 669 * MiB, WS_SS = 854 * MiB, WS_END = 856 * MiB;
constexpr int LDS_BYTES = 147456;

struct Params { const float* in[27]; float* out; unsigned char* ws; int ph_lo, ph_hi; };

#define LAUNDER_Z() int zz = 0; asm volatile("" : "+s"(zz))
#define PIN(i) (P.in[(i) + zz])
__device__ __forceinline__ int tid_l() { int w = __builtin_amdgcn_readfirstlane(threadIdx.x >> 6); asm volatile("" : "+s"(w)); int ln = __builtin_amdgcn_mbcnt_hi(~0u, __builtin_amdgcn_mbcnt_lo(~0u, 0u)); asm volatile("" : "+v"(ln)); return w * 64 + ln; }
__device__ __forceinline__ int bid_l() { int t = blockIdx.x; asm volatile("" : "+s"(t)); return t; }
__device__ __forceinline__ unsigned cvt_pk_bf16(float lo, float hi) { unsigned r; asm("v_cvt_pk_bf16_f32 %0, %1, %2" : "=v"(r) : "v"(lo), "v"(hi)); return r; }
__device__ __forceinline__ float bf_lo(unsigned w) { return __uint_as_float(w << 16); }
__device__ __forceinline__ float bf_hi(unsigned w) { return __uint_as_float(w & 0xffff0000u); }
__device__ __forceinline__ float bf2f(bf16_t b) { return __uint_as_float((unsigned)b << 16); }
__device__ __forceinline__ bf16_t f2bf(float f) { return (bf16_t)(cvt_pk_bf16(f, 0.f) & 0xffffu); }
__device__ __forceinline__ float sigmoidf_(float x) { return __builtin_amdgcn_rcpf(1.0f + __expf(-x)); }
__device__ __forceinline__ float siluf_(float x) { return x * sigmoidf_(x); }
__device__ __forceinline__ float gelu_tanh(float x) { const float u = 0.7978845608028654f * (x + 0.044715f * x * x * x); return x * __builtin_amdgcn_rcpf(1.0f + __expf(-2.0f * u)); }
__device__ __forceinline__ float shx(float v, int o, int lane) { return __int_as_float(__builtin_amdgcn_ds_bpermute((lane ^ o) << 2, __float_as_int(v))); }
__device__ __forceinline__ float shi(float v, int idx) { return __int_as_float(__builtin_amdgcn_ds_bpermute(idx << 2, __float_as_int(v))); }
__device__ __forceinline__ float wave_sum(float v, int lane) {
#pragma unroll
    for (int o = 1; o < 64; o <<= 1) v += shx(v, o, lane);
    return v;
}
__device__ __forceinline__ float wave_max(float v, int lane) {
#pragma unroll
    for (int o = 1; o < 64; o <<= 1) v = fmaxf(v, shx(v, o, lane));
    return v;
}

__device__ __forceinline__ float dpp_shr(float v, float ident, const int n) {
    switch (n) {
    case 1: return __int_as_float(__builtin_amdgcn_update_dpp(__float_as_int(ident), __float_as_int(v), 0x111, 0xf, 0xf, false));
    case 2: return __int_as_float(__builtin_amdgcn_update_dpp(__float_as_int(ident), __float_as_int(v), 0x112, 0xf, 0xf, false));
    case 4: return __int_as_float(__builtin_amdgcn_update_dpp(__float_as_int(ident), __float_as_int(v), 0x114, 0xf, 0xf, false));
    default: return __int_as_float(__builtin_amdgcn_update_dpp(__float_as_int(ident), __float_as_int(v), 0x118, 0xf, 0xf, false));
    }
}
__device__ __forceinline__ float rdlane(float v, const int l) { return __int_as_float(__builtin_amdgcn_readlane(__float_as_int(v), l)); }
__device__ __forceinline__ float wave_incl_sum(float v, int lane) {
    v += dpp_shr(v, 0.f, 1); v += dpp_shr(v, 0.f, 2); v += dpp_shr(v, 0.f, 4); v += dpp_shr(v, 0.f, 8);
    const float s0 = rdlane(v, 15), s1 = rdlane(v, 31), s2 = rdlane(v, 47); const int q = lane >> 4;
    return v + (q == 0 ? 0.f : (q == 1 ? s0 : (q == 2 ? s0 + s1 : (s0 + s1) + s2)));
}
__device__ __forceinline__ float wave_incl_max(float v, int lane) {
    const float NI = -3.0e38f;
    v = fmaxf(v, dpp_shr(v, NI, 1)); v = fmaxf(v, dpp_shr(v, NI, 2)); v = fmaxf(v, dpp_shr(v, NI, 4)); v = fmaxf(v, dpp_shr(v, NI, 8));
    const float m0 = rdlane(v, 15), m1 = fmaxf(m0, rdlane(v, 31)), m2 = fmaxf(m1, rdlane(v, 47)); const int q = lane >> 4;
    return fmaxf(v, q == 0 ? NI : (q == 1 ? m0 : (q == 2 ? m1 : m2)));
}
constexpr int BM = 256, BK = 64, HALF = 128, HTB = HALF * BK * 2;
__device__ __forceinline__ int lds_byte(int r, int c) { const int st = (r >> 4) * 2 + (c >> 5), rr = r & 15, cc = c & 31, ob = rr * 64 + cc * 2; return st * 1024 + (ob ^ (((ob >> 9) & 1) << 5)); }
__device__ __forceinline__ void stage_rc(int b, int& R, int& C) { const int st = b / 1024, sb = b % 1024, swz = sb ^ (((sb >> 9) & 1) << 5); R = (st >> 1) * 16 + swz / 64; C = (st & 1) * 32 + (swz % 64) / 2; }

struct Unit { int pm, pn, b, piece, tu, k0, nt; };
struct GemmDesc { const bf16_t* A; const bf16_t* Bt; int lda, ldb, K, nM, nN, nB; size_t sA, sB; int epi, layer, ssi, amode, gG, gc, split, ubase, umax, perm; };
enum { EPI_WIN = 0, EPI_S5A = 1, EPI_S5C = 2, EPI_GLU = 3, EPI_RES = 4, EPI_FFN = 5 };

__device__ __forceinline__ bool next_unit(const GemmDesc& d, int i, int G, int c, Unit& u) {
    const int per = d.nM * d.nN; long L = (long)d.ubase + (long)i * G + c; const int ntf = d.K / BK;
    if (L >= d.umax) return false;
    u.piece = -1; u.tu = 0; u.k0 = 0; u.nt = ntf;
    if (d.split > 0) { const int nfull = (per / G) * G;
        if (L >= nfull) { const long q = L - nfull; if (q >= (long)(per - nfull) * d.split) return false;
            u.tu = (int)(q / d.split); u.piece = (int)(q % d.split); u.nt = ntf / d.split; u.k0 = u.piece * u.nt; L = nfull + u.tu; } }
    if (L >= (long)per * d.nB) return false;
    u.b = (int)(L / per); int wgid = (int)(L % per);
    { const int q = per / 8, r = per % 8, xcd = wgid % 8, off = wgid / 8; wgid = (xcd < r ? xcd * (q + 1) : r * (q + 1) + (xcd - r) * q) + off; }
    const int nig = 8 * d.nN, gid = wgid / nig, fm = gid * 8, gsz = (d.nM - fm) < 8 ? (d.nM - fm) : 8;
    u.pm = fm + ((wgid % nig) % gsz); u.pn = (wgid % nig) / gsz; return true;
}

__device__ __forceinline__ void store_bf4(bf16_t* p, f32x4 v) { u32x2 w; w.x = cvt_pk_bf16(v[0], v[1]); w.y = cvt_pk_bf16(v[2], v[3]); *(u32x2*)p = w; }
__device__ __forceinline__ f32x4 load_bf4(const bf16_t* p) { const u32x2 w = *(const u32x2*)p; return (f32x4){bf_lo(w.x), bf_hi(w.x), bf_lo(w.y), bf_hi(w.y)}; }

typedef unsigned long long u64;
constexpr float SSCALE = 16777216.0f;
__device__ __forceinline__ float row_rs(const u64* ss, int r) { return __builtin_amdgcn_rsqf((float)ss[r] * (1.0f / (SSCALE * DM)) + EPSN); }
__device__ __forceinline__ void gemm_epilogue(const Params& P, const GemmDesc& d, const f32x4 (&acc)[2][2][4][2], const Unit& u, int wr, int wc, int fr, int fq) {
    LAUNDER_Z(); unsigned char* ws = P.ws + zz; const int l = d.layer;
    int lane;
    { const int t2 = tid_l(); const int w2 = __builtin_amdgcn_readfirstlane(t2 >> 6); wr = w2 >> 2; wc = w2 & 3; lane = t2 & 63; fr = lane & 15; fq = lane >> 4; }
    const int rbase = u.pm * BM + wr * 64 + fr, cbase = u.pn * BM + wc * 32 + 4 * fq;
    if (d.epi == EPI_RES) {
        const int cb8 = u.pn * BM + wc * 32 + 8 * fq;
        float* hb = (float*)(ws + WS_H) + (size_t)rbase * DM + cb8; bf16_t* nb = (bf16_t*)(ws + WS_HN) + (size_t)rbase * LDH + cb8;
        u64* ssp = (u64*)(ws + WS_SS) + (size_t)d.ssi * MP + rbase;
#pragma unroll
        for (int ai = 0; ai < 2; ++ai)
#pragma unroll
        for (int mh = 0; mh < 2; ++mh) {
            f32x4 t[2][2][2];
            float* hp = hb + (size_t)(ai * HALF + mh * 32) * DM; asm volatile("" : "+v"(hp));
#pragma unroll
            for (int m = 0; m < 2; ++m)
#pragma unroll
                for (int bj = 0; bj < 2; ++bj)
#pragma unroll
                    for (int n = 0; n < 2; ++n) t[m][bj][n] = *(const f32x4*)(hp + (size_t)(m * 16) * DM + bj * HALF + n * 4);
            float sq[2] = {0.f, 0.f};
#pragma unroll
            for (int m = 0; m < 2; ++m)
#pragma unroll
                for (int bj = 0; bj < 2; ++bj)
#pragma unroll
                    for (int n = 0; n < 2; ++n) { const f32x4 hv = t[m][bj][n] + acc[ai][bj][mh * 2 + m][n]; t[m][bj][n] = hv;
                        __builtin_nontemporal_store(hv, (f32x4*)(hp + (size_t)(m * 16) * DM + bj * HALF + n * 4));
                        sq[m] += (hv[0] * hv[0] + hv[1] * hv[1]) + (hv[2] * hv[2] + hv[3] * hv[3]); }
            bf16_t* np = nb + (size_t)(ai * HALF + mh * 32) * LDH; asm volatile("" : "+v"(np));
#pragma unroll
            for (int m = 0; m < 2; ++m) {
#pragma unroll
                for (int bj = 0; bj < 2; ++bj) { u32x4 o; o.x = cvt_pk_bf16(t[m][bj][0][0], t[m][bj][0][1]); o.y = cvt_pk_bf16(t[m][bj][0][2], t[m][bj][0][3]); o.z = cvt_pk_bf16(t[m][bj][1][0], t[m][bj][1][1]); o.w = cvt_pk_bf16(t[m][bj][1][2], t[m][bj][1][3]);
                    *(u32x4*)(np + (size_t)(m * 16) * LDH + bj * HALF) = o; }
                float q = sq[m]; q += shx(q, 16, lane); q += shx(q, 32, lane);
                if (fq == 0) atomicAdd(ssp + ai * HALF + mh * 32 + m * 16, (u64)(q * SSCALE));
            }
        }
        return;
    }
    if (d.epi == EPI_FFN) {
        const int ccol = u.pn * 128 + wc * 32 + 8 * fq;
        const float* cwb = PIN(23) + (size_t)l * 3 * DFF + ccol; const float* cbb = PIN(24) + (size_t)l * DFF + ccol;
        const u64* ssb = (const u64*)(ws + WS_SS) + (size_t)d.ssi * MP;
#pragma unroll
        for (int ai = 0; ai < 2; ++ai) {
            const int row0 = u.pm * 248 + (ai * 2 + wr) * 62 - 1 + fr;
            float rsv[4];
#pragma unroll
            for (int m = 0; m < 4; ++m) { int rc = row0 + m * 16; rc = rc < 0 ? 0 : (rc > MP - 1 ? MP - 1 : rc); rsv[m] = row_rs(ssb, rc); }
            bf16_t* ab = (bf16_t*)(ws + WS_ACT) + (size_t)row0 * LDF + ccol;
            u32x2 keep[4];
#pragma unroll
            for (int n = 0; n < 2; ++n) {
                const f32x4 w0 = *(const f32x4*)(cwb + n * 4), w1 = *(const f32x4*)(cwb + DFF + n * 4), w2 = *(const f32x4*)(cwb + 2 * DFF + n * 4), cb = *(const f32x4*)(cbb + n * 4);
                f32x4 X[4], RR[4], RL[4];
#pragma unroll
                for (int m = 0; m < 4; ++m) { X[m] = acc[ai][0][m][n] * rsv[m];
#pragma unroll
                    for (int j = 0; j < 4; ++j) { RR[m][j] = __int_as_float(__builtin_amdgcn_update_dpp(0, __float_as_int(X[m][j]), 0x121, 0xf, 0xf, false));
                                                  RL[m][j] = __int_as_float(__builtin_amdgcn_update_dpp(0, __float_as_int(X[m][j]), 0x12f, 0xf, 0xf, false)); } }
#pragma unroll
                for (int m = 0; m < 4; ++m) {
                    const f32x4 prev = (fr > 0) ? RR[m] : RR[m > 0 ? m - 1 : 0];
                    const f32x4 next = (fr < 15) ? RL[m] : RL[m < 3 ? m + 1 : 3];
                    const f32x4 gt = cb + w0 * prev + w1 * X[m] + w2 * next; const f32x4 v = acc[ai][1][m][n] * rsv[m];
                    const int lr = m * 16 + fr, row = row0 + m * 16;
                    u32x2 pk; pk.x = cvt_pk_bf16(siluf_(gt[0]) * v[0], siluf_(gt[1]) * v[1]); pk.y = cvt_pk_bf16(siluf_(gt[2]) * v[2], siluf_(gt[3]) * v[3]);
                    if (n == 0) keep[m] = pk;
                    else if (lr >= 1 && lr <= 62 && row < MP) { u32x4 o; o.x = keep[m].x; o.y = keep[m].y; o.z = pk.x; o.w = pk.y; __builtin_nontemporal_store(o, (u32x4*)(ab + (size_t)(m * 16) * LDF)); } }
            }
        }
        return;
    }
    if (d.epi == EPI_GLU) {
        const int c8 = u.pn * BM + wc * 32 + 8 * fq;
        const bf16_t* yb = (const bf16_t*)(ws + WS_YGELU) + (size_t)rbase * LDG + c8; bf16_t* ob = (bf16_t*)(ws + WS_YGLU) + (size_t)rbase * 1024 + c8;
        const float* bb = PIN(13) + (size_t)l * 1024 + c8;
#pragma unroll
        for (int bj = 0; bj < 2; ++bj) {
            f32x4 bg[2];
#pragma unroll
            for (int n = 0; n < 2; ++n) bg[n] = *(const f32x4*)(bb + bj * HALF + n * 4);
#pragma unroll
            for (int ai = 0; ai < 2; ++ai) {
                u32x4 y[4];
                const bf16_t* yq = yb + (size_t)(ai * HALF) * LDG + bj * HALF; asm volatile("" : "+v"(yq));
#pragma unroll
                for (int m = 0; m < 4; ++m) y[m] = *(const u32x4*)(yq + (size_t)(m * 16) * LDG);
#pragma unroll
                for (int m = 0; m < 4; ++m) { const f32x4 v0 = acc[ai][bj][m][0] + bg[0], v1 = acc[ai][bj][m][1] + bg[1]; const u32x4 yy = y[m]; u32x4 o;
                    o.x = cvt_pk_bf16(bf_lo(yy.x) * sigmoidf_(v0[0]), bf_hi(yy.x) * sigmoidf_(v0[1])); o.y = cvt_pk_bf16(bf_lo(yy.y) * sigmoidf_(v0[2]), bf_hi(yy.y) * sigmoidf_(v0[3]));
                    o.z = cvt_pk_bf16(bf_lo(yy.z) * sigmoidf_(v1[0]), bf_hi(yy.z) * sigmoidf_(v1[1])); o.w = cvt_pk_bf16(bf_lo(yy.w) * sigmoidf_(v1[2]), bf_hi(yy.w) * sigmoidf_(v1[3]));
                    *(u32x4*)(ob + (size_t)(ai * HALF + m * 16) * 1024 + bj * HALF) = o; }
            }
        }
        return;
    }
    if (d.epi == EPI_S5A) {
        float* sb = (float*)(ws + WS_SLOC) + ((size_t)u.b * S5ROWP + rbase) * 256 + wc * 32 + 8 * fq;
#pragma unroll
        for (int ai = 0; ai < 2; ++ai)
#pragma unroll
        for (int m = 0; m < 4; ++m) {
            float* sp = sb + (size_t)(ai * HALF + m * 16) * 256;
#pragma unroll
            for (int bj = 0; bj < 2; ++bj) { *(f32x4*)(sp + bj * HALF) = acc[ai][bj][m][0]; *(f32x4*)(sp + bj * HALF + 4) = acc[ai][bj][m][1]; }
        }
        return;
    }
    if (d.epi == EPI_S5C) {
#pragma unroll
        for (int ai = 0; ai < 2; ++ai)
#pragma unroll
        for (int m = 0; m < 4; ++m) {
            const int r = rbase + ai * HALF + m * 16;
            if (r < S5ROWS) { const int b = r / NCH, nn = r - b * NCH;
#pragma unroll
                for (int bj = 0; bj < 2; ++bj) { const int c8 = bj * HALF + wc * 32 + 8 * fq, tl = c8 >> 4, ch = c8 & 15; const size_t row = (size_t)b * LP + nn * 16 + tl;
                    const f32x4 v0 = acc[ai][bj][m][0], v1 = acc[ai][bj][m][1]; u32x4 o;
                    o.x = cvt_pk_bf16(gelu_tanh(v0[0]), gelu_tanh(v0[1])); o.y = cvt_pk_bf16(gelu_tanh(v0[2]), gelu_tanh(v0[3])); o.z = cvt_pk_bf16(gelu_tanh(v1[0]), gelu_tanh(v1[1])); o.w = cvt_pk_bf16(gelu_tanh(v1[2]), gelu_tanh(v1[3]));
                    *(u32x4*)((bf16_t*)(ws + WS_YGELU) + row * LDG + u.b * 16 + ch) = o; } }
        }
        return;
    }
    if (d.epi == EPI_WIN) {
        const u64* ssb = (const u64*)(ws + WS_SS) + (size_t)d.ssi * MP;
#pragma unroll
        for (int ai = 0; ai < 2; ++ai)
#pragma unroll
        for (int m = 0; m < 4; ++m) {
            const int r = rbase + ai * HALF + m * 16; const float rsc = row_rs(ssb, r);
#pragma unroll
            for (int bj = 0; bj < 2; ++bj) {
                const int c8 = u.pn * BM + bj * HALF + wc * 32 + 8 * fq;
                const f32x4 v0 = acc[ai][bj][m][0] * rsc, v1 = acc[ai][bj][m][1] * rsc;
                if (u.pn < 16) { u32x4 o; o.x = cvt_pk_bf16(v0[0], v0[1]); o.y = cvt_pk_bf16(v0[2], v0[3]); o.z = cvt_pk_bf16(v1[0], v1[1]); o.w = cvt_pk_bf16(v1[2], v1[3]);
                    if (u.pn < 4) { const int g = c8 >> 4, ch = c8 & 15, b = r / LP, pos = r - b * LP, cr = b * NCH + (pos >> 4), tl = pos & 15;
                        *(u32x4*)((bf16_t*)(ws + WS_UA) + ((size_t)g * S5ROWP + cr) * LDU + tl * 16 + ch) = o; }
                    else *(u32x4*)((bf16_t*)(ws + WS_Z) + (size_t)r * 3072 + (c8 - 1024)) = o; }
                else if (c8 - 4096 < 32) { float* gp = (float*)(ws + WS_G) + (size_t)r * 32 + (c8 - 4096); *(f32x4*)gp = v0; *(f32x4*)(gp + 4) = v1; }
            }
        }
        return;
    }
#pragma unroll
    for (int ai = 0; ai < 2; ++ai)
#pragma unroll
    for (int m = 0; m < 4; ++m) {
        const int r = rbase + ai * HALF + m * 16;
        const float rsc = (d.epi == EPI_WIN) ? row_rs((const u64*)(ws + WS_SS) + (size_t)d.ssi * MP, r) : 1.0f;
#pragma unroll
        for (int bj = 0; bj < 2; ++bj)
#pragma unroll
        for (int n = 0; n < 2; ++n) {
            const int c0 = cbase + bj * HALF + n * 16;
            const f32x4 v = acc[ai][bj][m][n] * rsc;
            switch (d.epi) {
            case EPI_WIN: {
                if (u.pn < 4) { const int g = c0 >> 4, ch = c0 & 15, b = r / LP, pos = r - b * LP, cr = b * NCH + (pos >> 4), tl = pos & 15;
                    store_bf4((bf16_t*)(ws + WS_UA) + ((size_t)g * S5ROWP + cr) * LDU + tl * 16 + ch, v); }
                else if (u.pn < 16) store_bf4((bf16_t*)(ws + WS_Z) + (size_t)r * 3072 + (c0 - 1024), v);
                else if (c0 - 4096 < 32) *(f32x4*)((float*)(ws + WS_G) + (size_t)r * 32 + (c0 - 4096)) = v;
            } break;
            case EPI_S5A: *(f32x4*)((float*)(ws + WS_SLOC) + ((size_t)u.b * S5ROWP + r) * 256 + c0) = v; break;
            case EPI_S5C: {
                if (r < S5ROWS) { const int b = r / NCH, nn = r - b * NCH, tl = c0 >> 4, ch = c0 & 15; const size_t row = (size_t)b * LP + nn * 16 + tl;
                    store_bf4((bf16_t*)(ws + WS_YGELU) + row * LDG + u.b * 16 + ch, (f32x4){gelu_tanh(v[0]), gelu_tanh(v[1]), gelu_tanh(v[2]), gelu_tanh(v[3])}); }
            } break;
            default: break;
            }
        }
    }
}

__device__ __forceinline__ void gemm_phase(const Params& P, LAS unsigned char* lds, const GemmDesc d) {
    const int tid = tid_l(), wid = __builtin_amdgcn_readfirstlane(tid >> 6), lane = tid & 63, wr = wid >> 2, wc = wid & 3, fr = lane & 15, fq = lane >> 4;
    const int K = d.K, nt = K / BK; const int G = d.gG, cblk = d.gc;
    unsigned voffA[2], voffB[2];
#pragma unroll
    for (int i = 0; i < 2; ++i) { int R, C; stage_rc(tid * 16 + i * 8192, R, C); const int Ra = (d.amode && R >= 64) ? R - 2 : R; voffA[i] = (unsigned)(Ra * d.lda + C) * 2u; const int Rb = d.perm ? ((R & ~31) + 8 * ((R & 15) >> 2) + 4 * ((R & 31) >> 4) + (R & 3)) : R; voffB[i] = (unsigned)(Rb * d.ldb + C) * 2u; }
    const size_t kstep = (size_t)(BK * 2);
    const size_t hstepA = (size_t)(d.amode ? 124 : HALF) * d.lda * 2, hstepB = (size_t)HALF * d.ldb * 2;
    const unsigned ldsw = (unsigned)wid * 1024u;
    const int aoff = lds_byte(wr * 64 + fr, fq * 8), boff = lds_byte(wc * 32 + fr, fq * 8);
#define PG8_SA(b, h) (((b) * 2 + (h)) * HTB)
#define PG8_SB(b, h) ((4 + (b) * 2 + (h)) * HTB)
#define PG8_STAGE(bufoff, gbase, voff) do { _Pragma("unroll") for (int _i = 0; _i < 2; ++_i) \
        __builtin_amdgcn_global_load_lds((const unsigned*)((const char*)(gbase) + (voff)[_i]), (LAS unsigned*)(lds + (bufoff) + ldsw + _i * 8192), 16, 0, 0); } while (0)
#define PG8_LDA(dst, b, h) do { _Pragma("unroll") for (int m = 0; m < 4; ++m) _Pragma("unroll") for (int k = 0; k < 2; ++k) dst[m][k] = *(const LAS bf16x8*)(lds + PG8_SA(b, h) + aoff + m * 2048 + k * 1024); } while (0)
#define PG8_LDB(dst, b, h) do { _Pragma("unroll") for (int n = 0; n < 2; ++n) _Pragma("unroll") for (int k = 0; k < 2; ++k) dst[n][k] = *(const LAS bf16x8*)(lds + PG8_SB(b, h) + boff + n * 2048 + k * 1024); } while (0)
#define PG8_MMA(ai, bj, At, Bt) do { __builtin_amdgcn_s_setprio(1); _Pragma("unroll") for (int m = 0; m < 4; ++m) _Pragma("unroll") for (int n = 0; n < 2; ++n) _Pragma("unroll") for (int k = 0; k < 2; ++k) \
        acc[ai][bj][m][n] = __builtin_amdgcn_mfma_f32_16x16x32_bf16(Bt[n][k], At[m][k], acc[ai][bj][m][n], 0, 0, 0); __builtin_amdgcn_s_setprio(0); } while (0)
#define PG8_WAIT_V(n) asm volatile("s_waitcnt vmcnt(" #n ")" ::: "memory")
#define PG8_WAIT_L(n) asm volatile("s_waitcnt lgkmcnt(" #n ")" ::: "memory")
#define PG8_BAR __builtin_amdgcn_s_barrier()
#define PG8_SCHED __builtin_amdgcn_sched_barrier(0)
    Unit cur, nxt; int ui = 0;
    if (!next_unit(d, 0, G, cblk, cur)) return;
    f32x4 acc[2][2][4][2];
#pragma unroll
    for (int a = 0; a < 2; ++a)
#pragma unroll
        for (int b = 0; b < 2; ++b)
#pragma unroll
            for (int m = 0; m < 4; ++m)
#pragma unroll
                for (int n = 0; n < 2; ++n) acc[a][b][m][n] = (f32x4){0.f, 0.f, 0.f, 0.f};
    bf16x8 At[4][2], B0[2][2], B1[2][2];
    const char* cA = (const char*)d.A + ((size_t)cur.b * d.sA) * 2 + (size_t)cur.pm * 2 * hstepA + (size_t)cur.k0 * kstep;
    const char* cB = (const char*)d.Bt + ((size_t)cur.b * d.sB) * 2 + (size_t)cur.pn * 2 * hstepB + (size_t)cur.k0 * kstep;
    PG8_STAGE(PG8_SB(0, 0), cB, voffB); PG8_STAGE(PG8_SA(0, 0), cA, voffA); PG8_STAGE(PG8_SB(0, 1), cB + hstepB, voffB); PG8_STAGE(PG8_SA(0, 1), cA + hstepA, voffA);
    if (wr == 1) PG8_BAR;
    PG8_WAIT_V(4); PG8_BAR;
    PG8_STAGE(PG8_SB(1, 0), cB + kstep, voffB); PG8_STAGE(PG8_SA(1, 0), cA + kstep, voffA); PG8_STAGE(PG8_SB(1, 1), cB + hstepB + kstep, voffB);
    PG8_WAIT_V(6); PG8_BAR;
    for (;;) {
        const bool has_next = next_unit(d, ui + 1, G, cblk, nxt);
        const char* nA = has_next ? (const char*)d.A + ((size_t)nxt.b * d.sA) * 2 + (size_t)nxt.pm * 2 * hstepA + (size_t)nxt.k0 * kstep : cA;
        const char* nB = has_next ? (const char*)d.Bt + ((size_t)nxt.b * d.sB) * 2 + (size_t)nxt.pn * 2 * hstepB + (size_t)nxt.k0 * kstep : cB;
        const int ntu = cur.nt;
        for (int t = 0; t < ntu; t += 2) {
            const bool last = (t == ntu - 2);
            const char* a1 = cA + (size_t)(t + 1) * kstep;
            const char* a2 = last ? nA : cA + (size_t)(t + 2) * kstep; const char* b2 = last ? nB : cB + (size_t)(t + 2) * kstep;
            const char* a3 = a2 + kstep; const char* b3 = b2 + kstep;
            PG8_LDB(B0, 0, 0); PG8_SCHED; PG8_LDA(At, 0, 0); PG8_STAGE(PG8_SA(1, 1), a1 + hstepA, voffA);
            PG8_WAIT_L(8); PG8_BAR; PG8_WAIT_L(0); PG8_MMA(0, 0, At, B0); PG8_BAR; PG8_SCHED;
            PG8_LDB(B1, 0, 1); PG8_STAGE(PG8_SB(0, 0), b2, voffB);
            PG8_BAR; PG8_WAIT_L(0); PG8_MMA(0, 1, At, B1); PG8_BAR;
            PG8_LDA(At, 0, 1); PG8_STAGE(PG8_SA(0, 0), a2, voffA);
            PG8_BAR; PG8_WAIT_L(0); PG8_MMA(1, 0, At, B0); PG8_BAR; PG8_SCHED;
            PG8_STAGE(PG8_SB(0, 1), b2 + hstepB, voffB);
            PG8_WAIT_V(6); PG8_BAR; PG8_MMA(1, 1, At, B1); PG8_BAR;
            PG8_LDB(B0, 1, 0); PG8_SCHED; PG8_LDA(At, 1, 0); PG8_STAGE(PG8_SA(0, 1), a2 + hstepA, voffA);
            PG8_WAIT_L(8); PG8_BAR; PG8_WAIT_L(0); PG8_MMA(0, 0, At, B0); PG8_BAR; PG8_SCHED;
            PG8_LDB(B1, 1, 1); PG8_STAGE(PG8_SB(1, 0), b3, voffB);
            PG8_BAR; PG8_WAIT_L(0); PG8_MMA(0, 1, At, B1); PG8_BAR;
            PG8_LDA(At, 1, 1); PG8_STAGE(PG8_SA(1, 0), a3, voffA);
            PG8_BAR; PG8_WAIT_L(0); PG8_MMA(1, 0, At, B0); PG8_BAR; PG8_SCHED;
            PG8_STAGE(PG8_SB(1, 1), b3 + hstepB, voffB);
            PG8_WAIT_V(6); PG8_BAR; PG8_MMA(1, 1, At, B1); PG8_BAR;
        }
        bool do_epi = true;
        if (cur.piece >= 0) {
            LAUNDER_Z();
            const int t3 = tid_l(); const int w3 = __builtin_amdgcn_readfirstlane(t3 >> 6), l3 = t3 & 63;
            const size_t pstride = (size_t)8 * 32 * 64;
            f32x4* slab = (f32x4*)(P.ws + zz + WS_UA) + ((size_t)(cur.tu * d.split) * 8 + w3) * 32 * 64 + l3;
            {   f32x4* mine = slab + (size_t)cur.piece * pstride;
#pragma unroll
                for (int idx = 0; idx < 32; ++idx) { asm volatile("global_store_dwordx4 %0, %1, off sc1\n\ts_nop 1" :: "v"(mine), "v"(acc[idx >> 4][(idx >> 3) & 1][(idx >> 1) & 3][idx & 1]) : "memory"); mine += 64; } }
            asm volatile("s_waitcnt vmcnt(0)" ::: "memory");
            unsigned old = 0u;
            if (l3 == 0) old = __hip_atomic_fetch_add((unsigned*)(P.ws + zz) + 8192 + cur.tu * 8 + w3, 1u, __ATOMIC_RELAXED, __HIP_MEMORY_SCOPE_AGENT);
            old = (unsigned)__builtin_amdgcn_readfirstlane((int)old);
            do_epi = ((old % (unsigned)d.split) == (unsigned)d.split - 1u);
            if (do_epi) {
                __builtin_amdgcn_fence(__ATOMIC_ACQUIRE, "agent");
                asm volatile("s_waitcnt vmcnt(0)" ::: "memory");
                const f32x4* p = slab;
#pragma unroll
                for (int i4 = 0; i4 < 8; ++i4) { f32x4 t4[4][4];
#pragma unroll
                    for (int j = 0; j < 4; ++j) { asm volatile("" : "+v"(p));
#pragma unroll
                        for (int q = 0; q < 4; ++q) t4[j][q] = p[(size_t)q * pstride];
                        p += 64; }
#pragma unroll
                    for (int j = 0; j < 4; ++j) { const int idx = i4 * 4 + j; acc[idx >> 4][(idx >> 3) & 1][(idx >> 1) & 3][idx & 1] = ((t4[j][0] + t4[j][1]) + t4[j][2]) + t4[j][3]; } }
            }
        }
        if (do_epi) gemm_epilogue(P, d, acc, cur, wr, wc, fr, fq);
        if (!has_next) break;
#pragma unroll
        for (int a = 0; a < 2; ++a)
#pragma unroll
            for (int b = 0; b < 2; ++b)
#pragma unroll
                for (int m = 0; m < 4; ++m)
#pragma unroll
                    for (int n = 0; n < 2; ++n) acc[a][b][m][n] = (f32x4){0.f, 0.f, 0.f, 0.f};
        cur = nxt; cA = nA; cB = nB; ++ui;
    }
    PG8_WAIT_V(0);
    if (wr == 0) PG8_BAR;
    PG8_BAR;
#undef PG8_SA
#undef PG8_SB
#undef PG8_STAGE
#undef PG8_LDA
#undef PG8_LDB
#undef PG8_MMA
#undef PG8_WAIT_V
#undef PG8_WAIT_L
#undef PG8_BAR
#undef PG8_SCHED
}

__device__ __forceinline__ void transpose_item(const float* W, int K, int N, bf16_t* WT, int ldw, LAS float* scr, int item, int lane, const float* gsc, int rowmap = 0) {
    const int nblk = N / 32, kb = item / nblk, nb = item % nblk, k0 = 64 * kb, n0 = 32 * nb;
    float wv[32];
#pragma unroll
    for (int i = 0; i < 32; ++i) { const int kk = 2 * i + (lane >> 5); wv[i] = W[(size_t)(k0 + kk) * N + n0 + (lane & 31)]; }
#pragma unroll
    for (int i = 0; i < 32; ++i) { const int kk = 2 * i + (lane >> 5); const float gg = gsc ? gsc[k0 + kk] : 1.0f; scr[kk * 33 + (lane & 31)] = wv[i] * gg; }
    asm volatile("s_waitcnt lgkmcnt(0)" ::: "memory");
    const int c = lane & 7;
#pragma unroll
    for (int j = 0; j < 4; ++j) { const int n = (lane >> 3) + 8 * j; const LAS float* s = scr + (8 * c) * 33 + n;
        u32x4 o; o.x = cvt_pk_bf16(s[0 * 33], s[1 * 33]); o.y = cvt_pk_bf16(s[2 * 33], s[3 * 33]); o.z = cvt_pk_bf16(s[4 * 33], s[5 * 33]); o.w = cvt_pk_bf16(s[6 * 33], s[7 * 33]);
        const int nr = n0 + n; const int dr = rowmap ? ((nr >> 7) * 256 + (nr & 127) + (rowmap == 2 ? 128 : 0)) : nr;
        *(u32x4*)(WT + (size_t)dr * ldw + k0 + 8 * c) = o; }
    asm volatile("s_waitcnt lgkmcnt(0)" ::: "memory");
}

__device__ __forceinline__ void norm_row_bf16(const float* hrow, const float* g, bf16_t* orow, int lane, bool pad) {
    u32x2* o8 = (u32x2*)orow + lane;
    if (pad) {
#pragma unroll
        for (int j = 0; j < 8; ++j) o8[64 * j] = (u32x2){0u, 0u};
        return; }
    const f32x4* xr = (const f32x4*)hrow + lane; const f32x4* gr = (const f32x4*)g + lane;
    f32x4 v[8]; float s = 0.f;
#pragma unroll
    for (int j = 0; j < 8; ++j) { v[j] = xr[64 * j]; s += (v[j][0] * v[j][0] + v[j][1] * v[j][1]) + (v[j][2] * v[j][2] + v[j][3] * v[j][3]); }
    const float rs = __builtin_amdgcn_rsqf(wave_sum(s, lane) * (1.0f / DM) + EPSN);
#pragma unroll
    for (int j = 0; j < 8; ++j) { const f32x4 gg = gr[64 * j]; u32x2 w; w.x = cvt_pk_bf16(v[j][0] * rs * gg[0], v[j][1] * rs * gg[1]); w.y = cvt_pk_bf16(v[j][2] * rs * gg[2], v[j][3] * rs * gg[3]); o8[64 * j] = w; }
}

__device__ __forceinline__ void zero_rows16(void* p, int n16, int gt, int NGT) { unsigned z0 = 0u; asm volatile("" : "+v"(z0)); u32x4* z = (u32x4*)p; for (int i = gt; i < n16; i += NGT) z[i] = (u32x4){z0, z0, z0, z0}; }
__device__ __forceinline__ void phase_init_rows(const Params& P) {
    LAUNDER_Z();
    const int lane = tid_l() & 63, gw = bid_l() * 8 + (tid_l() >> 6), NGW = gridDim.x * 8;
    float* H = (float*)(P.ws + zz + WS_H); bf16_t* HN = (bf16_t*)(P.ws + zz + WS_HN); u64* SS = (u64*)(P.ws + zz + WS_SS);
    float zf = 0.f; asm volatile("" : "+v"(zf));
    for (int r = gw; r < MP; r += NGW) {
        const int b = r / LP, pos = r - b * LP; f32x4* o = (f32x4*)(H + (size_t)r * DM) + lane; u32x2* o8 = (u32x2*)(HN + (size_t)r * LDH) + lane;
        if (pos < PADF) {
#pragma unroll
            for (int j = 0; j < 8; ++j) { o[64 * j] = (f32x4){zf, zf, zf, zf}; o8[64 * j] = (u32x2){__float_as_uint(zf), __float_as_uint(zf)}; }
            if (lane == 0) SS[r] = (u64)__float_as_uint(zf);
        } else {
            const float* src = pos < 64 ? PIN(1) + (size_t)(pos - PADF) * DM : PIN(0) + ((size_t)b * 2048 + (pos - 64)) * DM;
            const f32x4* s4 = (const f32x4*)src + lane; float sq = 0.f;
#pragma unroll
            for (int j = 0; j < 8; ++j) { const f32x4 v = s4[64 * j]; o[64 * j] = v; u32x2 w; w.x = cvt_pk_bf16(v[0], v[1]); w.y = cvt_pk_bf16(v[2], v[3]); o8[64 * j] = w; sq += (v[0] * v[0] + v[1] * v[1]) + (v[2] * v[2] + v[3] * v[3]); }
            sq = wave_sum(sq, lane); if (lane == 0) SS[r] = (u64)(sq * SSCALE);
        }
    }
    const int gt = bid_l() * 512 + tid_l(), NGT = gridDim.x * 512;
    for (int i = gt; i < 8 * MP; i += NGT) SS[MP + i] = (u64)__float_as_uint(zf);
    zero_rows16((bf16_t*)(P.ws + zz + WS_HN) - LDH, LDH / 8, gt, NGT); zero_rows16((bf16_t*)(P.ws + zz + WS_HN) + (size_t)MP * LDH, 256 * LDH / 8, gt, NGT);
    zero_rows16((bf16_t*)(P.ws + zz + WS_WSET + WO_WIN) + (size_t)DIN * LDH, (DINP - DIN) * LDH / 8, gt, NGT);
    zero_rows16((bf16_t*)((unsigned char*)P.out + zz + WO_WIN) + (size_t)DIN * LDH, (DINP - DIN) * LDH / 8, gt, NGT);
}

__device__ __forceinline__ void s5_precompute(const Params& P, LAS unsigned char* lds, int l, int g) {
    LAS float* lpr = (LAS float*)lds;
    LAS float* lpi = lpr + 2 * 17 * 64;
    LAS float* bbr = lpi + 2 * 17 * 64;
    LAS float* bbi = bbr + 2048;
    LAS float* ccr = bbi + 2048;
    LAS float* cci = ccr + 2048;
    LAS float* zr = cci + 2048;
    LAS float* zi = zr + 128;
    LAS float* kd = zi + 128;
    LAUNDER_Z();
    const int tid = tid_l();
    if (tid < 128) {
        const int dir = tid >> 6, p = tid & 63; const size_t o = ((size_t)(l * 2 + dir) * 64 + g) * 64 + p;
        const float are = fminf(PIN(4)[o], -1e-4f), aim = PIN(5)[o], dt = expf(PIN(6)[(size_t)(l * 2 + dir) * 64 + g]);
        const float mag = expf(are * dt); float sn, cs; sincosf(aim * dt, &sn, &cs); const float lr = mag * cs, li = mag * sn;
        { float pr = 1.0f, pi = 0.0f;
          for (int dd = 0; dd <= 16; ++dd) { lpr[(dir * 17 + dd) * 64 + p] = pr; lpi[(dir * 17 + dd) * 64 + p] = pi; const float nr = pr * lr - pi * li, ni = pr * li + pi * lr; pr = nr; pi = ni; } }
        { float* t16 = (float*)(P.ws + zz + 524288) + (((size_t)l * 64 + g) * 2 + dir) * 128; t16[p] = lpr[(dir * 17 + 16) * 64 + p]; t16[64 + p] = lpi[(dir * 17 + 16) * 64 + p]; }
        const float den = are * are + aim * aim, pp = lr - 1.0f;
        zr[dir * 64 + p] = (pp * are + li * aim) / den; zi[dir * 64 + p] = (li * are - pp * aim) / den;
    }
    __syncthreads();
    for (int e = tid; e < 2048; e += 512) { const int dir = e >> 10, p = (e >> 4) & 63, h = e & 15; const size_t o = (((size_t)(l * 2 + dir) * 64 + g) * 64 + p) * 16 + h;
        const float br = PIN(7)[o], bi = PIN(8)[o], z_r = zr[dir * 64 + p], z_i = zi[dir * 64 + p];
        bbr[e] = z_r * br - z_i * bi; bbi[e] = z_r * bi + z_i * br; }
    for (int e = tid; e < 2048; e += 512) { const int dir = e >> 10, h = (e >> 6) & 15, p = e & 63; const size_t o = (((size_t)(l * 2 + dir) * 64 + g) * 16 + h) * 64 + p;
        ccr[e] = PIN(9)[o]; cci[e] = PIN(10)[o]; }
    __syncthreads();
    for (int e = tid; e < 8192; e += 512) { const int dir = e >> 12, dd = (e >> 8) & 15, h = (e >> 4) & 15, h2 = e & 15; float s = 0.f;
        for (int p = 0; p < 64; ++p) { const float cr = ccr[(dir * 16 + h) * 64 + p], ci = cci[(dir * 16 + h) * 64 + p], lr = lpr[(dir * 17 + dd) * 64 + p], li = lpi[(dir * 17 + dd) * 64 + p];
            const float ur = cr * lr - ci * li, ui = cr * li + ci * lr; s += ur * bbr[(dir * 64 + p) * 16 + h2] - ui * bbi[(dir * 64 + p) * 16 + h2]; }
        kd[e] = s; }
    __syncthreads();
    bf16_t* WST = (bf16_t*)(P.ws + zz + WS_WST) + ((size_t)l * 64 + g) * (256 * LDWS);
    for (int e8 = tid; e8 < 8192; e8 += 512) { const int n = e8 >> 5, k0 = (e8 & 31) * 8; const int part = n >> 6, p = n & 63, dir = part >> 1; float v[8];
#pragma unroll
        for (int j = 0; j < 8; ++j) { const int k = k0 + j, s = k >> 4, h2 = k & 15, pw = dir == 0 ? 15 - s : s; const float lr = lpr[(dir * 17 + pw) * 64 + p], li = lpi[(dir * 17 + pw) * 64 + p], br = bbr[(dir * 64 + p) * 16 + h2], bi = bbi[(dir * 64 + p) * 16 + h2];
            v[j] = (part & 1) ? (lr * bi + li * br) : (lr * br - li * bi); }
        u32x4 o; o.x = cvt_pk_bf16(v[0], v[1]); o.y = cvt_pk_bf16(v[2], v[3]); o.z = cvt_pk_bf16(v[4], v[5]); o.w = cvt_pk_bf16(v[6], v[7]);
        *(u32x4*)(WST + (size_t)n * LDWS + k0) = o; }
    bf16_t* TO = (bf16_t*)(P.ws + zz + WS_TO) + ((size_t)l * 64 + g) * (256 * LDTO);
    const float* dsk = PIN(11) + ((size_t)l * 64 + g) * 16;
    for (int e8 = tid; e8 < 16384; e8 += 512) { const int n = e8 >> 6, k0 = (e8 & 63) * 8; const int t = n >> 4, h = n & 15; float v[8];
#pragma unroll
        for (int j = 0; j < 8; ++j) { const int k = k0 + j;
            if (k < 256) { const int s = k >> 4, h2 = k & 15;
                if (t > s) v[j] = kd[((0 * 16 + (t - s)) * 16 + h) * 16 + h2];
                else if (t < s) v[j] = kd[((1 * 16 + (s - t)) * 16 + h) * 16 + h2];
                else v[j] = kd[((0 * 16 + 0) * 16 + h) * 16 + h2] + kd[((1 * 16 + 0) * 16 + h) * 16 + h2] + (h == h2 ? dsk[h] : 0.f);
            } else { const int kk = k - 256, part = kk >> 6, p = kk & 63, dir = part >> 1, pw = dir == 0 ? t + 1 : 16 - t;
                const float cr = ccr[(dir * 16 + h) * 64 + p], ci = cci[(dir * 16 + h) * 64 + p], lr = lpr[(dir * 17 + pw) * 64 + p], li = lpi[(dir * 17 + pw) * 64 + p];
                v[j] = (part & 1) ? -(cr * li + ci * lr) : (cr * lr - ci * li); } }
        u32x4 o; o.x = cvt_pk_bf16(v[0], v[1]); o.y = cvt_pk_bf16(v[2], v[3]); o.z = cvt_pk_bf16(v[4], v[5]); o.w = cvt_pk_bf16(v[6], v[7]);
        *(u32x4*)(TO + (size_t)n * LDTO + k0) = o; }
    __syncthreads();
}

__device__ __forceinline__ unsigned char* wset_base(const Params& P, int l, int zz) { return (l & 1) ? (unsigned char*)P.out + zz : P.ws + zz + WS_WSET; }
__device__ __forceinline__ void convert_weights(const Params& P, LAS unsigned char* lds, int l, int gw, int NGW, int wave, int lane, int it_lo = 0, int it_hi = 1 << 30) {
    LAUNDER_Z();
    unsigned char* wb = wset_base(P, l, zz);
    LAS float* scr = (LAS float*)(lds + wave * 16384);
    constexpr int I_IN = 32 * 129, I_GLU = 16 * 32, I_OUT = 32 * 64, I_G = 32 * 176, I_DN = 88 * 64, NIT = I_IN + I_GLU + I_OUT + 2 * I_G + I_DN;
    const int ihi = it_hi < NIT ? it_hi : NIT;
    for (int it = it_lo + gw; it < ihi; it += NGW) { int r = it;
        if (r < I_IN) { transpose_item(PIN(3) + (size_t)l * DM * DIN, DM, DIN, (bf16_t*)(wb + WO_WIN), LDH, scr, r, lane, PIN(2) + (size_t)l * DM); continue; } r -= I_IN;
        if (r < I_GLU) { transpose_item(PIN(12) + (size_t)l * 1024 * 1024, 1024, 1024, (bf16_t*)(wb + WO_WGLU), LDG, scr, r, lane, nullptr); continue; } r -= I_GLU;
        if (r < I_OUT) { transpose_item(PIN(19) + (size_t)l * DM * DM, DM, DM, (bf16_t*)(wb + WO_WOUT), LDH, scr, r, lane, nullptr); continue; } r -= I_OUT;
        if (r < I_G) { transpose_item(PIN(21) + (size_t)l * DM * DFF, DM, DFF, (bf16_t*)(wb + WO_WGU), LDH, scr, r, lane, PIN(20) + (size_t)l * DM, 1); continue; } r -= I_G;
        if (r < I_G) { transpose_item(PIN(22) + (size_t)l * DM * DFF, DM, DFF, (bf16_t*)(wb + WO_WGU), LDH, scr, r, lane, PIN(20) + (size_t)l * DM, 2); continue; } r -= I_G;
        transpose_item(PIN(25) + (size_t)l * DFF * DM, DFF, DM, (bf16_t*)(wb + WO_WDN), LDF, scr, r, lane, nullptr);
    }
}

__device__ __forceinline__ void phase_s5_scan(const Params& P, int l, int bofs) {
    LAUNDER_Z();
    const int t = tid_l(); if (t >= 128) return;
    const int idx = (bid_l() - bofs) * 128 + t; if (idx >= 16384 || idx < 0) return;
    const int p4 = idx & 15, dir = (idx >> 4) & 1, b = (idx >> 5) & 7, g = idx >> 8;
    const float* t16 = (const float*)(P.ws + zz + 524288) + (((size_t)l * 64 + g) * 2 + dir) * 128 + 4 * p4;
    const f32x4 Lr = *(const f32x4*)t16, Li = *(const f32x4*)(t16 + 64);
    const f32x4* sl = (const f32x4*)((const float*)(P.ws + zz + WS_SLOC) + ((size_t)g * S5ROWP + b * NCH) * 256 + dir * 128 + 4 * p4);
    bf16_t* so = (bf16_t*)(P.ws + zz + WS_UA) + ((size_t)g * S5ROWP + b * NCH) * LDU + 256 + dir * 128 + 4 * p4;
    f32x4 sr = (f32x4){0.f, 0.f, 0.f, 0.f}, si = (f32x4){0.f, 0.f, 0.f, 0.f};
    for (int blk = 0; blk < 11; ++blk) {
        f32x4 xr[12], xi[12];
#pragma unroll
        for (int j = 0; j < 12; ++j) { const int i = blk * 12 + j, n = dir == 0 ? i : NCH - 1 - i; xr[j] = sl[(size_t)n * 64]; xi[j] = sl[(size_t)n * 64 + 16]; }
#pragma unroll
        for (int j = 0; j < 12; ++j) { const int i = blk * 12 + j, n = dir == 0 ? i : NCH - 1 - i;
            u32x2 wr_, wi_; wr_.x = cvt_pk_bf16(sr[0], sr[1]); wr_.y = cvt_pk_bf16(sr[2], sr[3]); wi_.x = cvt_pk_bf16(si[0], si[1]); wi_.y = cvt_pk_bf16(si[2], si[3]);
            *(u32x2*)(so + (size_t)n * LDU) = wr_; *(u32x2*)(so + (size_t)n * LDU + 64) = wi_;
            const f32x4 nr = Lr * sr - Li * si + xr[j], ni = Lr * si + Li * sr + xi[j]; sr = nr; si = ni; }
    }
}

constexpr int MLS = 72;
__device__ __forceinline__ f32x4 mma_tile(const LAS bf16_t* A, const LAS bf16_t* Bt, int fr, int fq, f32x4 acc) {
#pragma unroll
    for (int kk = 0; kk < 2; ++kk) { const bf16x8 a = *(const LAS bf16x8*)(A + fr * MLS + kk * 32 + fq * 8); const bf16x8 b = *(const LAS bf16x8*)(Bt + fr * MLS + kk * 32 + fq * 8);
        acc = __builtin_amdgcn_mfma_f32_16x16x32_bf16(a, b, acc, 0, 0, 0); }
    return acc;
}
__device__ __forceinline__ void phase_mlstm(const Params& P, LAS unsigned char* lds, int l) {
    LAUNDER_Z();
    const int tid = tid_l(), lane = tid & 63, w = tid >> 6, fr = lane & 15, fq = lane >> 4; unsigned char* ws = P.ws + zz;
    LAS bf16_t* Qs = (LAS bf16_t*)lds;
    LAS bf16_t* Ks = Qs + 64 * MLS;
    LAS bf16_t* Kw = Ks + 64 * MLS;
    LAS bf16_t* Ss = Kw + 64 * MLS;
    LAS bf16_t* Vt = Ss + 64 * MLS;
    LAS bf16_t* Ct = Vt + 160 * MLS;
    LAS float* den = (LAS float*)(Ct + 160 * MLS);
    LAS float* CW = den + 64;
    const bf16_t* Z = (const bf16_t*)(ws + WS_Z); const float* Gt = (const float*)(ws + WS_G);
    const int nmb = gridDim.x >= 256 ? 128 : gridDim.x;
    if (bid_l() >= nmb) return;
    for (int item = bid_l(); item < 128; item += nmb) {
        const int dir = item & 1, hd = (item >> 1) & 7, b = item >> 4;
        __syncthreads();
        for (int e = tid; e < 160 * MLS; e += 512) Ct[e] = 0;
        for (int e = tid; e < 32 * MLS; e += 512) Vt[128 * MLS + e] = (e < 64) ? (bf16_t)0x3F80 : (bf16_t)0;
        f32x4 Cst[5];
#pragma unroll
        for (int j = 0; j < 5; ++j) Cst[j] = (f32x4){0.f, 0.f, 0.f, 0.f};
        float m_prev = -1e30f;
        const float gb_i = PIN(17)[l * 32 + (2 * dir) * 8 + hd], gb_f = PIN(17)[l * 32 + (2 * dir + 1) * 8 + hd];
        bf16_t* Hout = (bf16_t*)(ws + WS_HFB) + (size_t)dir * MP * 1024;
        for (int e = tid; e < 512; e += 512) { const int rr = e >> 7, c = e & 127; const int colz = (c < 64 ? hd * 64 + c : 512 + hd * 64 + (c - 64));
            CW[e] = rr < 3 ? PIN(15)[(size_t)l * 3 * 1024 + rr * 1024 + colz] : PIN(16)[(size_t)l * 1024 + colz]; }
        const int wu = __builtin_amdgcn_readfirstlane(w);
        const int colz = (wu < 4 ? hd * 64 + wu * 16 : 512 + hd * 64 + (wu - 4) * 16);
        const int myoff = dir == 0 ? lane : 63 - lane;
        const int gcol_i = (2 * dir) * 8 + hd, gcol_f = (2 * dir + 1) * 8 + hd;
        u32x4 pz[8]; float pg_i, pg_f;
#define ML_PREFETCH(cx) do { const int n_ = dir == 0 ? (cx) : 32 - (cx); const size_t r_ = (size_t)(b * LP + n_ * 64 + myoff); \
            const bf16_t* zp_ = Z + r_ * 3072 + colz; const bf16_t* vp_ = Z + r_ * 3072 + 1024 + hd * 128 + wu * 16; \
            pz[0] = *(const u32x4*)(zp_ - 3072); pz[1] = *(const u32x4*)(zp_ - 3072 + 8); pz[2] = *(const u32x4*)(zp_); pz[3] = *(const u32x4*)(zp_ + 8); \
            pz[4] = *(const u32x4*)(zp_ + 3072); pz[5] = *(const u32x4*)(zp_ + 3072 + 8); pz[6] = *(const u32x4*)(vp_); pz[7] = *(const u32x4*)(vp_ + 8); \
            pg_i = Gt[r_ * 32 + gcol_i]; pg_f = Gt[r_ * 32 + gcol_f]; } while (0)
        ML_PREFETCH(0);
        __syncthreads();
        for (int cix = 0; cix < 33; ++cix) {
            const int n = dir == 0 ? cix : 32 - cix;
            const int rowbase = b * LP + n * 64;
            u32x4 cz[8];
#pragma unroll
            for (int j = 0; j < 8; ++j) cz[j] = pz[j];
            const float cg_i = pg_i, cg_f = pg_f;
            if (cix + 1 < 33) ML_PREFETCH(cix + 1);
            const bool mypad = (n * 64 + myoff) < PADF;
            float li = cg_i + gb_i;
            const float xf = cg_f + gb_f;
            float lf = fminf(xf, 0.f) - __logf(1.0f + __expf(-fabsf(xf)));
            if (mypad) { li = -1e30f; lf = 0.f; }
            const float bc = wave_incl_sum(lf, lane);
            const float gsum = rdlane(bc, 63);
            const float m_loc = rdlane(wave_incl_max(gsum - bc + li, lane), 63);
            const float wloc = __expf(gsum - bc + li - m_loc);
            const float cv = li - bc;
            const float pm = wave_incl_max(cv, lane);
            const float Mt = fmaxf(m_prev, pm);
            const float sint = __expf(m_prev - Mt);
            const float einv = __expf(-(bc + Mt));
            const float m_new = fmaxf(gsum + m_prev, m_loc);
            const float s_old = __expf(gsum + m_prev - m_new), s_loc = __expf(m_loc - m_new);
            {
                const int i = lane; const bool pad = mypad;
                const unsigned um[8] = {cz[0].x, cz[0].y, cz[0].z, cz[0].w, cz[1].x, cz[1].y, cz[1].z, cz[1].w};
                const unsigned u0[8] = {cz[2].x, cz[2].y, cz[2].z, cz[2].w, cz[3].x, cz[3].y, cz[3].z, cz[3].w};
                const unsigned up[8] = {cz[4].x, cz[4].y, cz[4].z, cz[4].w, cz[5].x, cz[5].y, cz[5].z, cz[5].w};
                float qv[16];
#pragma unroll
                for (int j4 = 0; j4 < 4; ++j4) {
                    const f32x4 w0 = *(const LAS f32x4*)(CW + 0 * 128 + wu * 16 + j4 * 4), w1 = *(const LAS f32x4*)(CW + 1 * 128 + wu * 16 + j4 * 4), w2 = *(const LAS f32x4*)(CW + 2 * 128 + wu * 16 + j4 * 4), bb = *(const LAS f32x4*)(CW + 3 * 128 + wu * 16 + j4 * 4);
#pragma unroll
                    for (int jj = 0; jj < 2; ++jj) { const int j = j4 * 2 + jj;
                        const float x0 = bb[2 * jj] + w0[2 * jj] * bf_lo(um[j]) + w1[2 * jj] * bf_lo(u0[j]) + w2[2 * jj] * bf_lo(up[j]);
                        const float x1 = bb[2 * jj + 1] + w0[2 * jj + 1] * bf_hi(um[j]) + w1[2 * jj + 1] * bf_hi(u0[j]) + w2[2 * jj + 1] * bf_hi(up[j]);
                        qv[2 * j] = pad ? 0.f : siluf_(x0); qv[2 * j + 1] = pad ? 0.f : siluf_(x1); } }
                if (wu < 4) {
                    u32x4 o0, o1; o0.x = cvt_pk_bf16(qv[0] * 0.125f, qv[1] * 0.125f); o0.y = cvt_pk_bf16(qv[2] * 0.125f, qv[3] * 0.125f); o0.z = cvt_pk_bf16(qv[4] * 0.125f, qv[5] * 0.125f); o0.w = cvt_pk_bf16(qv[6] * 0.125f, qv[7] * 0.125f);
                    o1.x = cvt_pk_bf16(qv[8] * 0.125f, qv[9] * 0.125f); o1.y = cvt_pk_bf16(qv[10] * 0.125f, qv[11] * 0.125f); o1.z = cvt_pk_bf16(qv[12] * 0.125f, qv[13] * 0.125f); o1.w = cvt_pk_bf16(qv[14] * 0.125f, qv[15] * 0.125f);
                    *(LAS u32x4*)(Qs + i * MLS + wu * 16) = o0; *(LAS u32x4*)(Qs + i * MLS + wu * 16 + 8) = o1;
                } else {
                    const int d0 = (wu - 4) * 16;
                    u32x4 o0, o1; o0.x = cvt_pk_bf16(qv[0], qv[1]); o0.y = cvt_pk_bf16(qv[2], qv[3]); o0.z = cvt_pk_bf16(qv[4], qv[5]); o0.w = cvt_pk_bf16(qv[6], qv[7]);
                    o1.x = cvt_pk_bf16(qv[8], qv[9]); o1.y = cvt_pk_bf16(qv[10], qv[11]); o1.z = cvt_pk_bf16(qv[12], qv[13]); o1.w = cvt_pk_bf16(qv[14], qv[15]);
                    *(LAS u32x4*)(Ks + i * MLS + d0) = o0; *(LAS u32x4*)(Ks + i * MLS + d0 + 8) = o1;
#pragma unroll
                    for (int j = 0; j < 16; ++j) Kw[(d0 + j) * MLS + i] = f2bf(qv[j] * wloc);
                }
                const unsigned uv[8] = {cz[6].x, cz[6].y, cz[6].z, cz[6].w, cz[7].x, cz[7].y, cz[7].z, cz[7].w};
#pragma unroll
                for (int j = 0; j < 8; ++j) { Vt[(wu * 16 + 2 * j) * MLS + i] = pad ? (bf16_t)0 : (bf16_t)(uv[j] & 0xffffu); Vt[(wu * 16 + 2 * j + 1) * MLS + i] = pad ? (bf16_t)0 : (bf16_t)(uv[j] >> 16); }
            }
            __syncthreads();
            {
                const int st = w & 3;
#pragma unroll
                for (int jj = 0; jj < 2; ++jj) { const int tt = (w >> 2) * 2 + jj;
                    f32x4 a = (f32x4){0.f, 0.f, 0.f, 0.f};
                    a = mma_tile(Ks + st * 16 * MLS, Qs + tt * 16 * MLS, fr, fq, a);
                    const int t = tt * 16 + fr, s0 = st * 16 + 4 * fq; const float Mtt = shi(Mt, t);
                    f32x4 o;
#pragma unroll
                    for (int j = 0; j < 4; ++j) { const float cs = shi(cv, s0 + j); o[j] = (s0 + j <= t) ? a[j] * __expf(cs - Mtt) : 0.f; }
                    u32x2 pk; pk.x = cvt_pk_bf16(o[0], o[1]); pk.y = cvt_pk_bf16(o[2], o[3]);
                    *(LAS u32x2*)(Ss + t * MLS + s0) = pk; }
            }
            __syncthreads();
            f32x4 num[5];
            const int tt = w & 3, tC = tt * 16 + fr; const float sint_t = shi(sint, tC), einv_t = shi(einv, tC);
#pragma unroll
            for (int j = 0; j < 5; ++j) { const int dvt = (w >> 2) * 5 + j;
                f32x4 a1 = (f32x4){0.f, 0.f, 0.f, 0.f}, a2 = (f32x4){0.f, 0.f, 0.f, 0.f};
                a1 = mma_tile(Vt + dvt * 16 * MLS, Ss + tt * 16 * MLS, fr, fq, a1);
                a2 = mma_tile(Ct + dvt * 16 * MLS, Qs + tt * 16 * MLS, fr, fq, a2);
                num[j] = a1 + a2 * sint_t;
                if (dvt == 8 && fq == 0) den[tC] = num[j][0]; }
            __syncthreads();
            {
                const float dn = den[tC]; const float inv = __builtin_amdgcn_rcpf(fmaxf(fabsf(dn), einv_t));
                const int off = dir == 0 ? tC : 63 - tC; const size_t r = (size_t)rowbase + off;
#pragma unroll
                for (int j = 0; j < 5; ++j) { const int dvt = (w >> 2) * 5 + j;
                    if (dvt < 8) store_bf4(Hout + r * 1024 + hd * 128 + dvt * 16 + 4 * fq, num[j] * inv); }
            }
            {
                const int dkt = w & 3;
#pragma unroll
                for (int j = 0; j < 5; ++j) { const int dvt = (w >> 2) * 5 + j;
                    f32x4 a = (f32x4){0.f, 0.f, 0.f, 0.f};
                    a = mma_tile(Kw + dkt * 16 * MLS, Vt + dvt * 16 * MLS, fr, fq, a);
                    Cst[j] = Cst[j] * s_old + a * s_loc;
                    u32x2 pk; pk.x = cvt_pk_bf16(Cst[j][0], Cst[j][1]); pk.y = cvt_pk_bf16(Cst[j][2], Cst[j][3]);
                    *(LAS u32x2*)(Ct + (dvt * 16 + fr) * MLS + dkt * 16 + 4 * fq) = pk; }
            }
            m_prev = m_new;
            __syncthreads();
        }
    }
}

__device__ __forceinline__ void phase_finalize(const Params& P, int l) {
    LAUNDER_Z();
    const int tid = tid_l(), lane = tid & 63, gw = bid_l() * 8 + (tid >> 6), NGW = gridDim.x * 8; unsigned char* ws = P.ws + zz;
    const bf16_t* YG = (const bf16_t*)(ws + WS_YGLU); const bf16_t* HF = (const bf16_t*)(ws + WS_HFB); const bf16_t* HB = HF + (size_t)MP * 1024;
    const bf16_t* Z = (const bf16_t*)(ws + WS_Z); bf16_t* Y = (bf16_t*)(ws + WS_Y);
    float g1[16], g2[16];
    { const f32x4* p1 = (const f32x4*)(PIN(14) + (size_t)l * 1024 + lane * 16); const f32x4* p2 = (const f32x4*)(PIN(18) + (size_t)l * 1024 + lane * 16);
#pragma unroll
      for (int j = 0; j < 4; ++j) { const f32x4 a = p1[j], b = p2[j]; g1[4 * j] = a[0]; g1[4 * j + 1] = a[1]; g1[4 * j + 2] = a[2]; g1[4 * j + 3] = a[3]; g2[4 * j] = b[0]; g2[4 * j + 1] = b[1]; g2[4 * j + 2] = b[2]; g2[4 * j + 3] = b[3]; } }
    for (int r = gw; r < MP; r += NGW) {
        u32x4* yo = (u32x4*)(Y + (size_t)r * LDH);
        if ((r % LP) < PADF) { unsigned z0 = 0u; asm volatile("" : "+v"(z0)); for (int j = 0; j < 4; ++j) yo[lane + 64 * j] = (u32x4){z0, z0, z0, z0}; continue; }
        const size_t o = (size_t)r * 1024 + lane * 16;
        const u32x4 f0 = *(const u32x4*)(HF + o), f1 = *(const u32x4*)(HF + o + 8), b0 = *(const u32x4*)(HB + o), b1 = *(const u32x4*)(HB + o + 8);
        const u32x4 q0 = *(const u32x4*)(Z + (size_t)r * 3072 + 2048 + lane * 16), q1 = *(const u32x4*)(Z + (size_t)r * 3072 + 2048 + lane * 16 + 8);
        {
            const u32x4 a0 = *(const u32x4*)(YG + (size_t)r * 1024 + lane * 16), a1 = *(const u32x4*)(YG + (size_t)r * 1024 + lane * 16 + 8);
            const unsigned uu[8] = {a0.x, a0.y, a0.z, a0.w, a1.x, a1.y, a1.z, a1.w}; float v[16]; float s = 0.f;
#pragma unroll
            for (int j = 0; j < 8; ++j) { v[2 * j] = bf_lo(uu[j]); v[2 * j + 1] = bf_hi(uu[j]); s += v[2 * j] * v[2 * j] + v[2 * j + 1] * v[2 * j + 1]; }
            const float rs = __builtin_amdgcn_rsqf(wave_sum(s, lane) * (1.0f / 1024.0f) + EPSN);
            const float* g = g1;
            u32x4 o0, o1; o0.x = cvt_pk_bf16(v[0] * rs * g[0], v[1] * rs * g[1]); o0.y = cvt_pk_bf16(v[2] * rs * g[2], v[3] * rs * g[3]); o0.z = cvt_pk_bf16(v[4] * rs * g[4], v[5] * rs * g[5]); o0.w = cvt_pk_bf16(v[6] * rs * g[6], v[7] * rs * g[7]);
            o1.x = cvt_pk_bf16(v[8] * rs * g[8], v[9] * rs * g[9]); o1.y = cvt_pk_bf16(v[10] * rs * g[10], v[11] * rs * g[11]); o1.z = cvt_pk_bf16(v[12] * rs * g[12], v[13] * rs * g[13]); o1.w = cvt_pk_bf16(v[14] * rs * g[14], v[15] * rs * g[15]);
            yo[lane * 2] = o0; yo[lane * 2 + 1] = o1;
        }
        {
            const unsigned uf[8] = {f0.x, f0.y, f0.z, f0.w, f1.x, f1.y, f1.z, f1.w}, ub[8] = {b0.x, b0.y, b0.z, b0.w, b1.x, b1.y, b1.z, b1.w}, uo[8] = {q0.x, q0.y, q0.z, q0.w, q1.x, q1.y, q1.z, q1.w};
            float v[16]; float s = 0.f;
#pragma unroll
            for (int j = 0; j < 8; ++j) { v[2 * j] = bf_lo(uf[j]) + bf_lo(ub[j]); v[2 * j + 1] = bf_hi(uf[j]) + bf_hi(ub[j]); s += v[2 * j] * v[2 * j] + v[2 * j + 1] * v[2 * j + 1]; }
            s += shx(s, 1, lane); s += shx(s, 2, lane); s += shx(s, 4, lane);
            const float rs = __builtin_amdgcn_rsqf(s * (1.0f / 128.0f) + EPSN);
            const float* g = g2;
            float ov[16];
#pragma unroll
            for (int j = 0; j < 8; ++j) { ov[2 * j] = sigmoidf_(bf_lo(uo[j])) * v[2 * j] * rs * g[2 * j]; ov[2 * j + 1] = sigmoidf_(bf_hi(uo[j])) * v[2 * j + 1] * rs * g[2 * j + 1]; }
            u32x4 o0, o1; o0.x = cvt_pk_bf16(ov[0], ov[1]); o0.y = cvt_pk_bf16(ov[2], ov[3]); o0.z = cvt_pk_bf16(ov[4], ov[5]); o0.w = cvt_pk_bf16(ov[6], ov[7]);
            o1.x = cvt_pk_bf16(ov[8], ov[9]); o1.y = cvt_pk_bf16(ov[10], ov[11]); o1.z = cvt_pk_bf16(ov[12], ov[13]); o1.w = cvt_pk_bf16(ov[14], ov[15]);
            yo[128 + lane * 2] = o0; yo[128 + lane * 2 + 1] = o1;
        }
    }
}

__device__ __forceinline__ void phase_final(const Params& P) {
    LAUNDER_Z();
    const int lane = tid_l() & 63, gw = bid_l() * 8 + (tid_l() >> 6), NGW = gridDim.x * 8;
    const float* H = (const float*)(P.ws + zz + WS_H);
    for (int q = gw; q < NB * 2048; q += NGW) {
        const int b = q >> 11, t = q & 2047; const size_t r = (size_t)b * LP + 64 + t;
        const f32x4* xr = (const f32x4*)(H + r * DM) + lane; const f32x4* gr = (const f32x4*)PIN(26) + lane; f32x4* o = (f32x4*)(P.out + zz + (size_t)q * DM) + lane;
        f32x4 v[8]; float s = 0.f;
#pragma unroll
        for (int j = 0; j < 8; ++j) { v[j] = xr[64 * j]; s += (v[j][0] * v[j][0] + v[j][1] * v[j][1]) + (v[j][2] * v[j][2] + v[j][3] * v[j][3]); }
        const float rs = __builtin_amdgcn_rsqf(wave_sum(s, lane) * (1.0f / DM) + EPSN);
#pragma unroll
        for (int j = 0; j < 8; ++j) o[64 * j] = v[j] * rs * gr[64 * j];
    }
}

#define XB_TMO      128
#define XB_XCNT(j)  (256  + 64 * (j))
#define XB_XSUB(j)  (1280 + 64 * (j))
#define XB_XGEN(j)  (2304 + 64 * (j))
#define XB_TOP      3328
#define XB_TOPGEN   3392
#define XCD_BAR_WORDS 3456
#define XB_SPIN_CAP (1u << 22)
__device__ __forceinline__ unsigned xb_ld(unsigned* p)              { return __hip_atomic_load(p, __ATOMIC_RELAXED, __HIP_MEMORY_SCOPE_AGENT); }
__device__ __forceinline__ unsigned xb_add(unsigned* p, unsigned v) { return __hip_atomic_fetch_add(p, v, __ATOMIC_RELAXED, __HIP_MEMORY_SCOPE_AGENT); }
__device__ __forceinline__ unsigned xb_xcc_id() { return (unsigned)__builtin_amdgcn_s_getreg((3 << 11) | 20) & 0xFu; }
#define XB_SPIN(cond, bar) do { unsigned _sp = 0; while (cond) { __builtin_amdgcn_s_sleep(1); \
    if ((++_sp & 255u) == 0u) { if (xb_ld(&(bar)[XB_TMO])) break; if (_sp > XB_SPIN_CAP) { atomicAdd(&(bar)[XB_TMO], 1u); break; } } } } while (0)
__device__ __forceinline__ void xcd_barrier(unsigned* bar, volatile LAS unsigned* st, unsigned G) {
    asm volatile("s_waitcnt vmcnt(0)" ::: "memory");
    __syncthreads();
    if (tid_l() == 0) {
        __builtin_amdgcn_s_waitcnt(0);
        const unsigned x = xb_xcc_id();
        unsigned nloc = st[0], nx = st[1];
        if (nloc == 0u) {
            unsigned sum, cnt, mine, sp = 0u;
            for (;;) {
                sum = 0u; cnt = 0u; mine = 0u;
#pragma unroll
                for (unsigned j = 0; j < 16; ++j) { const unsigned c = xb_ld(&bar[XB_XCNT(j)]); sum += c; cnt += (c > 0u) ? 1u : 0u; mine = (j == x) ? c : mine; }
                if (sum == G) break;
                __builtin_amdgcn_s_sleep(1);
                if ((++sp & 255u) == 0u) { if (xb_ld(&bar[XB_TMO])) break; if (sp > XB_SPIN_CAP) { atomicAdd(&bar[XB_TMO], 1u); break; } }
            }
            nloc = mine > 0u ? mine : 1u; nx = cnt > 0u ? cnt : 1u; st[0] = nloc; st[1] = nx;
        }
        const unsigned old = xb_add(&bar[XB_XSUB(x)], 1u);
        const unsigned gen = old / nloc;
        if (old + 1u == (gen + 1u) * nloc) {
            __builtin_amdgcn_fence(__ATOMIC_RELEASE, "agent");
            asm volatile("s_waitcnt vmcnt(0)" ::: "memory");
            const unsigned og = xb_add(&bar[XB_TOP], 1u);
            const unsigned tg = og / nx;
            if (og + 1u == (tg + 1u) * nx) xb_add(&bar[XB_TOPGEN], 1u);
            else XB_SPIN(xb_ld(&bar[XB_TOPGEN]) == tg, bar);
            __builtin_amdgcn_fence(__ATOMIC_ACQUIRE, "agent");
            xb_add(&bar[XB_XGEN(x)], 1u);
            asm volatile("s_waitcnt vmcnt(0)" ::: "memory");
        } else {
            XB_SPIN(xb_ld(&bar[XB_XGEN(x)]) == gen, bar);
            __builtin_amdgcn_fence(__ATOMIC_ACQUIRE, "agent");
            asm volatile("s_waitcnt vmcnt(0)" ::: "memory");
        }
    }
    __syncthreads();
}

__global__ void __launch_bounds__(512, 2) mk_fwd(Params P) {
    extern __shared__ __attribute__((aligned(16))) unsigned char lds_raw[];
    LAS unsigned char* lds = (LAS unsigned char*)lds_raw;
    cg::grid_group grid = cg::this_grid();
    volatile LAS unsigned* xst = (volatile LAS unsigned*)(lds + 131072);
    if (threadIdx.x < 4) xst[threadIdx.x] = 0u;
    __syncthreads();
    unsigned char* ws = P.ws;
    for (int ph = P.ph_lo; ph < P.ph_hi; ++ph) {
        if (ph == 0) {
            if (bid_l() == 0) { for (int i = tid_l(); i < 8192 + 1024 + XCD_BAR_WORDS; i += 512) ((unsigned*)ws)[i] = 0u; }
            phase_init_rows(P);
            for (int pr = bid_l(); pr < DEPTH * 64; pr += gridDim.x) s5_precompute(P, lds, pr >> 6, pr & 63);
            __syncthreads();
            convert_weights(P, lds, 0, bid_l() * 8 + (tid_l() >> 6), gridDim.x * 8, tid_l() >> 6, tid_l() & 63);
        }
        else if (ph == NPHASES - 1) phase_final(P);
        else {
            const int l = (ph - 1) / NPH_L, k = (ph - 1) % NPH_L;
            GemmDesc d; d.layer = l; d.nB = 1; d.sA = 0; d.sB = 0; d.A = nullptr; d.Bt = nullptr; d.lda = d.ldb = d.K = 256; d.nM = d.nN = 1; d.epi = 0; d.ssi = 0; d.amode = 0; d.split = 0; d.perm = 0; d.ubase = 0; d.umax = 0x7fffffff; d.gG = gridDim.x; d.gc = bid_l(); bool isg = false;
            const unsigned char* wb = (l & 1) ? (const unsigned char*)P.out : ws + WS_WSET;
            switch (k) {
            case 0: { const int gt = bid_l() * 512 + tid_l(), NGT = gridDim.x * 512; zero_rows16((bf16_t*)(ws + WS_Z) - 3072, 384, gt, NGT); zero_rows16((bf16_t*)(ws + WS_Z) + (size_t)MP * 3072, 384, gt, NGT); }
                d.A = (const bf16_t*)(ws + WS_HN); d.Bt = (const bf16_t*)(wb + WO_WIN); d.lda = LDH; d.ldb = LDH; d.K = DM; d.nM = MP / 256; d.nN = DINP / 256; d.epi = EPI_WIN; d.ssi = 2 * l; d.perm = 1; isg = true; break;
            case 1:
                if (bid_l() < 128) phase_mlstm(P, lds, l);
                else {
                    d.gG = gridDim.x - 128; d.gc = bid_l() - 128;
                    d.A = (const bf16_t*)(ws + WS_UA); d.Bt = (const bf16_t*)(ws + WS_WST) + (size_t)l * 64 * (256 * LDWS); d.lda = LDU; d.ldb = LDWS; d.K = 256; d.nM = S5ROWP / 256; d.nN = 1; d.nB = 64; d.sA = (size_t)S5ROWP * LDU; d.sB = 256 * LDWS; d.epi = EPI_S5A; d.perm = 1;
                    gemm_phase(P, lds, d);
                    xcd_barrier((unsigned*)ws + 8192 + 1024, xst + 2, gridDim.x - 128);
                    phase_s5_scan(P, l, 128);
                    xcd_barrier((unsigned*)ws + 8192 + 1024, xst + 2, gridDim.x - 128);
                    d.Bt = (const bf16_t*)(ws + WS_TO) + (size_t)l * 64 * (256 * LDTO); d.ldb = LDTO; d.K = 512; d.sB = 256 * LDTO; d.epi = EPI_S5C; d.perm = 1;
                    gemm_phase(P, lds, d);
                    xcd_barrier((unsigned*)ws + 8192 + 1024, xst + 2, gridDim.x - 128);
                    d.A = (const bf16_t*)(ws + WS_YGELU); d.Bt = (const bf16_t*)(wb + WO_WGLU); d.lda = LDG; d.ldb = LDG; d.K = 1024; d.nM = MP / 256; d.nN = 4; d.nB = 1; d.sA = 0; d.sB = 0; d.epi = EPI_GLU; d.perm = 1; d.umax = 2 * (gridDim.x - 128); isg = true;
                    if (bid_l() == 128 && tid_l() == 0) __hip_atomic_store((unsigned*)ws + 128, (unsigned)(l + 1), __ATOMIC_RELAXED, __HIP_MEMORY_SCOPE_AGENT);
                }
                break;
            case 2: phase_finalize(P, l); break;
            case 3: d.A = (const bf16_t*)(ws + WS_Y); d.Bt = (const bf16_t*)(wb + WO_WOUT); d.lda = LDH; d.ldb = LDH; d.K = DM; d.nM = MP / 256; d.nN = 8; d.epi = EPI_RES; d.ssi = 2 * l + 1; d.split = 4; d.perm = 1; isg = true; break;
            case 4: d.A = (const bf16_t*)(ws + WS_HN) - LDH; d.Bt = (const bf16_t*)(wb + WO_WGU); d.lda = LDH; d.ldb = LDH; d.K = DM; d.nM = 69; d.nN = 44; d.epi = EPI_FFN; d.ssi = 2 * l + 1; d.amode = 1; d.perm = 1; isg = true; break;
            case 5: d.A = (const bf16_t*)(ws + WS_ACT); d.Bt = (const bf16_t*)(wb + WO_WDN); d.lda = LDF; d.ldb = LDF; d.K = DFF; d.nM = MP / 256; d.nN = 8; d.epi = EPI_RES; d.ssi = 2 * l + 2; d.split = 4; d.perm = 1; isg = true; break;
            }
            if (isg) gemm_phase(P, lds, d);
            if (k == 0 && l + 1 < DEPTH) {
                const int nun = (MP / 256) * (DINP / 256), nbusy = nun - (nun / (int)gridDim.x) * (int)gridDim.x; const int t_ = tid_l(); __syncthreads();
                if (bid_l() >= nbusy) convert_weights(P, lds, l + 1, (bid_l() - nbusy) * 8 + (t_ >> 6), (gridDim.x - nbusy) * 8, t_ >> 6, t_ & 63, 0, CV_SPLIT1);
            }
            if (k == 1 && l + 1 < DEPTH && bid_l() < 128) {
                const int t_ = tid_l(); __syncthreads();
                convert_weights(P, lds, l + 1, bid_l() * 8 + (t_ >> 6), 128 * 8, t_ >> 6, t_ & 63, CV_SPLIT1, CV_SPLIT2);
            }
            if (k == 1 && bid_l() < 128) {
                const int ntail = (MP / 256) * 4 - 2 * ((int)gridDim.x - 128);
                if ((int)bid_l() < ntail) {
                    __syncthreads();
                    if (tid_l() == 0) { unsigned sp = 0; while (__hip_atomic_load((unsigned*)ws + 128, __ATOMIC_RELAXED, __HIP_MEMORY_SCOPE_AGENT) < (unsigned)(l + 1)) { __builtin_amdgcn_s_sleep(4); if (++sp > (1u << 24)) break; }
                        __builtin_amdgcn_fence(__ATOMIC_ACQUIRE, "agent"); asm volatile("s_waitcnt vmcnt(0)" ::: "memory"); }
                    __syncthreads();
                    d.A = (const bf16_t*)(ws + WS_YGELU); d.Bt = (const bf16_t*)(wb + WO_WGLU); d.lda = LDG; d.ldb = LDG; d.K = 1024; d.nM = MP / 256; d.nN = 4; d.nB = 1; d.sA = 0; d.sB = 0; d.epi = EPI_GLU; d.perm = 1;
                    d.ubase = 2 * ((int)gridDim.x - 128); d.umax = 0x7fffffff; d.gG = ntail; d.gc = bid_l();
                    gemm_phase(P, lds, d);
                }
            }
            if (k == 5 && l + 1 < DEPTH) {
                const int nun = (MP / 256) * 8, nfull = (nun / (int)gridDim.x) * (int)gridDim.x, nbusy = (nun - nfull) * 4;
                const int t_ = tid_l(); __syncthreads();
                if (nbusy == 0 || nbusy >= (int)gridDim.x) convert_weights(P, lds, l + 1, bid_l() * 8 + (t_ >> 6), gridDim.x * 8, t_ >> 6, t_ & 63, CV_SPLIT2);
                else if (bid_l() >= nbusy) convert_weights(P, lds, l + 1, (bid_l() - nbusy) * 8 + (t_ >> 6), (gridDim.x - nbusy) * 8, t_ >> 6, t_ & 63, CV_SPLIT2);
            }
        }
        if (ph + 1 < P.ph_hi) { if (ph == 0) { grid.sync(); if (threadIdx.x == 0) { (void)xb_add((unsigned*)ws + 1024 + XB_XCNT(xb_xcc_id()), 1u); if (blockIdx.x >= 128) (void)xb_add((unsigned*)ws + 8192 + 1024 + XB_XCNT(xb_xcc_id()), 1u); } } else xcd_barrier((unsigned*)ws + 1024, xst, gridDim.x); }
    }
}

extern "C" void kernel_launch(void* const* d_in, const int* in_sizes, int n_in, void* d_out, int out_size, void* d_ws, size_t ws_size, hipStream_t stream) {
    static int grid = 0;
    if (grid == 0) {
        int dev = 0, cus = 0, per_cu = 0;
        hipGetDevice(&dev); hipDeviceGetAttribute(&cus, hipDeviceAttributeMultiprocessorCount, dev);
        if (hipFuncSetAttribute((const void*)mk_fwd, hipFuncAttributeMaxDynamicSharedMemorySize, LDS_BYTES) != hipSuccess) { fprintf(stderr, "kernel_launch: hipFuncSetAttribute failed\n"); grid = -1; return; }
        if (hipOccupancyMaxActiveBlocksPerMultiprocessor(&per_cu, (const void*)mk_fwd, 512, LDS_BYTES) != hipSuccess || per_cu < 1) { fprintf(stderr, "kernel_launch: occupancy query says %d\n", per_cu); per_cu = 1; }
        (void)hipGetLastError();
        grid = cus;
        if (ws_size < WS_END) fprintf(stderr, "kernel_launch: workspace too small: %zu < %zu\n", ws_size, (size_t)WS_END);
    }
    if (grid < 0) return;
    Params p{};
    for (int i = 0; i < 27; ++i) p.in[i] = (const float*)d_in[i];
    p.out = (float*)d_out; p.ws = (unsigned char*)d_ws; p.ph_lo = 0; p.ph_hi = NPHASES;
    void* args[] = {&p};
    hipError_t e = hipLaunchCooperativeKernel((const void*)mk_fwd, dim3(grid), dim3(512), args, LDS_BYTES, stream);
    if (e != hipSuccess) fprintf(stderr, "cooperative launch failed: %s (grid %d)\n", hipGetErrorString(e), grid);
}
```

```cpp
#include <hip/hip_runtime.h>
#include <hip/hip_cooperative_groups.h>
#include <cstdio>
namespace cg = cooperative_groups;

#define LAS __attribute__((address_space(3)))
typedef unsigned short bf16_t;
typedef short bf16x8 __attribute__((ext_vector_type(8)));
typedef float f32x4 __attribute__((ext_vector_type(4)));
typedef unsigned u32x4 __attribute__((ext_vector_type(4)));
typedef unsigned u32x2 __attribute__((ext_vector_type(2)));

constexpr int DM = 2048, NB = 8, LP = 2112, PADF = 48, MP = NB * LP;
constexpr int DIN = 4128, DINP = 4352, DFF = 5632, DEPTH = 4;
constexpr int NCH = LP / 16;
constexpr int S5ROWS = NB * NCH;
constexpr int S5ROWP = 1280;
constexpr float EPSN = 1e-6f;
constexpr int LDH = 2112, LDF = 5696, LDG = 1088, LDU = 576, LDWS = 320, LDTO = 576;
constexpr int CV_SPLIT1 = 7075, CV_SPLIT2 = 14150;
constexpr int NPH_L = 6, NPHASES = 2 + DEPTH * NPH_L;

constexpr size_t MiB = 1u << 20;
constexpr size_t WO_WIN = 0 * MiB, WO_WGLU = 18 * MiB, WO_WOUT = 21 * MiB, WO_WGU = 30 * MiB, WO_WDN = 76 * MiB;
constexpr size_t WS_WSET = 1 * MiB;
constexpr size_t WS_WST = 100 * MiB, WS_TO = 140 * MiB, WS_H = 212 * MiB, WS_HN = 344 * MiB + 8192, WS_G = 413 * MiB, WS_Y = 416 * MiB;
constexpr size_t WS_UA = 485 * MiB, WS_Z = 576 * MiB, WS_SLOC = 676 * MiB, WS_YGELU = 676 * MiB, WS_YGLU = 716 * MiB, WS_HFB = 756 * MiB;
constexpr size_t WS_GT = 486 * MiB, WS_ACT = 669 * MiB, WS_SS = 854 * MiB, WS_END = 856 * MiB;
constexpr int LDS_BYTES = 147456;

struct Params { const float* in[27]; float* out; unsigned char* ws; int ph_lo, ph_hi; };

#define LAUNDER_Z() int zz = 0; asm volatile("" : "+s"(zz))
#define PIN(i) (P.in[(i) + zz])
__device__ __forceinline__ int tid_l() { int w = __builtin_amdgcn_readfirstlane(threadIdx.x >> 6); asm volatile("" : "+s"(w)); int ln = __builtin_amdgcn_mbcnt_hi(~0u, __builtin_amdgcn_mbcnt_lo(~0u, 0u)); asm volatile("" : "+v"(ln)); return w * 64 + ln; }
__device__ __forceinline__ int bid_l() { int t = blockIdx.x; asm volatile("" : "+s"(t)); return t; }
__device__ __forceinline__ unsigned cvt_pk_bf16(float lo, float hi) { unsigned r; asm("v_cvt_pk_bf16_f32 %0, %1, %2" : "=v"(r) : "v"(lo), "v"(hi)); return r; }
__device__ __forceinline__ float bf_lo(unsigned w) { return __uint_as_float(w << 16); }
__device__ __forceinline__ float bf_hi(unsigned w) { return __uint_as_float(w & 0xffff0000u); }
__device__ __forceinline__ float bf2f(bf16_t b) { return __uint_as_float((unsigned)b << 16); }
__device__ __forceinline__ bf16_t f2bf(float f) { return (bf16_t)(cvt_pk_bf16(f, 0.f) & 0xffffu); }
__device__ __forceinline__ float sigmoidf_(float x) { return __builtin_amdgcn_rcpf(1.0f + __expf(-x)); }
__device__ __forceinline__ float siluf_(float x) { return x * sigmoidf_(x); }
__device__ __forceinline__ float gelu_tanh(float x) { const float u = 0.7978845608028654f * (x + 0.044715f * x * x * x); return x * __builtin_amdgcn_rcpf(1.0f + __expf(-2.0f * u)); }
__device__ __forceinline__ float shx(float v, int o, int lane) { return __int_as_float(__builtin_amdgcn_ds_bpermute((lane ^ o) << 2, __float_as_int(v))); }
__device__ __forceinline__ float shi(float v, int idx) { return __int_as_float(__builtin_amdgcn_ds_bpermute(idx << 2, __float_as_int(v))); }
__device__ __forceinline__ float wave_sum(float v, int lane) {
#pragma unroll
    for (int o = 1; o < 64; o <<= 1) v += shx(v, o, lane);
    return v;
}
__device__ __forceinline__ float wave_max(float v, int lane) {
#pragma unroll
    for (int o = 1; o < 64; o <<= 1) v = fmaxf(v, shx(v, o, lane));
    return v;
}

__device__ __forceinline__ float dpp_shr(float v, float ident, const int n) {
    switch (n) {
    case 1: return __int_as_float(__builtin_amdgcn_update_dpp(__float_as_int(ident), __float_as_int(v), 0x111, 0xf, 0xf, false));
    case 2: return __int_as_float(__builtin_amdgcn_update_dpp(__float_as_int(ident), __float_as_int(v), 0x112, 0xf, 0xf, false));
    case 4: return __int_as_float(__builtin_amdgcn_update_dpp(__float_as_int(ident), __float_as_int(v), 0x114, 0xf, 0xf, false));
    default: return __int_as_float(__builtin_amdgcn_update_dpp(__float_as_int(ident), __float_as_int(v), 0x118, 0xf, 0xf, false));
    }
}
__device__ __forceinline__ float rdlane(float v, const int l) { return __int_as_float(__builtin_amdgcn_readlane(__float_as_int(v), l)); }
__device__ __forceinline__ float wave_incl_sum(float v, int lane) {
    v += dpp_shr(v, 0.f, 1); v += dpp_shr(v, 0.f, 2); v += dpp_shr(v, 0.f, 4); v += dpp_shr(v, 0.f, 8);
    const float s0 = rdlane(v, 15), s1 = rdlane(v, 31), s2 = rdlane(v, 47); const int q = lane >> 4;
    return v + (q == 0 ? 0.f : (q == 1 ? s0 : (q == 2 ? s0 + s1 : (s0 + s1) + s2)));
}
__device__ __forceinline__ float wave_incl_max(float v, int lane) {
    const float NI = -3.0e38f;
    v = fmaxf(v, dpp_shr(v, NI, 1)); v = fmaxf(v, dpp_shr(v, NI, 2)); v = fmaxf(v, dpp_shr(v, NI, 4)); v = fmaxf(v, dpp_shr(v, NI, 8));
    const float m0 = rdlane(v, 15), m1 = fmaxf(m0, rdlane(v, 31)), m2 = fmaxf(m1, rdlane(v, 47)); const int q = lane >> 4;
    return fmaxf(v, q == 0 ? NI : (q == 1 ? m0 : (q == 2 ? m1 : m2)));
}
constexpr int BM = 256, BK = 64, HALF = 128, HTB = HALF * BK * 2;
__device__ __forceinline__ int lds_byte(int r, int c) { const int st = (r >> 4) * 2 + (c >> 5), rr = r & 15, cc = c & 31, ob = rr * 64 + cc * 2; return st * 1024 + (ob ^ (((ob >> 9) & 1) << 5)); }
__device__ __forceinline__ void stage_rc(int b, int& R, int& C) { const int st = b / 1024, sb = b % 1024, swz = sb ^ (((sb >> 9) & 1) << 5); R = (st >> 1) * 16 + swz / 64; C = (st & 1) * 32 + (swz % 64) / 2; }

struct Unit { int pm, pn, b, piece, tu, k0, nt; };
struct GemmDesc { const bf16_t* A; const bf16_t* Bt; int lda, ldb, K, nM, nN, nB; size_t sA, sB; int epi, layer, ssi, amode, gG, gc, split, ubase, umax, perm; };
enum { EPI_WIN = 0, EPI_S5A = 1, EPI_S5C = 2, EPI_GLU = 3, EPI_RES = 4, EPI_FFN = 5 };

__device__ __forceinline__ bool next_unit(const GemmDesc& d, int i, int G, int c, Unit& u) {
    const int per = d.nM * d.nN; long L = (long)d.ubase + (long)i * G + c; const int ntf = d.K / BK;
    if (L >= d.umax) return false;
    u.piece = -1; u.tu = 0; u.k0 = 0; u.nt = ntf;
    if (d.split > 0) { const int nfull = (per / G) * G;
        if (L >= nfull) { const long q = L - nfull; if (q >= (long)(per - nfull) * d.split) return false;
            u.tu = (int)(q / d.split); u.piece = (int)(q % d.split); u.nt = ntf / d.split; u.k0 = u.piece * u.nt; L = nfull + u.tu; } }
    if (L >= (long)per * d.nB) return false;
    u.b = (int)(L / per); int wgid = (int)(L % per);
    { const int q = per / 8, r = per % 8, xcd = wgid % 8, off = wgid / 8; wgid = (xcd < r ? xcd * (q + 1) : r * (q + 1) + (xcd - r) * q) + off; }
    const int nig = 8 * d.nN, gid = wgid / nig, fm = gid * 8, gsz = (d.nM - fm) < 8 ? (d.nM - fm) : 8;
    u.pm = fm + ((wgid % nig) % gsz); u.pn = (wgid % nig) / gsz; return true;
}

__device__ __forceinline__ void store_bf4(bf16_t* p, f32x4 v) { u32x2 w; w.x = cvt_pk_bf16(v[0], v[1]); w.y = cvt_pk_bf16(v[2], v[3]); *(u32x2*)p = w; }
__device__ __forceinline__ f32x4 load_bf4(const bf16_t* p) { const u32x2 w = *(const u32x2*)p; return (f32x4){bf_lo(w.x), bf_hi(w.x), bf_lo(w.y), bf_hi(w.y)}; }

typedef unsigned long long u64;
constexpr float SSCALE = 16777216.0f;
__device__ __forceinline__ float row_rs(const u64* ss, int r) { return __builtin_amdgcn_rsqf((float)ss[r] * (1.0f / (SSCALE * DM)) + EPSN); }
__device__ __forceinline__ void gemm_epilogue(const Params& P, const GemmDesc& d, const f32x4 (&acc)[2][2][4][2], const Unit& u, int wr, int wc, int fr, int fq) {
    LAUNDER_Z(); unsigned char* ws = P.ws + zz; const int l = d.layer;
    int lane;
    { const int t2 = tid_l(); const int w2 = __builtin_amdgcn_readfirstlane(t2 >> 6); wr = w2 >> 2; wc = w2 & 3; lane = t2 & 63; fr = lane & 15; fq = lane >> 4; }
    const int rbase = u.pm * BM + wr * 64 + fr, cbase = u.pn * BM + wc * 32 + 4 * fq;
    if (d.epi == EPI_RES) {
        const int cb8 = u.pn * BM + wc * 32 + 8 * fq;
        float* hb = (float*)(ws + WS_H) + (size_t)rbase * DM + cb8; bf16_t* nb = (bf16_t*)(ws + WS_HN) + (size_t)rbase * LDH + cb8;
        u64* ssp = (u64*)(ws + WS_SS) + (size_t)d.ssi * MP + rbase;
#pragma unroll
        for (int ai = 0; ai < 2; ++ai)
#pragma unroll
        for (int mh = 0; mh < 2; ++mh) {
            f32x4 t[2][2][2];
            float* hp = hb + (size_t)(ai * HALF + mh * 32) * DM; asm volatile("" : "+v"(hp));
#pragma unroll
            for (int m = 0; m < 2; ++m)
#pragma unroll
                for (int bj = 0; bj < 2; ++bj)
#pragma unroll
                    for (int n = 0; n < 2; ++n) t[m][bj][n] = *(const f32x4*)(hp + (size_t)(m * 16) * DM + bj * HALF + n * 4);
            float sq[2] = {0.f, 0.f};
#pragma unroll
            for (int m = 0; m < 2; ++m)
#pragma unroll
                for (int bj = 0; bj < 2; ++bj)
#pragma unroll
                    for (int n = 0; n < 2; ++n) { const f32x4 hv = t[m][bj][n] + acc[ai][bj][mh * 2 + m][n]; t[m][bj][n] = hv;
                        __builtin_nontemporal_store(hv, (f32x4*)(hp + (size_t)(m * 16) * DM + bj * HALF + n * 4));
                        sq[m] += (hv[0] * hv[0] + hv[1] * hv[1]) + (hv[2] * hv[2] + hv[3] * hv[3]); }
            bf16_t* np = nb + (size_t)(ai * HALF + mh * 32) * LDH; asm volatile("" : "+v"(np));
#pragma unroll
            for (int m = 0; m < 2; ++m) {
#pragma unroll
                for (int bj = 0; bj < 2; ++bj) { u32x4 o; o.x = cvt_pk_bf16(t[m][bj][0][0], t[m][bj][0][1]); o.y = cvt_pk_bf16(t[m][bj][0][2], t[m][bj][0][3]); o.z = cvt_pk_bf16(t[m][bj][1][0], t[m][bj][1][1]); o.w = cvt_pk_bf16(t[m][bj][1][2], t[m][bj][1][3]);
                    *(u32x4*)(np + (size_t)(m * 16) * LDH + bj * HALF) = o; }
                float q = sq[m]; q += shx(q, 16, lane); q += shx(q, 32, lane);
                if (fq == 0) atomicAdd(ssp + ai * HALF + mh * 32 + m * 16, (u64)(q * SSCALE));
            }
        }
        return;
    }
    if (d.epi == EPI_FFN) {
        const int ccol = u.pn * 128 + wc * 32 + 8 * fq;
        const float* cwb = PIN(23) + (size_t)l * 3 * DFF + ccol; const float* cbb = PIN(24) + (size_t)l * DFF + ccol;
        const u64* ssb = (const u64*)(ws + WS_SS) + (size_t)d.ssi * MP;
#pragma unroll
        for (int ai = 0; ai < 2; ++ai) {
            const int row0 = u.pm * 248 + (ai * 2 + wr) * 62 - 1 + fr;
            float rsv[4];
#pragma unroll
            for (int m = 0; m < 4; ++m) { int rc = row0 + m * 16; rc = rc < 0 ? 0 : (rc > MP - 1 ? MP - 1 : rc); rsv[m] = row_rs(ssb, rc); }
            bf16_t* ab = (bf16_t*)(ws + WS_ACT) + (size_t)row0 * LDF + ccol;
            u32x2 keep[4];
#pragma unroll
            for (int n = 0; n < 2; ++n) {
                const f32x4 w0 = *(const f32x4*)(cwb + n * 4), w1 = *(const f32x4*)(cwb + DFF + n * 4), w2 = *(const f32x4*)(cwb + 2 * DFF + n * 4), cb = *(const f32x4*)(cbb + n * 4);
                f32x4 X[4], RR[4], RL[4];
#pragma unroll
                for (int m = 0; m < 4; ++m) { X[m] = acc[ai][0][m][n] * rsv[m];
#pragma unroll
                    for (int j = 0; j < 4; ++j) { RR[m][j] = __int_as_float(__builtin_amdgcn_update_dpp(0, __float_as_int(X[m][j]), 0x121, 0xf, 0xf, false));
                                                  RL[m][j] = __int_as_float(__builtin_amdgcn_update_dpp(0, __float_as_int(X[m][j]), 0x12f, 0xf, 0xf, false)); } }
#pragma unroll
                for (int m = 0; m < 4; ++m) {
                    const f32x4 prev = (fr > 0) ? RR[m] : RR[m > 0 ? m - 1 : 0];
                    const f32x4 next = (fr < 15) ? RL[m] : RL[m < 3 ? m + 1 : 3];
                    const f32x4 gt = cb + w0 * prev + w1 * X[m] + w2 * next; const f32x4 v = acc[ai][1][m][n] * rsv[m];
                    const int lr = m * 16 + fr, row = row0 + m * 16;
                    const f32x4 ex = gt * (-1.4426950408889634f);
                    f32x4 dn; dn[0] = __builtin_amdgcn_exp2f(ex[0]); dn[1] = __builtin_amdgcn_exp2f(ex[1]); dn[2] = __builtin_amdgcn_exp2f(ex[2]); dn[3] = __builtin_amdgcn_exp2f(ex[3]);
                    dn = dn + 1.0f;
                    f32x4 rc; rc[0] = __builtin_amdgcn_rcpf(dn[0]); rc[1] = __builtin_amdgcn_rcpf(dn[1]); rc[2] = __builtin_amdgcn_rcpf(dn[2]); rc[3] = __builtin_amdgcn_rcpf(dn[3]);
                    const f32x4 o4 = (gt * v) * rc;
                    u32x2 pk; pk.x = cvt_pk_bf16(o4[0], o4[1]); pk.y = cvt_pk_bf16(o4[2], o4[3]);
                    if (n == 0) keep[m] = pk;
                    else if (lr >= 1 && lr <= 62 && row < MP) { u32x4 o; o.x = keep[m].x; o.y = keep[m].y; o.z = pk.x; o.w = pk.y; __builtin_nontemporal_store(o, (u32x4*)(ab + (size_t)(m * 16) * LDF)); } }
            }
        }
        return;
    }
    if (d.epi == EPI_GLU) {
        const int c8 = u.pn * BM + wc * 32 + 8 * fq;
        const bf16_t* yb = (const bf16_t*)(ws + WS_YGELU) + (size_t)rbase * LDG + c8; bf16_t* ob = (bf16_t*)(ws + WS_YGLU) + (size_t)rbase * 1024 + c8;
        const float* bb = PIN(13) + (size_t)l * 1024 + c8;
#pragma unroll
        for (int bj = 0; bj < 2; ++bj) {
            f32x4 bg[2];
#pragma unroll
            for (int n = 0; n < 2; ++n) bg[n] = *(const f32x4*)(bb + bj * HALF + n * 4);
#pragma unroll
            for (int ai = 0; ai < 2; ++ai) {
                u32x4 y[4];
                const bf16_t* yq = yb + (size_t)(ai * HALF) * LDG + bj * HALF; asm volatile("" : "+v"(yq));
#pragma unroll
                for (int m = 0; m < 4; ++m) y[m] = *(const u32x4*)(yq + (size_t)(m * 16) * LDG);
#pragma unroll
                for (int m = 0; m < 4; ++m) { const f32x4 v0 = acc[ai][bj][m][0] + bg[0], v1 = acc[ai][bj][m][1] + bg[1]; const u32x4 yy = y[m]; u32x4 o;
                    o.x = cvt_pk_bf16(bf_lo(yy.x) * sigmoidf_(v0[0]), bf_hi(yy.x) * sigmoidf_(v0[1])); o.y = cvt_pk_bf16(bf_lo(yy.y) * sigmoidf_(v0[2]), bf_hi(yy.y) * sigmoidf_(v0[3]));
                    o.z = cvt_pk_bf16(bf_lo(yy.z) * sigmoidf_(v1[0]), bf_hi(yy.z) * sigmoidf_(v1[1])); o.w = cvt_pk_bf16(bf_lo(yy.w) * sigmoidf_(v1[2]), bf_hi(yy.w) * sigmoidf_(v1[3]));
                    *(u32x4*)(ob + (size_t)(ai * HALF + m * 16) * 1024 + bj * HALF) = o; }
            }
        }
        return;
    }
    if (d.epi == EPI_S5A) {
        float* sb = (float*)(ws + WS_SLOC) + ((size_t)u.b * S5ROWP + rbase) * 256 + wc * 32 + 8 * fq;
#pragma unroll
        for (int ai = 0; ai < 2; ++ai)
#pragma unroll
        for (int m = 0; m < 4; ++m) {
            float* sp = sb + (size_t)(ai * HALF + m * 16) * 256;
#pragma unroll
            for (int bj = 0; bj < 2; ++bj) { *(f32x4*)(sp + bj * HALF) = acc[ai][bj][m][0]; *(f32x4*)(sp + bj * HALF + 4) = acc[ai][bj][m][1]; }
        }
        return;
    }
    if (d.epi == EPI_S5C) {
#pragma unroll
        for (int ai = 0; ai < 2; ++ai)
#pragma unroll
        for (int m = 0; m < 4; ++m) {
            const int r = rbase + ai * HALF + m * 16;
            if (r < S5ROWS) { const int b = r / NCH, nn = r - b * NCH;
#pragma unroll
                for (int bj = 0; bj < 2; ++bj) { const int c8 = bj * HALF + wc * 32 + 8 * fq, tl = c8 >> 4, ch = c8 & 15; const size_t row = (size_t)b * LP + nn * 16 + tl;
                    const f32x4 v0 = acc[ai][bj][m][0], v1 = acc[ai][bj][m][1]; u32x4 o;
                    o.x = cvt_pk_bf16(gelu_tanh(v0[0]), gelu_tanh(v0[1])); o.y = cvt_pk_bf16(gelu_tanh(v0[2]), gelu_tanh(v0[3])); o.z = cvt_pk_bf16(gelu_tanh(v1[0]), gelu_tanh(v1[1])); o.w = cvt_pk_bf16(gelu_tanh(v1[2]), gelu_tanh(v1[3]));
                    *(u32x4*)((bf16_t*)(ws + WS_YGELU) + row * LDG + u.b * 16 + ch) = o; } }
        }
        return;
    }
    if (d.epi == EPI_WIN) {
        const u64* ssb = (const u64*)(ws + WS_SS) + (size_t)d.ssi * MP;
#pragma unroll
        for (int ai = 0; ai < 2; ++ai)
#pragma unroll
        for (int m = 0; m < 4; ++m) {
            const int r = rbase + ai * HALF + m * 16; const float rsc = row_rs(ssb, r);
#pragma unroll
            for (int bj = 0; bj < 2; ++bj) {
                const int c8 = u.pn * BM + bj * HALF + wc * 32 + 8 * fq;
                const f32x4 v0 = acc[ai][bj][m][0] * rsc, v1 = acc[ai][bj][m][1] * rsc;
                if (u.pn < 16) { u32x4 o; o.x = cvt_pk_bf16(v0[0], v0[1]); o.y = cvt_pk_bf16(v0[2], v0[3]); o.z = cvt_pk_bf16(v1[0], v1[1]); o.w = cvt_pk_bf16(v1[2], v1[3]);
                    if (u.pn < 4) { const int g = c8 >> 4, ch = c8 & 15, b = r / LP, pos = r - b * LP, cr = b * NCH + (pos >> 4), tl = pos & 15;
                        *(u32x4*)((bf16_t*)(ws + WS_UA) + ((size_t)g * S5ROWP + cr) * LDU + tl * 16 + ch) = o; }
                    else *(u32x4*)((bf16_t*)(ws + WS_Z) + (size_t)r * 3072 + (c8 - 1024)) = o; }
                else if (c8 - 4096 < 32) { float* gp = (float*)(ws + WS_G) + (size_t)r * 32 + (c8 - 4096); *(f32x4*)gp = v0; *(f32x4*)(gp + 4) = v1; }
            }
        }
        return;
    }
#pragma unroll
    for (int ai = 0; ai < 2; ++ai)
#pragma unroll
    for (int m = 0; m < 4; ++m) {
        const int r = rbase + ai * HALF + m * 16;
        const float rsc = (d.epi == EPI_WIN) ? row_rs((const u64*)(ws + WS_SS) + (size_t)d.ssi * MP, r) : 1.0f;
#pragma unroll
        for (int bj = 0; bj < 2; ++bj)
#pragma unroll
        for (int n = 0; n < 2; ++n) {
            const int c0 = cbase + bj * HALF + n * 16;
            const f32x4 v = acc[ai][bj][m][n] * rsc;
            switch (d.epi) {
            case EPI_WIN: {
                if (u.pn < 4) { const int g = c0 >> 4, ch = c0 & 15, b = r / LP, pos = r - b * LP, cr = b * NCH + (pos >> 4), tl = pos & 15;
                    store_bf4((bf16_t*)(ws + WS_UA) + ((size_t)g * S5ROWP + cr) * LDU + tl * 16 + ch, v); }
                else if (u.pn < 16) store_bf4((bf16_t*)(ws + WS_Z) + (size_t)r * 3072 + (c0 - 1024), v);
                else if (c0 - 4096 < 32) *(f32x4*)((float*)(ws + WS_G) + (size_t)r * 32 + (c0 - 4096)) = v;
            } break;
            case EPI_S5A: *(f32x4*)((float*)(ws + WS_SLOC) + ((size_t)u.b * S5ROWP + r) * 256 + c0) = v; break;
            case EPI_S5C: {
                if (r < S5ROWS) { const int b = r / NCH, nn = r - b * NCH, tl = c0 >> 4, ch = c0 & 15; const size_t row = (size_t)b * LP + nn * 16 + tl;
                    store_bf4((bf16_t*)(ws + WS_YGELU) + row * LDG + u.b * 16 + ch, (f32x4){gelu_tanh(v[0]), gelu_tanh(v[1]), gelu_tanh(v[2]), gelu_tanh(v[3])}); }
            } break;
            default: break;
            }
        }
    }
}

__device__ __forceinline__ void gemm_phase(const Params& P, LAS unsigned char* lds, const GemmDesc d) {
    const int tid = tid_l(), wid = __builtin_amdgcn_readfirstlane(tid >> 6), lane = tid & 63, wr = wid >> 2, wc = wid & 3, fr = lane & 15, fq = lane >> 4;
    const int K = d.K, nt = K / BK; const int G = d.gG, cblk = d.gc;
    unsigned voffA[2], voffB[2];
#pragma unroll
    for (int i = 0; i < 2; ++i) { int R, C; stage_rc(tid * 16 + i * 8192, R, C); const int Ra = (d.amode && R >= 64) ? R - 2 : R; voffA[i] = (unsigned)(Ra * d.lda + C) * 2u; const int Rb = d.perm ? ((R & ~31) + 8 * ((R & 15) >> 2) + 4 * ((R & 31) >> 4) + (R & 3)) : R; voffB[i] = (unsigned)(Rb * d.ldb + C) * 2u; }
    const size_t kstep = (size_t)(BK * 2);
    const size_t hstepA = (size_t)(d.amode ? 124 : HALF) * d.lda * 2, hstepB = (size_t)HALF * d.ldb * 2;
    const unsigned ldsw = (unsigned)wid * 1024u;
    const int aoff = lds_byte(wr * 64 + fr, fq * 8), boff = lds_byte(wc * 32 + fr, fq * 8);
#define PG8_SA(b, h) (((b) * 2 + (h)) * HTB)
#define PG8_SB(b, h) ((4 + (b) * 2 + (h)) * HTB)
#define PG8_STAGE(bufoff, gbase, voff) do { _Pragma("unroll") for (int _i = 0; _i < 2; ++_i) \
        __builtin_amdgcn_global_load_lds((const unsigned*)((const char*)(gbase) + (voff)[_i]), (LAS unsigned*)(lds + (bufoff) + ldsw + _i * 8192), 16, 0, 0); } while (0)
#define PG8_LDA(dst, b, h) do { _Pragma("unroll") for (int m = 0; m < 4; ++m) _Pragma("unroll") for (int k = 0; k < 2; ++k) dst[m][k] = *(const LAS bf16x8*)(lds + PG8_SA(b, h) + aoff + m * 2048 + k * 1024); } while (0)
#define PG8_LDB(dst, b, h) do { _Pragma("unroll") for (int n = 0; n < 2; ++n) _Pragma("unroll") for (int k = 0; k < 2; ++k) dst[n][k] = *(const LAS bf16x8*)(lds + PG8_SB(b, h) + boff + n * 2048 + k * 1024); } while (0)
#define PG8_MMA(ai, bj, At, Bt) do { __builtin_amdgcn_s_setprio(1); _Pragma("unroll") for (int m = 0; m < 4; ++m) _Pragma("unroll") for (int n = 0; n < 2; ++n) _Pragma("unroll") for (int k = 0; k < 2; ++k) \
        acc[ai][bj][m][n] = __builtin_amdgcn_mfma_f32_16x16x32_bf16(Bt[n][k], At[m][k], acc[ai][bj][m][n], 0, 0, 0); __builtin_amdgcn_s_setprio(0); } while (0)
#define PG8_WAIT_V(n) asm volatile("s_waitcnt vmcnt(" #n ")" ::: "memory")
#define PG8_WAIT_L(n) asm volatile("s_waitcnt lgkmcnt(" #n ")" ::: "memory")
#define PG8_BAR __builtin_amdgcn_s_barrier()
#define PG8_SCHED __builtin_amdgcn_sched_barrier(0)
    Unit cur, nxt; int ui = 0;
    if (!next_unit(d, 0, G, cblk, cur)) return;
    f32x4 acc[2][2][4][2];
#pragma unroll
    for (int a = 0; a < 2; ++a)
#pragma unroll
        for (int b = 0; b < 2; ++b)
#pragma unroll
            for (int m = 0; m < 4; ++m)
#pragma unroll
                for (int n = 0; n < 2; ++n) acc[a][b][m][n] = (f32x4){0.f, 0.f, 0.f, 0.f};
    bf16x8 At[4][2], B0[2][2], B1[2][2];
    const char* cA = (const char*)d.A + ((size_t)cur.b * d.sA) * 2 + (size_t)cur.pm * 2 * hstepA + (size_t)cur.k0 * kstep;
    const char* cB = (const char*)d.Bt + ((size_t)cur.b * d.sB) * 2 + (size_t)cur.pn * 2 * hstepB + (size_t)cur.k0 * kstep;
    PG8_STAGE(PG8_SB(0, 0), cB, voffB); PG8_STAGE(PG8_SA(0, 0), cA, voffA); PG8_STAGE(PG8_SB(0, 1), cB + hstepB, voffB); PG8_STAGE(PG8_SA(0, 1), cA + hstepA, voffA);
    if (wr == 1) PG8_BAR;
    PG8_WAIT_V(4); PG8_BAR;
    PG8_STAGE(PG8_SB(1, 0), cB + kstep, voffB); PG8_STAGE(PG8_SA(1, 0), cA + kstep, voffA); PG8_STAGE(PG8_SB(1, 1), cB + hstepB + kstep, voffB);
    PG8_WAIT_V(6); PG8_BAR;
    for (;;) {
        const bool has_next = next_unit(d, ui + 1, G, cblk, nxt);
        const char* nA = has_next ? (const char*)d.A + ((size_t)nxt.b * d.sA) * 2 + (size_t)nxt.pm * 2 * hstepA + (size_t)nxt.k0 * kstep : cA;
        const char* nB = has_next ? (const char*)d.Bt + ((size_t)nxt.b * d.sB) * 2 + (size_t)nxt.pn * 2 * hstepB + (size_t)nxt.k0 * kstep : cB;
        const int ntu = cur.nt;
        for (int t = 0; t < ntu; t += 2) {
            const bool last = (t == ntu - 2);
            const char* a1 = cA + (size_t)(t + 1) * kstep;
            const char* a2 = last ? nA : cA + (size_t)(t + 2) * kstep; const char* b2 = last ? nB : cB + (size_t)(t + 2) * kstep;
            const char* a3 = a2 + kstep; const char* b3 = b2 + kstep;
            PG8_LDB(B0, 0, 0); PG8_SCHED; PG8_LDA(At, 0, 0); PG8_STAGE(PG8_SA(1, 1), a1 + hstepA, voffA);
            PG8_WAIT_L(8); PG8_BAR; PG8_WAIT_L(0); PG8_MMA(0, 0, At, B0); PG8_BAR; PG8_SCHED;
            PG8_LDB(B1, 0, 1); PG8_STAGE(PG8_SB(0, 0), b2, voffB);
            PG8_BAR; PG8_WAIT_L(0); PG8_MMA(0, 1, At, B1); PG8_BAR;
            PG8_LDA(At, 0, 1); PG8_STAGE(PG8_SA(0, 0), a2, voffA);
            PG8_BAR; PG8_WAIT_L(0); PG8_MMA(1, 0, At, B0); PG8_BAR; PG8_SCHED;
            PG8_STAGE(PG8_SB(0, 1), b2 + hstepB, voffB);
            PG8_WAIT_V(6); PG8_BAR; PG8_MMA(1, 1, At, B1); PG8_BAR;
            PG8_LDB(B0, 1, 0); PG8_SCHED; PG8_LDA(At, 1, 0); PG8_STAGE(PG8_SA(0, 1), a2 + hstepA, voffA);
            PG8_WAIT_L(8); PG8_BAR; PG8_WAIT_L(0); PG8_MMA(0, 0, At, B0); PG8_BAR; PG8_SCHED;
            PG8_LDB(B1, 1, 1); PG8_STAGE(PG8_SB(1, 0), b3, voffB);
            PG8_BAR; PG8_WAIT_L(0); PG8_MMA(0, 1, At, B1); PG8_BAR;
            PG8_LDA(At, 1, 1); PG8_STAGE(PG8_SA(1, 0), a3, voffA);
            PG8_BAR; PG8_WAIT_L(0); PG8_MMA(1, 0, At, B0); PG8_BAR; PG8_SCHED;
            PG8_STAGE(PG8_SB(1, 1), b3 + hstepB, voffB);
            PG8_WAIT_V(6); PG8_BAR; PG8_MMA(1, 1, At, B1); PG8_BAR;
        }
        bool do_epi = true;
        if (cur.piece >= 0) {
            LAUNDER_Z();
            const int t3 = tid_l(); const int w3 = __builtin_amdgcn_readfirstlane(t3 >> 6), l3 = t3 & 63;
            const size_t pstride = (size_t)8 * 32 * 64;
            f32x4* slab = (f32x4*)(P.ws + zz + WS_UA) + ((size_t)(cur.tu * d.split) * 8 + w3) * 32 * 64 + l3;
            {   f32x4* mine = slab + (size_t)cur.piece * pstride;
#pragma unroll
                for (int idx = 0; idx < 32; ++idx) { asm volatile("global_store_dwordx4 %0, %1, off sc1\n\ts_nop 1" :: "v"(mine), "v"(acc[idx >> 4][(idx >> 3) & 1][(idx >> 1) & 3][idx & 1]) : "memory"); mine += 64; } }
            asm volatile("s_waitcnt vmcnt(0)" ::: "memory");
            unsigned old = 0u;
            if (l3 == 0) old = __hip_atomic_fetch_add((unsigned*)(P.ws + zz) + 8192 + cur.tu * 8 + w3, 1u, __ATOMIC_RELAXED, __HIP_MEMORY_SCOPE_AGENT);
            old = (unsigned)__builtin_amdgcn_readfirstlane((int)old);
            do_epi = ((old % (unsigned)d.split) == (unsigned)d.split - 1u);
            if (do_epi) {
                __builtin_amdgcn_fence(__ATOMIC_ACQUIRE, "agent");
                asm volatile("s_waitcnt vmcnt(0)" ::: "memory");
                const f32x4* p = slab;
#pragma unroll
                for (int i4 = 0; i4 < 8; ++i4) { f32x4 t4[4][4];
#pragma unroll
                    for (int j = 0; j < 4; ++j) { asm volatile("" : "+v"(p));
#pragma unroll
                        for (int q = 0; q < 4; ++q) t4[j][q] = p[(size_t)q * pstride];
                        p += 64; }
#pragma unroll
                    for (int j = 0; j < 4; ++j) { const int idx = i4 * 4 + j; acc[idx >> 4][(idx >> 3) & 1][(idx >> 1) & 3][idx & 1] = ((t4[j][0] + t4[j][1]) + t4[j][2]) + t4[j][3]; } }
            }
        }
        if (do_epi) gemm_epilogue(P, d, acc, cur, wr, wc, fr, fq);
        if (!has_next) break;
#pragma unroll
        for (int a = 0; a < 2; ++a)
#pragma unroll
            for (int b = 0; b < 2; ++b)
#pragma unroll
                for (int m = 0; m < 4; ++m)
#pragma unroll
                    for (int n = 0; n < 2; ++n) acc[a][b][m][n] = (f32x4){0.f, 0.f, 0.f, 0.f};
        cur = nxt; cA = nA; cB = nB; ++ui;
    }
    PG8_WAIT_V(0);
    if (wr == 0) PG8_BAR;
    PG8_BAR;
#undef PG8_SA
#undef PG8_SB
#undef PG8_STAGE
#undef PG8_LDA
#undef PG8_LDB
#undef PG8_MMA
#undef PG8_WAIT_V
#undef PG8_WAIT_L
#undef PG8_BAR
#undef PG8_SCHED
}

__device__ __forceinline__ void transpose_item(const float* W, int K, int N, bf16_t* WT, int ldw, LAS float* scr, int item, int lane, const float* gsc, int rowmap = 0) {
    const int nblk = N / 32, kb = item / nblk, nb = item % nblk, k0 = 64 * kb, n0 = 32 * nb;
    float wv[32];
#pragma unroll
    for (int i = 0; i < 32; ++i) { const int kk = 2 * i + (lane >> 5); wv[i] = W[(size_t)(k0 + kk) * N + n0 + (lane & 31)]; }
#pragma unroll
    for (int i = 0; i < 32; ++i) { const int kk = 2 * i + (lane >> 5); const float gg = gsc ? gsc[k0 + kk] : 1.0f; scr[kk * 33 + (lane & 31)] = wv[i] * gg; }
    asm volatile("s_waitcnt lgkmcnt(0)" ::: "memory");
    const int c = lane & 7;
#pragma unroll
    for (int j = 0; j < 4; ++j) { const int n = (lane >> 3) + 8 * j; const LAS float* s = scr + (8 * c) * 33 + n;
        u32x4 o; o.x = cvt_pk_bf16(s[0 * 33], s[1 * 33]); o.y = cvt_pk_bf16(s[2 * 33], s[3 * 33]); o.z = cvt_pk_bf16(s[4 * 33], s[5 * 33]); o.w = cvt_pk_bf16(s[6 * 33], s[7 * 33]);
        const int nr = n0 + n; const int dr = rowmap ? ((nr >> 7) * 256 + (nr & 127) + (rowmap == 2 ? 128 : 0)) : nr;
        *(u32x4*)(WT + (size_t)dr * ldw + k0 + 8 * c) = o; }
    asm volatile("s_waitcnt lgkmcnt(0)" ::: "memory");
}

__device__ __forceinline__ void norm_row_bf16(const float* hrow, const float* g, bf16_t* orow, int lane, bool pad) {
    u32x2* o8 = (u32x2*)orow + lane;
    if (pad) {
#pragma unroll
        for (int j = 0; j < 8; ++j) o8[64 * j] = (u32x2){0u, 0u};
        return; }
    const f32x4* xr = (const f32x4*)hrow + lane; const f32x4* gr = (const f32x4*)g + lane;
    f32x4 v[8]; float s = 0.f;
#pragma unroll
    for (int j = 0; j < 8; ++j) { v[j] = xr[64 * j]; s += (v[j][0] * v[j][0] + v[j][1] * v[j][1]) + (v[j][2] * v[j][2] + v[j][3] * v[j][3]); }
    const float rs = __builtin_amdgcn_rsqf(wave_sum(s, lane) * (1.0f / DM) + EPSN);
#pragma unroll
    for (int j = 0; j < 8; ++j) { const f32x4 gg = gr[64 * j]; u32x2 w; w.x = cvt_pk_bf16(v[j][0] * rs * gg[0], v[j][1] * rs * gg[1]); w.y = cvt_pk_bf16(v[j][2] * rs * gg[2], v[j][3] * rs * gg[3]); o8[64 * j] = w; }
}

__device__ __forceinline__ void zero_rows16(void* p, int n16, int gt, int NGT) { unsigned z0 = 0u; asm volatile("" : "+v"(z0)); u32x4* z = (u32x4*)p; for (int i = gt; i < n16; i += NGT) z[i] = (u32x4){z0, z0, z0, z0}; }
__device__ __forceinline__ void phase_init_rows(const Params& P) {
    LAUNDER_Z();
    const int lane = tid_l() & 63, gw = bid_l() * 8 + (tid_l() >> 6), NGW = gridDim.x * 8;
    float* H = (float*)(P.ws + zz + WS_H); bf16_t* HN = (bf16_t*)(P.ws + zz + WS_HN); u64* SS = (u64*)(P.ws + zz + WS_SS);
    float zf = 0.f; asm volatile("" : "+v"(zf));
    for (int r = gw; r < MP; r += NGW) {
        const int b = r / LP, pos = r - b * LP; f32x4* o = (f32x4*)(H + (size_t)r * DM) + lane; u32x2* o8 = (u32x2*)(HN + (size_t)r * LDH) + lane;
        if (pos < PADF) {
#pragma unroll
            for (int j = 0; j < 8; ++j) { o[64 * j] = (f32x4){zf, zf, zf, zf}; o8[64 * j] = (u32x2){__float_as_uint(zf), __float_as_uint(zf)}; }
            if (lane == 0) SS[r] = (u64)__float_as_uint(zf);
        } else {
            const float* src = pos < 64 ? PIN(1) + (size_t)(pos - PADF) * DM : PIN(0) + ((size_t)b * 2048 + (pos - 64)) * DM;
            const f32x4* s4 = (const f32x4*)src + lane; float sq = 0.f;
#pragma unroll
            for (int j = 0; j < 8; ++j) { const f32x4 v = s4[64 * j]; o[64 * j] = v; u32x2 w; w.x = cvt_pk_bf16(v[0], v[1]); w.y = cvt_pk_bf16(v[2], v[3]); o8[64 * j] = w; sq += (v[0] * v[0] + v[1] * v[1]) + (v[2] * v[2] + v[3] * v[3]); }
            sq = wave_sum(sq, lane); if (lane == 0) SS[r] = (u64)(sq * SSCALE);
        }
    }
    const int gt = bid_l() * 512 + tid_l(), NGT = gridDim.x * 512;
    for (int i = gt; i < 8 * MP; i += NGT) SS[MP + i] = (u64)__float_as_uint(zf);
    zero_rows16((bf16_t*)(P.ws + zz + WS_HN) - LDH, LDH / 8, gt, NGT); zero_rows16((bf16_t*)(P.ws + zz + WS_HN) + (size_t)MP * LDH, 256 * LDH / 8, gt, NGT);
    zero_rows16((bf16_t*)(P.ws + zz + WS_WSET + WO_WIN) + (size_t)DIN * LDH, (DINP - DIN) * LDH / 8, gt, NGT);
    zero_rows16((bf16_t*)((unsigned char*)P.out + zz + WO_WIN) + (size_t)DIN * LDH, (DINP - DIN) * LDH / 8, gt, NGT);
}

__device__ __forceinline__ void s5_precompute(const Params& P, LAS unsigned char* lds, int l, int g) {
    LAS float* lpr = (LAS float*)lds;
    LAS float* lpi = lpr + 2 * 17 * 64;
    LAS float* bbr = lpi + 2 * 17 * 64;
    LAS float* bbi = bbr + 2048;
    LAS float* ccr = bbi + 2048;
    LAS float* cci = ccr + 2048;
    LAS float* zr = cci + 2048;
    LAS float* zi = zr + 128;
    LAS float* kd = zi + 128;
    LAUNDER_Z();
    const int tid = tid_l();
    if (tid < 128) {
        const int dir = tid >> 6, p = tid & 63; const size_t o = ((size_t)(l * 2 + dir) * 64 + g) * 64 + p;
        const float are = fminf(PIN(4)[o], -1e-4f), aim = PIN(5)[o], dt = expf(PIN(6)[(size_t)(l * 2 + dir) * 64 + g]);
        const float mag = expf(are * dt); float sn, cs; sincosf(aim * dt, &sn, &cs); const float lr = mag * cs, li = mag * sn;
        { float pr = 1.0f, pi = 0.0f;
          for (int dd = 0; dd <= 16; ++dd) { lpr[(dir * 17 + dd) * 64 + p] = pr; lpi[(dir * 17 + dd) * 64 + p] = pi; const float nr = pr * lr - pi * li, ni = pr * li + pi * lr; pr = nr; pi = ni; } }
        { float* t16 = (float*)(P.ws + zz + 524288) + (((size_t)l * 64 + g) * 2 + dir) * 128; t16[p] = lpr[(dir * 17 + 16) * 64 + p]; t16[64 + p] = lpi[(dir * 17 + 16) * 64 + p]; }
        const float den = are * are + aim * aim, pp = lr - 1.0f;
        zr[dir * 64 + p] = (pp * are + li * aim) / den; zi[dir * 64 + p] = (li * are - pp * aim) / den;
    }
    __syncthreads();
    for (int e = tid; e < 2048; e += 512) { const int dir = e >> 10, p = (e >> 4) & 63, h = e & 15; const size_t o = (((size_t)(l * 2 + dir) * 64 + g) * 64 + p) * 16 + h;
        const float br = PIN(7)[o], bi = PIN(8)[o], z_r = zr[dir * 64 + p], z_i = zi[dir * 64 + p];
        bbr[e] = z_r * br - z_i * bi; bbi[e] = z_r * bi + z_i * br; }
    for (int e = tid; e < 2048; e += 512) { const int dir = e >> 10, h = (e >> 6) & 15, p = e & 63; const size_t o = (((size_t)(l * 2 + dir) * 64 + g) * 16 + h) * 64 + p;
        ccr[e] = PIN(9)[o]; cci[e] = PIN(10)[o]; }
    __syncthreads();
    for (int e = tid; e < 8192; e += 512) { const int dir = e >> 12, dd = (e >> 8) & 15, h = (e >> 4) & 15, h2 = e & 15; float s = 0.f;
        for (int p = 0; p < 64; ++p) { const float cr = ccr[(dir * 16 + h) * 64 + p], ci = cci[(dir * 16 + h) * 64 + p], lr = lpr[(dir * 17 + dd) * 64 + p], li = lpi[(dir * 17 + dd) * 64 + p];
            const float ur = cr * lr - ci * li, ui = cr * li + ci * lr; s += ur * bbr[(dir * 64 + p) * 16 + h2] - ui * bbi[(dir * 64 + p) * 16 + h2]; }
        kd[e] = s; }
    __syncthreads();
    bf16_t* WST = (bf16_t*)(P.ws + zz + WS_WST) + ((size_t)l * 64 + g) * (256 * LDWS);
    for (int e8 = tid; e8 < 8192; e8 += 512) { const int n = e8 >> 5, k0 = (e8 & 31) * 8; const int part = n >> 6, p = n & 63, dir = part >> 1; float v[8];
#pragma unroll
        for (int j = 0; j < 8; ++j) { const int k = k0 + j, s = k >> 4, h2 = k & 15, pw = dir == 0 ? 15 - s : s; const float lr = lpr[(dir * 17 + pw) * 64 + p], li = lpi[(dir * 17 + pw) * 64 + p], br = bbr[(dir * 64 + p) * 16 + h2], bi = bbi[(dir * 64 + p) * 16 + h2];
            v[j] = (part & 1) ? (lr * bi + li * br) : (lr * br - li * bi); }
        u32x4 o; o.x = cvt_pk_bf16(v[0], v[1]); o.y = cvt_pk_bf16(v[2], v[3]); o.z = cvt_pk_bf16(v[4], v[5]); o.w = cvt_pk_bf16(v[6], v[7]);
        *(u32x4*)(WST + (size_t)n * LDWS + k0) = o; }
    bf16_t* TO = (bf16_t*)(P.ws + zz + WS_TO) + ((size_t)l * 64 + g) * (256 * LDTO);
    const float* dsk = PIN(11) + ((size_t)l * 64 + g) * 16;
    for (int e8 = tid; e8 < 16384; e8 += 512) { const int n = e8 >> 6, k0 = (e8 & 63) * 8; const int t = n >> 4, h = n & 15; float v[8];
#pragma unroll
        for (int j = 0; j < 8; ++j) { const int k = k0 + j;
            if (k < 256) { const int s = k >> 4, h2 = k & 15;
                if (t > s) v[j] = kd[((0 * 16 + (t - s)) * 16 + h) * 16 + h2];
                else if (t < s) v[j] = kd[((1 * 16 + (s - t)) * 16 + h) * 16 + h2];
                else v[j] = kd[((0 * 16 + 0) * 16 + h) * 16 + h2] + kd[((1 * 16 + 0) * 16 + h) * 16 + h2] + (h == h2 ? dsk[h] : 0.f);
            } else { const int kk = k - 256, part = kk >> 6, p = kk & 63, dir = part >> 1, pw = dir == 0 ? t + 1 : 16 - t;
                const float cr = ccr[(dir * 16 + h) * 64 + p], ci = cci[(dir * 16 + h) * 64 + p], lr = lpr[(dir * 17 + pw) * 64 + p], li = lpi[(dir * 17 + pw) * 64 + p];
                v[j] = (part & 1) ? -(cr * li + ci * lr) : (cr * lr - ci * li); } }
        u32x4 o; o.x = cvt_pk_bf16(v[0], v[1]); o.y = cvt_pk_bf16(v[2], v[3]); o.z = cvt_pk_bf16(v[4], v[5]); o.w = cvt_pk_bf16(v[6], v[7]);
        *(u32x4*)(TO + (size_t)n * LDTO + k0) = o; }
    __syncthreads();
}

__device__ __forceinline__ unsigned char* wset_base(const Params& P, int l, int zz) { return (l & 1) ? (unsigned char*)P.out + zz : P.ws + zz + WS_WSET; }
__device__ __forceinline__ void convert_weights(const Params& P, LAS unsigned char* lds, int l, int gw, int NGW, int wave, int lane, int it_lo = 0, int it_hi = 1 << 30) {
    LAUNDER_Z();
    unsigned char* wb = wset_base(P, l, zz);
    LAS float* scr = (LAS float*)(lds + wave * 16384);
    constexpr int I_IN = 32 * 129, I_GLU = 16 * 32, I_OUT = 32 * 64, I_G = 32 * 176, I_DN = 88 * 64, NIT = I_IN + I_GLU + I_OUT + 2 * I_G + I_DN;
    const int ihi = it_hi < NIT ? it_hi : NIT;
    for (int it = it_lo + gw; it < ihi; it += NGW) { int r = it;
        if (r < I_IN) { transpose_item(PIN(3) + (size_t)l * DM * DIN, DM, DIN, (bf16_t*)(wb + WO_WIN), LDH, scr, r, lane, PIN(2) + (size_t)l * DM); continue; } r -= I_IN;
        if (r < I_GLU) { transpose_item(PIN(12) + (size_t)l * 1024 * 1024, 1024, 1024, (bf16_t*)(wb + WO_WGLU), LDG, scr, r, lane, nullptr); continue; } r -= I_GLU;
        if (r < I_OUT) { transpose_item(PIN(19) + (size_t)l * DM * DM, DM, DM, (bf16_t*)(wb + WO_WOUT), LDH, scr, r, lane, nullptr); continue; } r -= I_OUT;
        if (r < I_G) { transpose_item(PIN(21) + (size_t)l * DM * DFF, DM, DFF, (bf16_t*)(wb + WO_WGU), LDH, scr, r, lane, PIN(20) + (size_t)l * DM, 1); continue; } r -= I_G;
        if (r < I_G) { transpose_item(PIN(22) + (size_t)l * DM * DFF, DM, DFF, (bf16_t*)(wb + WO_WGU), LDH, scr, r, lane, PIN(20) + (size_t)l * DM, 2); continue; } r -= I_G;
        transpose_item(PIN(25) + (size_t)l * DFF * DM, DFF, DM, (bf16_t*)(wb + WO_WDN), LDF, scr, r, lane, nullptr);
    }
}

__device__ __forceinline__ void phase_s5_scan(const Params& P, int l, int bofs) {
    LAUNDER_Z();
    const int t = tid_l(); if (t >= 128) return;
    const int idx = (bid_l() - bofs) * 128 + t; if (idx >= 16384 || idx < 0) return;
    const int p4 = idx & 15, dir = (idx >> 4) & 1, b = (idx >> 5) & 7, g = idx >> 8;
    const float* t16 = (const float*)(P.ws + zz + 524288) + (((size_t)l * 64 + g) * 2 + dir) * 128 + 4 * p4;
    const f32x4 Lr = *(const f32x4*)t16, Li = *(const f32x4*)(t16 + 64);
    const f32x4* sl = (const f32x4*)((const float*)(P.ws + zz + WS_SLOC) + ((size_t)g * S5ROWP + b * NCH) * 256 + dir * 128 + 4 * p4);
    bf16_t* so = (bf16_t*)(P.ws + zz + WS_UA) + ((size_t)g * S5ROWP + b * NCH) * LDU + 256 + dir * 128 + 4 * p4;
    f32x4 sr = (f32x4){0.f, 0.f, 0.f, 0.f}, si = (f32x4){0.f, 0.f, 0.f, 0.f};
    for (int blk = 0; blk < 11; ++blk) {
        f32x4 xr[12], xi[12];
#pragma unroll
        for (int j = 0; j < 12; ++j) { const int i = blk * 12 + j, n = dir == 0 ? i : NCH - 1 - i; xr[j] = sl[(size_t)n * 64]; xi[j] = sl[(size_t)n * 64 + 16]; }
#pragma unroll
        for (int j = 0; j < 12; ++j) { const int i = blk * 12 + j, n = dir == 0 ? i : NCH - 1 - i;
            u32x2 wr_, wi_; wr_.x = cvt_pk_bf16(sr[0], sr[1]); wr_.y = cvt_pk_bf16(sr[2], sr[3]); wi_.x = cvt_pk_bf16(si[0], si[1]); wi_.y = cvt_pk_bf16(si[2], si[3]);
            *(u32x2*)(so + (size_t)n * LDU) = wr_; *(u32x2*)(so + (size_t)n * LDU + 64) = wi_;
            const f32x4 nr = Lr * sr - Li * si + xr[j], ni = Lr * si + Li * sr + xi[j]; sr = nr; si = ni; }
    }
}

constexpr int MLS = 72;
__device__ __forceinline__ f32x4 mma_tile(const LAS bf16_t* A, const LAS bf16_t* Bt, int fr, int fq, f32x4 acc) {
#pragma unroll
    for (int kk = 0; kk < 2; ++kk) { const bf16x8 a = *(const LAS bf16x8*)(A + fr * MLS + kk * 32 + fq * 8); const bf16x8 b = *(const LAS bf16x8*)(Bt + fr * MLS + kk * 32 + fq * 8);
        acc = __builtin_amdgcn_mfma_f32_16x16x32_bf16(a, b, acc, 0, 0, 0); }
    return acc;
}
__device__ __forceinline__ void phase_mlstm(const Params& P, LAS unsigned char* lds, int l) {
    LAUNDER_Z();
    const int tid = tid_l(), lane = tid & 63, w = tid >> 6, fr = lane & 15, fq = lane >> 4; unsigned char* ws = P.ws + zz;
    LAS bf16_t* Qs = (LAS bf16_t*)lds;
    LAS bf16_t* Ks = Qs + 64 * MLS;
    LAS bf16_t* Kw = Ks + 64 * MLS;
    LAS bf16_t* Ss = Kw + 64 * MLS;
    LAS bf16_t* Vt = Ss + 64 * MLS;
    LAS bf16_t* Ct = Vt + 160 * MLS;
    LAS float* den = (LAS float*)(Ct + 160 * MLS);
    LAS float* CW = den + 64;
    const bf16_t* Z = (const bf16_t*)(ws + WS_Z); const float* Gt = (const float*)(ws + WS_G);
    const int nmb = gridDim.x >= 256 ? 128 : gridDim.x;
    if (bid_l() >= nmb) return;
    for (int item = bid_l(); item < 128; item += nmb) {
        const int dir = item & 1, hd = (item >> 1) & 7, b = item >> 4;
        __syncthreads();
        for (int e = tid; e < 160 * MLS; e += 512) Ct[e] = 0;
        for (int e = tid; e < 32 * MLS; e += 512) Vt[128 * MLS + e] = (e < 64) ? (bf16_t)0x3F80 : (bf16_t)0;
        f32x4 Cst[5];
#pragma unroll
        for (int j = 0; j < 5; ++j) Cst[j] = (f32x4){0.f, 0.f, 0.f, 0.f};
        float m_prev = -1e30f;
        const float gb_i = PIN(17)[l * 32 + (2 * dir) * 8 + hd], gb_f = PIN(17)[l * 32 + (2 * dir + 1) * 8 + hd];
        bf16_t* Hout = (bf16_t*)(ws + WS_HFB) + (size_t)dir * MP * 1024;
        for (int e = tid; e < 512; e += 512) { const int rr = e >> 7, c = e & 127; const int colz = (c < 64 ? hd * 64 + c : 512 + hd * 64 + (c - 64));
            CW[e] = rr < 3 ? PIN(15)[(size_t)l * 3 * 1024 + rr * 1024 + colz] : PIN(16)[(size_t)l * 1024 + colz]; }
        const int wu = __builtin_amdgcn_readfirstlane(w);
        const int colz = (wu < 4 ? hd * 64 + wu * 16 : 512 + hd * 64 + (wu - 4) * 16);
        const int myoff = dir == 0 ? lane : 63 - lane;
        const int gcol_i = (2 * dir) * 8 + hd, gcol_f = (2 * dir + 1) * 8 + hd;
        u32x4 pz[8]; float pg_i, pg_f;
#define ML_PREFETCH(cx) do { const int n_ = dir == 0 ? (cx) : 32 - (cx); const size_t r_ = (size_t)(b * LP + n_ * 64 + myoff); \
            const bf16_t* zp_ = Z + r_ * 3072 + colz; const bf16_t* vp_ = Z + r_ * 3072 + 1024 + hd * 128 + wu * 16; \
            pz[0] = *(const u32x4*)(zp_ - 3072); pz[1] = *(const u32x4*)(zp_ - 3072 + 8); pz[2] = *(const u32x4*)(zp_); pz[3] = *(const u32x4*)(zp_ + 8); \
            pz[4] = *(const u32x4*)(zp_ + 3072); pz[5] = *(const u32x4*)(zp_ + 3072 + 8); pz[6] = *(const u32x4*)(vp_); pz[7] = *(const u32x4*)(vp_ + 8); \
            pg_i = Gt[r_ * 32 + gcol_i]; pg_f = Gt[r_ * 32 + gcol_f]; } while (0)
        ML_PREFETCH(0);
        __syncthreads();
        for (int cix = 0; cix < 33; ++cix) {
            const int n = dir == 0 ? cix : 32 - cix;
            const int rowbase = b * LP + n * 64;
            u32x4 cz[8];
#pragma unroll
            for (int j = 0; j < 8; ++j) cz[j] = pz[j];
            const float cg_i = pg_i, cg_f = pg_f;
            if (cix + 1 < 33) ML_PREFETCH(cix + 1);
            const bool mypad = (n * 64 + myoff) < PADF;
            float li = cg_i + gb_i;
            const float xf = cg_f + gb_f;
            float lf = fminf(xf, 0.f) - __logf(1.0f + __expf(-fabsf(xf)));
            if (mypad) { li = -1e30f; lf = 0.f; }
            const float bc = wave_incl_sum(lf, lane);
            const float gsum = rdlane(bc, 63);
            const float m_loc = rdlane(wave_incl_max(gsum - bc + li, lane), 63);
            const float wloc = __expf(gsum - bc + li - m_loc);
            const float cv = li - bc;
            const float pm = wave_incl_max(cv, lane);
            const float Mt = fmaxf(m_prev, pm);
            const float sint = __expf(m_prev - Mt);
            const float einv = __expf(-(bc + Mt));
            const float m_new = fmaxf(gsum + m_prev, m_loc);
            const float s_old = __expf(gsum + m_prev - m_new), s_loc = __expf(m_loc - m_new);
            {
                const int i = lane; const bool pad = mypad;
                const unsigned um[8] = {cz[0].x, cz[0].y, cz[0].z, cz[0].w, cz[1].x, cz[1].y, cz[1].z, cz[1].w};
                const unsigned u0[8] = {cz[2].x, cz[2].y, cz[2].z, cz[2].w, cz[3].x, cz[3].y, cz[3].z, cz[3].w};
                const unsigned up[8] = {cz[4].x, cz[4].y, cz[4].z, cz[4].w, cz[5].x, cz[5].y, cz[5].z, cz[5].w};
                float qv[16];
#pragma unroll
                for (int j4 = 0; j4 < 4; ++j4) {
                    const f32x4 w0 = *(const LAS f32x4*)(CW + 0 * 128 + wu * 16 + j4 * 4), w1 = *(const LAS f32x4*)(CW + 1 * 128 + wu * 16 + j4 * 4), w2 = *(const LAS f32x4*)(CW + 2 * 128 + wu * 16 + j4 * 4), bb = *(const LAS f32x4*)(CW + 3 * 128 + wu * 16 + j4 * 4);
#pragma unroll
                    for (int jj = 0; jj < 2; ++jj) { const int j = j4 * 2 + jj;
                        const float x0 = bb[2 * jj] + w0[2 * jj] * bf_lo(um[j]) + w1[2 * jj] * bf_lo(u0[j]) + w2[2 * jj] * bf_lo(up[j]);
                        const float x1 = bb[2 * jj + 1] + w0[2 * jj + 1] * bf_hi(um[j]) + w1[2 * jj + 1] * bf_hi(u0[j]) + w2[2 * jj + 1] * bf_hi(up[j]);
                        qv[2 * j] = pad ? 0.f : siluf_(x0); qv[2 * j + 1] = pad ? 0.f : siluf_(x1); } }
                if (wu < 4) {
                    u32x4 o0, o1; o0.x = cvt_pk_bf16(qv[0] * 0.125f, qv[1] * 0.125f); o0.y = cvt_pk_bf16(qv[2] * 0.125f, qv[3] * 0.125f); o0.z = cvt_pk_bf16(qv[4] * 0.125f, qv[5] * 0.125f); o0.w = cvt_pk_bf16(qv[6] * 0.125f, qv[7] * 0.125f);
                    o1.x = cvt_pk_bf16(qv[8] * 0.125f, qv[9] * 0.125f); o1.y = cvt_pk_bf16(qv[10] * 0.125f, qv[11] * 0.125f); o1.z = cvt_pk_bf16(qv[12] * 0.125f, qv[13] * 0.125f); o1.w = cvt_pk_bf16(qv[14] * 0.125f, qv[15] * 0.125f);
                    *(LAS u32x4*)(Qs + i * MLS + wu * 16) = o0; *(LAS u32x4*)(Qs + i * MLS + wu * 16 + 8) = o1;
                } else {
                    const int d0 = (wu - 4) * 16;
                    u32x4 o0, o1; o0.x = cvt_pk_bf16(qv[0], qv[1]); o0.y = cvt_pk_bf16(qv[2], qv[3]); o0.z = cvt_pk_bf16(qv[4], qv[5]); o0.w = cvt_pk_bf16(qv[6], qv[7]);
                    o1.x = cvt_pk_bf16(qv[8], qv[9]); o1.y = cvt_pk_bf16(qv[10], qv[11]); o1.z = cvt_pk_bf16(qv[12], qv[13]); o1.w = cvt_pk_bf16(qv[14], qv[15]);
                    *(LAS u32x4*)(Ks + i * MLS + d0) = o0; *(LAS u32x4*)(Ks + i * MLS + d0 + 8) = o1;
#pragma unroll
                    for (int j = 0; j < 16; ++j) Kw[(d0 + j) * MLS + i] = f2bf(qv[j] * wloc);
                }
                const unsigned uv[8] = {cz[6].x, cz[6].y, cz[6].z, cz[6].w, cz[7].x, cz[7].y, cz[7].z, cz[7].w};
#pragma unroll
                for (int j = 0; j < 8; ++j) { Vt[(wu * 16 + 2 * j) * MLS + i] = pad ? (bf16_t)0 : (bf16_t)(uv[j] & 0xffffu); Vt[(wu * 16 + 2 * j + 1) * MLS + i] = pad ? (bf16_t)0 : (bf16_t)(uv[j] >> 16); }
            }
            __syncthreads();
            {
                const int st = w & 3;
#pragma unroll
                for (int jj = 0; jj < 2; ++jj) { const int tt = (w >> 2) * 2 + jj;
                    f32x4 a = (f32x4){0.f, 0.f, 0.f, 0.f};
                    a = mma_tile(Ks + st * 16 * MLS, Qs + tt * 16 * MLS, fr, fq, a);
                    const int t = tt * 16 + fr, s0 = st * 16 + 4 * fq; const float Mtt = shi(Mt, t);
                    f32x4 o;
#pragma unroll
                    for (int j = 0; j < 4; ++j) { const float cs = shi(cv, s0 + j); o[j] = (s0 + j <= t) ? a[j] * __expf(cs - Mtt) : 0.f; }
                    u32x2 pk; pk.x = cvt_pk_bf16(o[0], o[1]); pk.y = cvt_pk_bf16(o[2], o[3]);
                    *(LAS u32x2*)(Ss + t * MLS + s0) = pk; }
            }
            __syncthreads();
            f32x4 num[5];
            const int tt = w & 3, tC = tt * 16 + fr; const float sint_t = shi(sint, tC), einv_t = shi(einv, tC);
#pragma unroll
            for (int j = 0; j < 5; ++j) { const int dvt = (w >> 2) * 5 + j;
                f32x4 a1 = (f32x4){0.f, 0.f, 0.f, 0.f}, a2 = (f32x4){0.f, 0.f, 0.f, 0.f};
                a1 = mma_tile(Vt + dvt * 16 * MLS, Ss + tt * 16 * MLS, fr, fq, a1);
                a2 = mma_tile(Ct + dvt * 16 * MLS, Qs + tt * 16 * MLS, fr, fq, a2);
                num[j] = a1 + a2 * sint_t;
                if (dvt == 8 && fq == 0) den[tC] = num[j][0]; }
            __syncthreads();
            {
                const float dn = den[tC]; const float inv = __builtin_amdgcn_rcpf(fmaxf(fabsf(dn), einv_t));
                const int off = dir == 0 ? tC : 63 - tC; const size_t r = (size_t)rowbase + off;
#pragma unroll
                for (int j = 0; j < 5; ++j) { const int dvt = (w >> 2) * 5 + j;
                    if (dvt < 8) store_bf4(Hout + r * 1024 + hd * 128 + dvt * 16 + 4 * fq, num[j] * inv); }
            }
            {
                const int dkt = w & 3;
#pragma unroll
                for (int j = 0; j < 5; ++j) { const int dvt = (w >> 2) * 5 + j;
                    f32x4 a = (f32x4){0.f, 0.f, 0.f, 0.f};
                    a = mma_tile(Kw + dkt * 16 * MLS, Vt + dvt * 16 * MLS, fr, fq, a);
                    Cst[j] = Cst[j] * s_old + a * s_loc;
                    u32x2 pk; pk.x = cvt_pk_bf16(Cst[j][0], Cst[j][1]); pk.y = cvt_pk_bf16(Cst[j][2], Cst[j][3]);
                    *(LAS u32x2*)(Ct + (dvt * 16 + fr) * MLS + dkt * 16 + 4 * fq) = pk; }
            }
            m_prev = m_new;
            __syncthreads();
        }
    }
}

__device__ __forceinline__ void phase_finalize(const Params& P, int l) {
    LAUNDER_Z();
    const int tid = tid_l(), lane = tid & 63, gw = bid_l() * 8 + (tid >> 6), NGW = gridDim.x * 8; unsigned char* ws = P.ws + zz;
    const bf16_t* YG = (const bf16_t*)(ws + WS_YGLU); const bf16_t* HF = (const bf16_t*)(ws + WS_HFB); const bf16_t* HB = HF + (size_t)MP * 1024;
    const bf16_t* Z = (const bf16_t*)(ws + WS_Z); bf16_t* Y = (bf16_t*)(ws + WS_Y);
    float g1[16], g2[16];
    { const f32x4* p1 = (const f32x4*)(PIN(14) + (size_t)l * 1024 + lane * 16); const f32x4* p2 = (const f32x4*)(PIN(18) + (size_t)l * 1024 + lane * 16);
#pragma unroll
      for (int j = 0; j < 4; ++j) { const f32x4 a = p1[j], b = p2[j]; g1[4 * j] = a[0]; g1[4 * j + 1] = a[1]; g1[4 * j + 2] = a[2]; g1[4 * j + 3] = a[3]; g2[4 * j] = b[0]; g2[4 * j + 1] = b[1]; g2[4 * j + 2] = b[2]; g2[4 * j + 3] = b[3]; } }
    for (int r = gw; r < MP; r += NGW) {
        u32x4* yo = (u32x4*)(Y + (size_t)r * LDH);
        if ((r % LP) < PADF) { unsigned z0 = 0u; asm volatile("" : "+v"(z0)); for (int j = 0; j < 4; ++j) yo[lane + 64 * j] = (u32x4){z0, z0, z0, z0}; continue; }
        const size_t o = (size_t)r * 1024 + lane * 16;
        const u32x4 f0 = *(const u32x4*)(HF + o), f1 = *(const u32x4*)(HF + o + 8), b0 = *(const u32x4*)(HB + o), b1 = *(const u32x4*)(HB + o + 8);
        const u32x4 q0 = *(const u32x4*)(Z + (size_t)r * 3072 + 2048 + lane * 16), q1 = *(const u32x4*)(Z + (size_t)r * 3072 + 2048 + lane * 16 + 8);
        {
            const u32x4 a0 = *(const u32x4*)(YG + (size_t)r * 1024 + lane * 16), a1 = *(const u32x4*)(YG + (size_t)r * 1024 + lane * 16 + 8);
            const unsigned uu[8] = {a0.x, a0.y, a0.z, a0.w, a1.x, a1.y, a1.z, a1.w}; float v[16]; float s = 0.f;
#pragma unroll
            for (int j = 0; j < 8; ++j) { v[2 * j] = bf_lo(uu[j]); v[2 * j + 1] = bf_hi(uu[j]); s += v[2 * j] * v[2 * j] + v[2 * j + 1] * v[2 * j + 1]; }
            const float rs = __builtin_amdgcn_rsqf(wave_sum(s, lane) * (1.0f / 1024.0f) + EPSN);
            const float* g = g1;
            u32x4 o0, o1; o0.x = cvt_pk_bf16(v[0] * rs * g[0], v[1] * rs * g[1]); o0.y = cvt_pk_bf16(v[2] * rs * g[2], v[3] * rs * g[3]); o0.z = cvt_pk_bf16(v[4] * rs * g[4], v[5] * rs * g[5]); o0.w = cvt_pk_bf16(v[6] * rs * g[6], v[7] * rs * g[7]);
            o1.x = cvt_pk_bf16(v[8] * rs * g[8], v[9] * rs * g[9]); o1.y = cvt_pk_bf16(v[10] * rs * g[10], v[11] * rs * g[11]); o1.z = cvt_pk_bf16(v[12] * rs * g[12], v[13] * rs * g[13]); o1.w = cvt_pk_bf16(v[14] * rs * g[14], v[15] * rs * g[15]);
            yo[lane * 2] = o0; yo[lane * 2 + 1] = o1;
        }
        {
            const unsigned uf[8] = {f0.x, f0.y, f0.z, f0.w, f1.x, f1.y, f1.z, f1.w}, ub[8] = {b0.x, b0.y, b0.z, b0.w, b1.x, b1.y, b1.z, b1.w}, uo[8] = {q0.x, q0.y, q0.z, q0.w, q1.x, q1.y, q1.z, q1.w};
            float v[16]; float s = 0.f;
#pragma unroll
            for (int j = 0; j < 8; ++j) { v[2 * j] = bf_lo(uf[j]) + bf_lo(ub[j]); v[2 * j + 1] = bf_hi(uf[j]) + bf_hi(ub[j]); s += v[2 * j] * v[2 * j] + v[2 * j + 1] * v[2 * j + 1]; }
            s += shx(s, 1, lane); s += shx(s, 2, lane); s += shx(s, 4, lane);
            const float rs = __builtin_amdgcn_rsqf(s * (1.0f / 128.0f) + EPSN);
            const float* g = g2;
            float ov[16];
#pragma unroll
            for (int j = 0; j < 8; ++j) { ov[2 * j] = sigmoidf_(bf_lo(uo[j])) * v[2 * j] * rs * g[2 * j]; ov[2 * j + 1] = sigmoidf_(bf_hi(uo[j])) * v[2 * j + 1] * rs * g[2 * j + 1]; }
            u32x4 o0, o1; o0.x = cvt_pk_bf16(ov[0], ov[1]); o0.y = cvt_pk_bf16(ov[2], ov[3]); o0.z = cvt_pk_bf16(ov[4], ov[5]); o0.w = cvt_pk_bf16(ov[6], ov[7]);
            o1.x = cvt_pk_bf16(ov[8], ov[9]); o1.y = cvt_pk_bf16(ov[10], ov[11]); o1.z = cvt_pk_bf16(ov[12], ov[13]); o1.w = cvt_pk_bf16(ov[14], ov[15]);
            yo[128 + lane * 2] = o0; yo[128 + lane * 2 + 1] = o1;
        }
    }
}

__device__ __forceinline__ void phase_final(const Params& P) {
    LAUNDER_Z();
    const int lane = tid_l() & 63, gw = bid_l() * 8 + (tid_l() >> 6), NGW = gridDim.x * 8;
    const float* H = (const float*)(P.ws + zz + WS_H);
    for (int q = gw; q < NB * 2048; q += NGW) {
        const int b = q >> 11, t = q & 2047; const size_t r = (size_t)b * LP + 64 + t;
        const f32x4* xr = (const f32x4*)(H + r * DM) + lane; const f32x4* gr = (const f32x4*)PIN(26) + lane; f32x4* o = (f32x4*)(P.out + zz + (size_t)q * DM) + lane;
        f32x4 v[8]; float s = 0.f;
#pragma unroll
        for (int j = 0; j < 8; ++j) { v[j] = xr[64 * j]; s += (v[j][0] * v[j][0] + v[j][1] * v[j][1]) + (v[j][2] * v[j][2] + v[j][3] * v[j][3]); }
        const float rs = __builtin_amdgcn_rsqf(wave_sum(s, lane) * (1.0f / DM) + EPSN);
#pragma unroll
        for (int j = 0; j < 8; ++j) o[64 * j] = v[j] * rs * gr[64 * j];
    }
}

#define XB_TMO      128
#define XB_XCNT(j)  (256  + 64 * (j))
#define XB_XSUB(j)  (1280 + 64 * (j))
#define XB_XGEN(j)  (2304 + 64 * (j))
#define XB_TOP      3328
#define XB_TOPGEN   3392
#define XCD_BAR_WORDS 3456
#define XB_SPIN_CAP (1u << 22)
__device__ __forceinline__ unsigned xb_ld(unsigned* p)              { return __hip_atomic_load(p, __ATOMIC_RELAXED, __HIP_MEMORY_SCOPE_AGENT); }
__device__ __forceinline__ unsigned xb_add(unsigned* p, unsigned v) { return __hip_atomic_fetch_add(p, v, __ATOMIC_RELAXED, __HIP_MEMORY_SCOPE_AGENT); }
__device__ __forceinline__ unsigned xb_xcc_id() { return (unsigned)__builtin_amdgcn_s_getreg((3 << 11) | 20) & 0xFu; }
#define XB_SPIN(cond, bar) do { unsigned _sp = 0; while (cond) { __builtin_amdgcn_s_sleep(1); \
    if ((++_sp & 255u) == 0u) { if (xb_ld(&(bar)[XB_TMO])) break; if (_sp > XB_SPIN_CAP) { atomicAdd(&(bar)[XB_TMO], 1u); break; } } } } while (0)
__device__ __forceinline__ void xcd_barrier(unsigned* bar, volatile LAS unsigned* st, unsigned G) {
    asm volatile("s_waitcnt vmcnt(0)" ::: "memory");
    __syncthreads();
    if (tid_l() == 0) {
        __builtin_amdgcn_s_waitcnt(0);
        const unsigned x = xb_xcc_id();
        unsigned nloc = st[0], nx = st[1];
        if (nloc == 0u) {
            unsigned sum, cnt, mine, sp = 0u;
            for (;;) {
                sum = 0u; cnt = 0u; mine = 0u;
#pragma unroll
                for (unsigned j = 0; j < 16; ++j) { const unsigned c = xb_ld(&bar[XB_XCNT(j)]); sum += c; cnt += (c > 0u) ? 1u : 0u; mine = (j == x) ? c : mine; }
                if (sum == G) break;
                __builtin_amdgcn_s_sleep(1);
                if ((++sp & 255u) == 0u) { if (xb_ld(&bar[XB_TMO])) break; if (sp > XB_SPIN_CAP) { atomicAdd(&bar[XB_TMO], 1u); break; } }
            }
            nloc = mine > 0u ? mine : 1u; nx = cnt > 0u ? cnt : 1u; st[0] = nloc; st[1] = nx;
        }
        const unsigned old = xb_add(&bar[XB_XSUB(x)], 1u);
        const unsigned gen = old / nloc;
        if (old + 1u == (gen + 1u) * nloc) {
            __builtin_amdgcn_fence(__ATOMIC_RELEASE, "agent");
            asm volatile("s_waitcnt vmcnt(0)" ::: "memory");
            const unsigned og = xb_add(&bar[XB_TOP], 1u);
            const unsigned tg = og / nx;
            if (og + 1u == (tg + 1u) * nx) xb_add(&bar[XB_TOPGEN], 1u);
            else XB_SPIN(xb_ld(&bar[XB_TOPGEN]) == tg, bar);
            __builtin_amdgcn_fence(__ATOMIC_ACQUIRE, "agent");
            xb_add(&bar[XB_XGEN(x)], 1u);
            asm volatile("s_waitcnt vmcnt(0)" ::: "memory");
        } else {
            XB_SPIN(xb_ld(&bar[XB_XGEN(x)]) == gen, bar);
            __builtin_amdgcn_fence(__ATOMIC_ACQUIRE, "agent");
            asm volatile("s_waitcnt vmcnt(0)" ::: "memory");
        }
    }
    __syncthreads();
}

__global__ void __launch_bounds__(512, 2) mk_fwd(Params P) {
    extern __shared__ __attribute__((aligned(16))) unsigned char lds_raw[];
    LAS unsigned char* lds = (LAS unsigned char*)lds_raw;
    cg::grid_group grid = cg::this_grid();
    volatile LAS unsigned* xst = (volatile LAS unsigned*)(lds + 131072);
    if (threadIdx.x < 4) xst[threadIdx.x] = 0u;
    __syncthreads();
    unsigned char* ws = P.ws;
    for (int ph = P.ph_lo; ph < P.ph_hi; ++ph) {
        if (ph == 0) {
            if (bid_l() == 0) { for (int i = tid_l(); i < 8192 + 1024 + XCD_BAR_WORDS; i += 512) ((unsigned*)ws)[i] = 0u; }
            phase_init_rows(P);
            for (int pr = bid_l(); pr < DEPTH * 64; pr += gridDim.x) s5_precompute(P, lds, pr >> 6, pr & 63);
            __syncthreads();
            convert_weights(P, lds, 0, bid_l() * 8 + (tid_l() >> 6), gridDim.x * 8, tid_l() >> 6, tid_l() & 63);
        }
        else if (ph == NPHASES - 1) phase_final(P);
        else {
            const int l = (ph - 1) / NPH_L, k = (ph - 1) % NPH_L;
            GemmDesc d; d.layer = l; d.nB = 1; d.sA = 0; d.sB = 0; d.A = nullptr; d.Bt = nullptr; d.lda = d.ldb = d.K = 256; d.nM = d.nN = 1; d.epi = 0; d.ssi = 0; d.amode = 0; d.split = 0; d.perm = 0; d.ubase = 0; d.umax = 0x7fffffff; d.gG = gridDim.x; d.gc = bid_l(); bool isg = false;
            const unsigned char* wb = (l & 1) ? (const unsigned char*)P.out : ws + WS_WSET;
            switch (k) {
            case 0: { const int gt = bid_l() * 512 + tid_l(), NGT = gridDim.x * 512; zero_rows16((bf16_t*)(ws + WS_Z) - 3072, 384, gt, NGT); zero_rows16((bf16_t*)(ws + WS_Z) + (size_t)MP * 3072, 384, gt, NGT); }
                d.A = (const bf16_t*)(ws + WS_HN); d.Bt = (const bf16_t*)(wb + WO_WIN); d.lda = LDH; d.ldb = LDH; d.K = DM; d.nM = MP / 256; d.nN = DINP / 256; d.epi = EPI_WIN; d.ssi = 2 * l; d.perm = 1; isg = true; break;
            case 1:
                if (bid_l() < 128) phase_mlstm(P, lds, l);
                else {
                    d.gG = gridDim.x - 128; d.gc = bid_l() - 128;
                    d.A = (const bf16_t*)(ws + WS_UA); d.Bt = (const bf16_t*)(ws + WS_WST) + (size_t)l * 64 * (256 * LDWS); d.lda = LDU; d.ldb = LDWS; d.K = 256; d.nM = S5ROWP / 256; d.nN = 1; d.nB = 64; d.sA = (size_t)S5ROWP * LDU; d.sB = 256 * LDWS; d.epi = EPI_S5A; d.perm = 1;
                    gemm_phase(P, lds, d);
                    xcd_barrier((unsigned*)ws + 8192 + 1024, xst + 2, gridDim.x - 128);
                    phase_s5_scan(P, l, 128);
                    xcd_barrier((unsigned*)ws + 8192 + 1024, xst + 2, gridDim.x - 128);
                    d.Bt = (const bf16_t*)(ws + WS_TO) + (size_t)l * 64 * (256 * LDTO); d.ldb = LDTO; d.K = 512; d.sB = 256 * LDTO; d.epi = EPI_S5C; d.perm = 1;
                    gemm_phase(P, lds, d);
                    xcd_barrier((unsigned*)ws + 8192 + 1024, xst + 2, gridDim.x - 128);
                    d.A = (const bf16_t*)(ws + WS_YGELU); d.Bt = (const bf16_t*)(wb + WO_WGLU); d.lda = LDG; d.ldb = LDG; d.K = 1024; d.nM = MP / 256; d.nN = 4; d.nB = 1; d.sA = 0; d.sB = 0; d.epi = EPI_GLU; d.perm = 1; d.umax = 2 * (gridDim.x - 128); isg = true;
                    if (bid_l() == 128 && tid_l() == 0) __hip_atomic_store((unsigned*)ws + 128, (unsigned)(l + 1), __ATOMIC_RELAXED, __HIP_MEMORY_SCOPE_AGENT);
                }
                break;
            case 2: phase_finalize(P, l); break;
            case 3: d.A = (const bf16_t*)(ws + WS_Y); d.Bt = (const bf16_t*)(wb + WO_WOUT); d.lda = LDH; d.ldb = LDH; d.K = DM; d.nM = MP / 256; d.nN = 8; d.epi = EPI_RES; d.ssi = 2 * l + 1; d.split = 4; d.perm = 1; isg = true; break;
            case 4: d.A = (const bf16_t*)(ws + WS_HN) - LDH; d.Bt = (const bf16_t*)(wb + WO_WGU); d.lda = LDH; d.ldb = LDH; d.K = DM; d.nM = 69; d.nN = 44; d.epi = EPI_FFN; d.ssi = 2 * l + 1; d.amode = 1; d.perm = 1; isg = true; break;
            case 5: d.A = (const bf16_t*)(ws + WS_ACT); d.Bt = (const bf16_t*)(wb + WO_WDN); d.lda = LDF; d.ldb = LDF; d.K = DFF; d.nM = MP / 256; d.nN = 8; d.epi = EPI_RES; d.ssi = 2 * l + 2; d.split = 4; d.perm = 1; isg = true; break;
            }
            if (isg) gemm_phase(P, lds, d);
            if (k == 0 && l + 1 < DEPTH) {
                const int nun = (MP / 256) * (DINP / 256), nbusy = nun - (nun / (int)gridDim.x) * (int)gridDim.x; const int t_ = tid_l(); __syncthreads();
                if (bid_l() >= nbusy) convert_weights(P, lds, l + 1, (bid_l() - nbusy) * 8 + (t_ >> 6), (gridDim.x - nbusy) * 8, t_ >> 6, t_ & 63, 0, CV_SPLIT1);
            }
            if (k == 1 && l + 1 < DEPTH && bid_l() < 128) {
                const int t_ = tid_l(); __syncthreads();
                convert_weights(P, lds, l + 1, bid_l() * 8 + (t_ >> 6), 128 * 8, t_ >> 6, t_ & 63, CV_SPLIT1, CV_SPLIT2);
            }
            if (k == 1 && bid_l() < 128) {
                const int ntail = (MP / 256) * 4 - 2 * ((int)gridDim.x - 128);
                if ((int)bid_l() < ntail) {
                    __syncthreads();
                    if (tid_l() == 0) { unsigned sp = 0; while (__hip_atomic_load((unsigned*)ws + 128, __ATOMIC_RELAXED, __HIP_MEMORY_SCOPE_AGENT) < (unsigned)(l + 1)) { __builtin_amdgcn_s_sleep(4); if (++sp > (1u << 24)) break; }
                        __builtin_amdgcn_fence(__ATOMIC_ACQUIRE, "agent"); asm volatile("s_waitcnt vmcnt(0)" ::: "memory"); }
                    __syncthreads();
                    d.A = (const bf16_t*)(ws + WS_YGELU); d.Bt = (const bf16_t*)(wb + WO_WGLU); d.lda = LDG; d.ldb = LDG; d.K = 1024; d.nM = MP / 256; d.nN = 4; d.nB = 1; d.sA = 0; d.sB = 0; d.epi = EPI_GLU; d.perm = 1;
                    d.ubase = 2 * ((int)gridDim.x - 128); d.umax = 0x7fffffff; d.gG = ntail; d.gc = bid_l();
                    gemm_phase(P, lds, d);
                }
            }
            if (k == 5 && l + 1 < DEPTH) {
                const int nun = (MP / 256) * 8, nfull = (nun / (int)gridDim.x) * (int)gridDim.x, nbusy = (nun - nfull) * 4;
                const int t_ = tid_l(); __syncthreads();
                if (nbusy == 0 || nbusy >= (int)gridDim.x) convert_weights(P, lds, l + 1, bid_l() * 8 + (t_ >> 6), gridDim.x * 8, t_ >> 6, t_ & 63, CV_SPLIT2);
                else if (bid_l() >= nbusy) convert_weights(P, lds, l + 1, (bid_l() - nbusy) * 8 + (t_ >> 6), (gridDim.x - nbusy) * 8, t_ >> 6, t_ & 63, CV_SPLIT2);
            }
        }
        if (ph + 1 < P.ph_hi) { if (ph == 0) { grid.sync(); if (threadIdx.x == 0) { (void)xb_add((unsigned*)ws + 1024 + XB_XCNT(xb_xcc_id()), 1u); if (blockIdx.x >= 128) (void)xb_add((unsigned*)ws + 8192 + 1024 + XB_XCNT(xb_xcc_id()), 1u); } } else xcd_barrier((unsigned*)ws + 1024, xst, gridDim.x); }
    }
}

extern "C" void kernel_launch(void* const* d_in, const int* in_sizes, int n_in, void* d_out, int out_size, void* d_ws, size_t ws_size, hipStream_t stream) {
    static int grid = 0;
    if (grid == 0) {
        int dev = 0, cus = 0, per_cu = 0;
        hipGetDevice(&dev); hipDeviceGetAttribute(&cus, hipDeviceAttributeMultiprocessorCount, dev);
        if (hipFuncSetAttribute((const void*)mk_fwd, hipFuncAttributeMaxDynamicSharedMemorySize, LDS_BYTES) != hipSuccess) { fprintf(stderr, "kernel_launch: hipFuncSetAttribute failed\n"); grid = -1; return; }
        if (hipOccupancyMaxActiveBlocksPerMultiprocessor(&per_cu, (const void*)mk_fwd, 512, LDS_BYTES) != hipSuccess || per_cu < 1) { fprintf(stderr, "kernel_launch: occupancy query says %d\n", per_cu); per_cu = 1; }
        (void)hipGetLastError();
        grid = cus;
        if (ws_size < WS_END) fprintf(stderr, "kernel_launch: workspace too small: %zu < %zu\n", ws_size, (size_t)WS_END);
    }
    if (grid < 0) return;
    Params p{};
    for (int i = 0; i < 27; ++i) p.in[i] = (const float*)d_in[i];
    p.out = (float*)d_out; p.ws = (unsigned char*)d_ws; p.ph_lo = 0; p.ph_hi = NPHASES;
    void* args[] = {&p};
    hipError_t e = hipLaunchCooperativeKernel((const void*)mk_fwd, dim3(grid), dim3(512), args, LDS_BYTES, stream);
    if (e != hipSuccess) fprintf(stderr, "cooperative launch failed: %s (grid %d)\n", hipGetErrorString(e), grid);
}
```
